# Optimizing an MI355X kernel written in HIP

```python
import math
import jax, jax.numpy as jnp
from jax import lax
import numpy as np

D_MODEL = 1024
BATCH = 2
SEQ = 16384
DEPTH = 2

GRID_W = 64
CTX_LEN = 256
ROPE_THETA = 10000.0
Q_BLOCK = 128
EPS = 1e-6
HALF_WIDTH = D_MODEL // 2

A_HEAD_DIM = 64
A_HEADS = HALF_WIDTH // A_HEAD_DIM
A_KV_HEADS = 2
A_WIDTH = A_HEADS * A_HEAD_DIM
A_KV_WIDTH = A_KV_HEADS * A_HEAD_DIM
B_HEAD_DIM = 128
B_HEADS = HALF_WIDTH // B_HEAD_DIM
B_WIDTH = B_HEADS * B_HEAD_DIM
B_CONV = 3
B_CHUNK = 128
IN_EVEN = A_WIDTH + 2 * A_KV_WIDTH + 4 * B_WIDTH + 4 * B_HEADS
MIX_EVEN = A_WIDTH + B_WIDTH
C_HEAD_DIM = 64
C_V_DIM = 2 * C_HEAD_DIM
C_HEADS = HALF_WIDTH // C_V_DIM
C_WIDTH = C_HEADS * C_V_DIM
D_HEADS = 4
D_Q_LORA = 256
D_KV_LORA = 128
D_NOPE = 64
D_ROPE = 32
D_V_DIM = HALF_WIDTH // D_HEADS
D_WIDTH = D_HEADS * D_V_DIM
IN_ODD = 3 * C_WIDTH + D_Q_LORA + D_KV_LORA + D_ROPE
MIX_ODD = C_WIDTH + D_WIDTH
N_EXPERTS = 32
N_GROUPS = 4
TOP_K = 2
D_EXPERT = 512
MOE_BLOCK = 128

kernel_name = "hybrid_gqa_mlstm_diffattn_mla_moe_prefix_dit"


def rms_norm(x, g):
    xf = x.astype(jnp.float32)
    y = xf * lax.rsqrt(jnp.mean(xf * xf, axis=-1, keepdims=True) + EPS)
    return (y * g.astype(jnp.float32)).astype(x.dtype)


def modulate(x, g, shift, scale):
    return rms_norm(x, g) * (1.0 + scale) + shift


def split_cols(z, sizes):
    bounds = [int(b) for b in np.cumsum(sizes)[:-1]]
    return jnp.split(z, bounds, axis=-1)


def axial_rope_tables(n_tokens, rot_dim):
    rows = n_tokens // GRID_W
    row = jnp.repeat(jnp.arange(rows), GRID_W)
    col = jnp.tile(jnp.arange(GRID_W), rows)
    n_freq = rot_dim // 4
    inv = ROPE_THETA ** (-jnp.arange(n_freq, dtype=jnp.float32) / n_freq)
    ang = jnp.concatenate([row[:, None] * inv, col[:, None] * inv], axis=-1)
    return jnp.cos(ang), jnp.sin(ang)


def apply_rope(x, cos, sin):
    xp = x.reshape(*x.shape[:-1], -1, 2)
    x0, x1 = xp[..., 0], xp[..., 1]
    c = cos[:, None, :].astype(x.dtype)
    s = sin[:, None, :].astype(x.dtype)
    return jnp.stack([x0 * c - x1 * s, x0 * s + x1 * c], axis=-1).reshape(x.shape)


def q_layout(q, n_kv):
    b, n, h, d = q.shape
    return q.reshape(b, n, n_kv, h // n_kv, d).transpose(0, 2, 3, 1, 4)


def kv_layout(t):
    return t.transpose(0, 2, 1, 3)


def merge_heads(o):
    b, hk, g, n, d = o.shape
    return o.transpose(0, 3, 1, 2, 4).reshape(b, n, hk * g * d)


def blocked_attention(q, k, v, scale):
    b, hk, g, sq, d = q.shape
    nb = sq // Q_BLOCK
    qb = jnp.moveaxis(q.reshape(b, hk, g, nb, Q_BLOCK, d), 3, 0)

    def one(qi):
        s = jnp.einsum('bhgqd,bhkd->bhgqk', qi, k).astype(jnp.float32) * scale
        p = jax.nn.softmax(s, axis=-1)
        return jnp.einsum('bhgqk,bhkd->bhgqd', p.astype(v.dtype), v)

    out = lax.map(one, qb)
    return jnp.moveaxis(out, 0, 3).reshape(b, hk, g, sq, v.shape[-1])


def blocked_diff_attention(q1, q2, k1, k2, v, lam, scale):
    b, h, sq, d = q1.shape
    nb = sq // Q_BLOCK
    q1b = jnp.moveaxis(q1.reshape(b, h, nb, Q_BLOCK, d), 2, 0)
    q2b = jnp.moveaxis(q2.reshape(b, h, nb, Q_BLOCK, d), 2, 0)

    def one(qs):
        qa, qb = qs
        p1 = jax.nn.softmax(jnp.einsum('bhqd,bhkd->bhqk', qa, k1).astype(jnp.float32) * scale, axis=-1)
        p2 = jax.nn.softmax(jnp.einsum('bhqd,bhkd->bhqk', qb, k2).astype(jnp.float32) * scale, axis=-1)
        return jnp.einsum('bhqk,bhkd->bhqd', (p1 - lam * p2).astype(v.dtype), v)

    out = lax.map(one, (q1b, q2b))
    return jnp.moveaxis(out, 0, 2).reshape(b, h, sq, v.shape[-1])


def centred_conv(x, w, bias):
    n = x.shape[1]
    pad = B_CONV // 2
    xp = jnp.pad(x, ((0, 0), (pad, pad), (0, 0)))
    return sum(xp[:, j:j + n] * w[j] for j in range(B_CONV)) + bias


def mlstm_chunkwise(q, k, v, i_pre, log_f, state):
    b, h, L, d = q.shape
    nc = L // B_CHUNK

    def chunks(t):
        return jnp.moveaxis(t.reshape(b, h, nc, B_CHUNK, *t.shape[3:]), 2, 0)

    tril = jnp.tril(jnp.ones((B_CHUNK, B_CHUNK), dtype=bool))

    def step(carry, inp):
        C, n, m = carry
        qc, kc, vc, ic, fc = inp
        bcum = jnp.cumsum(fc, axis=-1)
        log_w = jnp.where(tril, bcum[..., :, None] - bcum[..., None, :] + ic[..., None, :], -jnp.inf)
        log_inter = bcum + m[..., None]
        m_row = jnp.maximum(log_inter, jnp.max(log_w, axis=-1))
        w_intra = jnp.exp(log_w - m_row[..., None])
        a_inter = jnp.exp(log_inter - m_row)
        s = jnp.einsum('bhjd,bhsd->bhjs', qc, kc) * w_intra
        num = a_inter[..., None] * jnp.einsum('bhjd,bhde->bhje', qc, C) + jnp.einsum('bhjs,bhse->bhje', s, vc)
        den = a_inter * jnp.einsum('bhjd,bhd->bhj', qc, n) + jnp.sum(s, axis=-1)
        hc = num / jnp.maximum(jnp.abs(den), jnp.exp(-m_row))[..., None]
        b_last = bcum[..., -1]
        log_g = b_last[..., None] - bcum + ic
        m_new = jnp.maximum(b_last + m, jnp.max(log_g, axis=-1))
        g = jnp.exp(log_g - m_new[..., None])
        decay = jnp.exp(b_last + m - m_new)
        C_new = decay[..., None, None] * C + jnp.einsum('bhsd,bhse->bhde', kc * g[..., None], vc)
        n_new = decay[..., None] * n + jnp.einsum('bhs,bhsd->bhd', g, kc)
        return (C_new, n_new, m_new), hc

    state, hs = lax.scan(step, state, (chunks(q), chunks(k), chunks(v), chunks(i_pre), chunks(log_f)))
    return jnp.moveaxis(hs, 0, 2).reshape(b, h, L, d), state


def mlstm_bidirectional(ctx_in, lat_in):
    q_c, k_c, v_c, if_c, ff_c, ib_c, fb_c = ctx_in
    q_l, k_l, v_l, if_l, ff_l, ib_l, fb_l = lat_in
    bsz, nh, _, dh = q_c.shape
    zero = (jnp.zeros((bsz, nh, dh, dh), jnp.float32), jnp.zeros((bsz, nh, dh), jnp.float32),
            jnp.zeros((bsz, nh), jnp.float32))
    flip = lambda t: jnp.flip(t, axis=2)
    hf_c, st_f = mlstm_chunkwise(q_c, k_c, v_c, if_c, ff_c, zero)
    hf_l, _ = mlstm_chunkwise(q_l, k_l, v_l, if_l, ff_l, st_f)
    hb_c, st_b = mlstm_chunkwise(flip(q_c), flip(k_c), flip(v_c), flip(ib_c), flip(fb_c), zero)
    hb_l, _ = mlstm_chunkwise(flip(q_l), flip(k_l), flip(v_l), flip(ib_l), flip(fb_l), st_b)
    return hf_c + flip(hb_c), hf_l + flip(hb_l)


def even_mixer(h_lat, h_ctx, need_ctx, w_in, w_out, g_q, g_k, conv_w, conv_b, b_gates, g_h, rope):
    sizes = (A_WIDTH, A_KV_WIDTH, A_KV_WIDTH, 2 * B_WIDTH, B_WIDTH, B_WIDTH, 4 * B_HEADS)

    def project(h):
        bsz, n = h.shape[:2]
        qa, ka, va, qk_b, vb, ob, gates = split_cols(h @ w_in, sizes)
        qk_b = jax.nn.silu(centred_conv(qk_b, conv_w, conv_b))
        qb, kb = jnp.split(qk_b, 2, axis=-1)
        heads = lambda t: t.reshape(bsz, n, B_HEADS, B_HEAD_DIM).transpose(0, 2, 1, 3).astype(jnp.float32)
        gates = (gates + b_gates).astype(jnp.float32).reshape(bsz, n, 4, B_HEADS).transpose(2, 0, 3, 1)
        i_f, f_f, i_b, f_b = gates
        m_in = (heads(qb), heads(kb) * (B_HEAD_DIM ** -0.5), heads(vb),
                i_f, jax.nn.log_sigmoid(f_f), i_b, jax.nn.log_sigmoid(f_b))
        ka = rms_norm(ka.reshape(bsz, n, A_KV_HEADS, A_HEAD_DIM), g_k)
        va = va.reshape(bsz, n, A_KV_HEADS, A_HEAD_DIM)
        return qa, ka, va, m_in, ob

    def gqa_q(qa):
        bsz, n = qa.shape[:2]
        return rms_norm(qa.reshape(bsz, n, A_HEADS, A_HEAD_DIM), g_q)

    def finish_b(hb, ob):
        bsz, _, n, _ = hb.shape
        hn = rms_norm(hb.transpose(0, 2, 1, 3), g_h.reshape(B_HEADS, B_HEAD_DIM))
        return hn.reshape(bsz, n, B_WIDTH).astype(ob.dtype) * jax.nn.sigmoid(ob)

    scale = A_HEAD_DIM ** -0.5
    cos, sin = rope
    qa_l, ka_l, va_l, m_l, ob_l = project(h_lat)
    qa_c, ka_c, va_c, m_c, ob_c = project(h_ctx)
    q_l = apply_rope(gqa_q(qa_l), cos, sin)
    k_l = apply_rope(ka_l, cos, sin)
    k_all = jnp.concatenate([kv_layout(ka_c), kv_layout(k_l)], axis=2)
    v_all = jnp.concatenate([kv_layout(va_c), kv_layout(va_l)], axis=2)
    oa_l = merge_heads(blocked_attention(q_layout(q_l, A_KV_HEADS), k_all, v_all, scale))
    hb_c, hb_l = mlstm_bidirectional(m_c, m_l)
    out_l = jnp.concatenate([oa_l, finish_b(hb_l, ob_l)], axis=-1) @ w_out
    out_c = None
    if need_ctx:
        oa_c = merge_heads(blocked_attention(q_layout(gqa_q(qa_c), A_KV_HEADS),
                                             kv_layout(ka_c), kv_layout(va_c), scale))
        out_c = jnp.concatenate([oa_c, finish_b(hb_c, ob_c)], axis=-1) @ w_out
    return out_l, out_c


def odd_mixer(h_lat, h_ctx, need_ctx, lam_init, w_in, w_out, g_qc, g_kc, lam_p, g_sub,
              g_cq, w_uq, g_ckv, w_ukv, g_qd, g_kd, rope_c, rope_d):
    sizes = (C_WIDTH, C_WIDTH, C_WIDTH, D_Q_LORA, D_KV_LORA, D_ROPE)
    c_scale = C_HEAD_DIM ** -0.5
    d_scale = (D_NOPE + D_ROPE) ** -0.5

    def keys_values(zp):
        _, kc, vc, _, ckv, kr = zp
        bsz, n = kc.shape[:2]
        kc = rms_norm(kc.reshape(bsz, n, 2 * C_HEADS, C_HEAD_DIM), g_kc)
        vc = vc.reshape(bsz, n, C_HEADS, C_V_DIM)
        kv = (rms_norm(ckv, g_ckv) @ w_ukv).reshape(bsz, n, D_HEADS, D_NOPE + D_V_DIM)
        k_rope = jnp.broadcast_to(kr[:, :, None, :], (bsz, n, D_HEADS, D_ROPE))
        kd = rms_norm(jnp.concatenate([kv[..., :D_NOPE], k_rope], axis=-1), g_kd)
        return kc, vc, kd, kv[..., D_NOPE:]

    def queries(zp):
        qc, _, _, cq, _, _ = zp
        bsz, n = qc.shape[:2]
        qc = rms_norm(qc.reshape(bsz, n, 2 * C_HEADS, C_HEAD_DIM), g_qc)
        qd = rms_norm((rms_norm(cq, g_cq) @ w_uq).reshape(bsz, n, D_HEADS, D_NOPE + D_ROPE), g_qd)
        return qc, qd

    def diff_heads(t):
        bsz, n, _, d = t.shape
        t = t.reshape(bsz, n, C_HEADS, 2, d).transpose(0, 2, 3, 1, 4)
        return t[:, :, 0], t[:, :, 1]

    lq1, lk1, lq2, lk2 = lam_p.astype(jnp.float32)
    lam = jnp.exp(jnp.sum(lq1 * lk1)) - jnp.exp(jnp.sum(lq2 * lk2)) + lam_init

    def diff_attend(qc, k1, k2, v):
        q1, q2 = diff_heads(qc)
        o = blocked_diff_attention(q1, q2, k1, k2, v, lam, c_scale).transpose(0, 2, 1, 3)
        bsz, n = o.shape[:2]
        return (rms_norm(o, g_sub) * (1.0 - lam_init)).reshape(bsz, n, C_WIDTH)

    def rope_tail(t):
        return jnp.concatenate([t[..., :D_NOPE], apply_rope(t[..., D_NOPE:], *rope_d)], axis=-1)

    z_l = split_cols(h_lat @ w_in, sizes)
    z_c = split_cols(h_ctx @ w_in, sizes)
    kc_c, vc_c, kd_c, vd_c = keys_values(z_c)
    kc_l, vc_l, kd_l, vd_l = keys_values(z_l)
    qc_l, qd_l = queries(z_l)
    qc_l = apply_rope(qc_l, *rope_c)
    kc_l = apply_rope(kc_l, *rope_c)
    qd_l = rope_tail(qd_l)
    kd_l = rope_tail(kd_l)
    k1_c, k2_c = diff_heads(kc_c)
    k1_l, k2_l = diff_heads(kc_l)
    k1_all = jnp.concatenate([k1_c, k1_l], axis=2)
    k2_all = jnp.concatenate([k2_c, k2_l], axis=2)
    vc_all = jnp.concatenate([kv_layout(vc_c), kv_layout(vc_l)], axis=2)
    kd_all = jnp.concatenate([kv_layout(kd_c), kv_layout(kd_l)], axis=2)
    vd_all = jnp.concatenate([kv_layout(vd_c), kv_layout(vd_l)], axis=2)
    oc_l = diff_attend(qc_l, k1_all, k2_all, vc_all)
    od_l = merge_heads(blocked_attention(q_layout(qd_l, D_HEADS), kd_all, vd_all, d_scale))
    out_l = jnp.concatenate([oc_l, od_l], axis=-1) @ w_out
    out_c = None
    if need_ctx:
        qc_c, qd_c = queries(z_c)
        oc_c = diff_attend(qc_c, k1_c, k2_c, kv_layout(vc_c))
        od_c = merge_heads(blocked_attention(q_layout(qd_c, D_HEADS), kv_layout(kd_c), kv_layout(vd_c), d_scale))
        out_c = jnp.concatenate([oc_c, od_c], axis=-1) @ w_out
    return out_l, out_c


def moe(tokens, w_router, b_router, w1, w3, w2):
    T, d = tokens.shape
    per = N_EXPERTS // N_GROUPS
    scores = jax.nn.sigmoid((tokens @ w_router).astype(jnp.float32))
    sel = scores + b_router.astype(jnp.float32)
    grp = lax.top_k(sel.reshape(T, N_GROUPS, per), 2)[0].sum(-1)
    g_idx = jnp.argmax(grp, axis=-1)
    in_group = (jnp.arange(N_EXPERTS) // per)[None, :] == g_idx[:, None]
    _, e_idx = lax.top_k(jnp.where(in_group, sel, -jnp.inf), TOP_K)
    gate = jnp.take_along_axis(scores, e_idx, axis=-1)
    gate = gate / jnp.sum(gate, axis=-1, keepdims=True)
    n_assign = T * TOP_K
    e_flat = e_idx.reshape(-1)
    tok_flat = jnp.repeat(jnp.arange(T, dtype=jnp.int32), TOP_K)
    order = jnp.argsort(e_flat)
    se, st = e_flat[order], tok_flat[order]
    counts = jnp.zeros((N_EXPERTS,), jnp.int32).at[e_flat].add(1)
    start = jnp.cumsum(counts) - counts
    padded = (counts + MOE_BLOCK - 1) // MOE_BLOCK * MOE_BLOCK
    pend = jnp.cumsum(padded)
    pstart = pend - padded
    dest = pstart[se] + jnp.arange(n_assign, dtype=jnp.int32) - start[se]
    n_rows = -(-n_assign // MOE_BLOCK) * MOE_BLOCK + N_EXPERTS * MOE_BLOCK
    nb = n_rows // MOE_BLOCK
    row_tok = jnp.full((n_rows,), T, jnp.int32).at[dest].set(st)
    xin = jnp.concatenate([tokens, jnp.zeros((1, d), tokens.dtype)], axis=0)[row_tok]
    blk_e = jnp.minimum(jnp.searchsorted(pend, jnp.arange(nb, dtype=jnp.int32) * MOE_BLOCK, side='right'),
                        N_EXPERTS - 1)

    def expert_block(args):
        xb, e = args
        return (jax.nn.silu(xb @ w1[e]) * (xb @ w3[e])) @ w2[e]

    y = lax.map(expert_block, (xin.reshape(nb, MOE_BLOCK, d), blk_e)).reshape(n_rows, d)
    dest_assign = jnp.zeros((n_assign,), jnp.int32).at[order].set(dest)
    return jnp.einsum('tk,tkd->td', gate.astype(tokens.dtype), y[dest_assign].reshape(T, TOP_K, d))


def setup_inputs(seed: int = 0) -> dict:
    key = jax.random.key(seed)
    ks = iter(jax.random.split(key, 40))
    nrm = lambda shape, s: jax.random.normal(next(ks), shape, jnp.float32) * s
    gain = lambda shape: 1.0 + nrm(shape, 0.05)
    ne, no = (DEPTH + 1) // 2, DEPTH // 2
    D = D_MODEL
    gate_base = jnp.repeat(jnp.array([0.0, 3.0, 0.0, 3.0], jnp.float32), B_HEADS)
    return {
        "x": nrm((BATCH, SEQ, D), 1.0),
        "c": nrm((BATCH, D), 1.0),
        "ctx": nrm((BATCH, CTX_LEN, D), 1.0),
        "c_ctx": nrm((D,), 1.0),
        "w_ada": nrm((DEPTH, D, 6 * D), 0.5 * D ** -0.5),
        "b_ada": nrm((DEPTH, 6 * D), 0.01),
        "g_mix": gain((DEPTH, D)),
        "g_ffn": gain((DEPTH, D)),
        "e_w_in": nrm((ne, D, IN_EVEN), D ** -0.5),
        "e_w_out": nrm((ne, MIX_EVEN, D), MIX_EVEN ** -0.5),
        "e_g_q": gain((ne, A_HEAD_DIM)),
        "e_g_k": gain((ne, A_HEAD_DIM)),
        "e_conv_w": nrm((ne, B_CONV, 2 * B_WIDTH), B_CONV ** -0.5),
        "e_conv_b": nrm((ne, 2 * B_WIDTH), 0.01),
        "e_b_gates": gate_base + nrm((ne, 4 * B_HEADS), 0.1),
        "e_g_h": gain((ne, B_WIDTH)),
        "o_w_in": nrm((no, D, IN_ODD), D ** -0.5),
        "o_w_out": nrm((no, MIX_ODD, D), MIX_ODD ** -0.5),
        "o_g_qc": gain((no, C_HEAD_DIM)),
        "o_g_kc": gain((no, C_HEAD_DIM)),
        "o_lam": nrm((no, 4, C_HEAD_DIM), 0.1),
        "o_g_sub": gain((no, C_V_DIM)),
        "o_g_cq": gain((no, D_Q_LORA)),
        "o_w_uq": nrm((no, D_Q_LORA, D_HEADS * (D_NOPE + D_ROPE)), D_Q_LORA ** -0.5),
        "o_g_ckv": gain((no, D_KV_LORA)),
        "o_w_ukv": nrm((no, D_KV_LORA, D_HEADS * (D_NOPE + D_V_DIM)), D_KV_LORA ** -0.5),
        "o_g_qd": gain((no, D_NOPE + D_ROPE)),
        "o_g_kd": gain((no, D_NOPE + D_ROPE)),
        "w_router": nrm((D, N_EXPERTS), D ** -0.5),
        "b_router": nrm((N_EXPERTS,), 0.01),
        "w1": nrm((DEPTH, N_EXPERTS, D, D_EXPERT), D ** -0.5),
        "w3": nrm((DEPTH, N_EXPERTS, D, D_EXPERT), D ** -0.5),
        "w2": nrm((DEPTH, N_EXPERTS, D_EXPERT, D), D_EXPERT ** -0.5),
    }


def reference(x, c, ctx, c_ctx, w_ada, b_ada, g_mix, g_ffn,
              e_w_in, e_w_out, e_g_q, e_g_k, e_conv_w, e_conv_b, e_b_gates, e_g_h,
              o_w_in, o_w_out, o_g_qc, o_g_kc, o_lam, o_g_sub, o_g_cq, o_w_uq, o_g_ckv, o_w_ukv,
              o_g_qd, o_g_kd, w_router, b_router, w1, w3, w2):
    bsz, n_lat, d = x.shape
    rope_64 = axial_rope_tables(n_lat, A_HEAD_DIM)
    rope_d = axial_rope_tables(n_lat, D_ROPE)
    x_lat, x_ctx = x, ctx
    for layer in range(DEPTH):
        last = layer == DEPTH - 1
        j = layer // 2
        mod_l = jax.nn.silu(c) @ w_ada[layer] + b_ada[layer]
        mod_c = jax.nn.silu(c_ctx) @ w_ada[layer] + b_ada[layer]
        sh1, sc1, g1, sh2, sc2, g2 = [m[:, None, :] for m in jnp.split(mod_l, 6, axis=-1)]
        sh1c, sc1c, g1c, sh2c, sc2c, g2c = jnp.split(mod_c, 6, axis=-1)
        h_l = modulate(x_lat, g_mix[layer], sh1, sc1)
        h_c = modulate(x_ctx, g_mix[layer], sh1c, sc1c)
        if layer % 2 == 0:
            o_l, o_c = even_mixer(h_l, h_c, not last, e_w_in[j], e_w_out[j], e_g_q[j], e_g_k[j],
                                  e_conv_w[j], e_conv_b[j], e_b_gates[j], e_g_h[j], rope_64)
        else:
            lam_init = 0.8 - 0.6 * math.exp(-0.3 * layer)
            o_l, o_c = odd_mixer(h_l, h_c, not last, lam_init, o_w_in[j], o_w_out[j], o_g_qc[j], o_g_kc[j],
                                 o_lam[j], o_g_sub[j], o_g_cq[j], o_w_uq[j], o_g_ckv[j], o_w_ukv[j],
                                 o_g_qd[j], o_g_kd[j], rope_64, rope_d)
        x_lat = x_lat + g1 * o_l
        f_l = modulate(x_lat, g_ffn[layer], sh2, sc2).reshape(-1, d)
        if last:
            y = moe(f_l, w_router, b_router, w1[layer], w3[layer], w2[layer])
            x_lat = x_lat + g2 * y.reshape(x_lat.shape)
        else:
            x_ctx = x_ctx + g1c * o_c
            f_c = modulate(x_ctx, g_ffn[layer], sh2c, sc2c).reshape(-1, d)
            n_ctx_tok = f_c.shape[0]
            y = moe(jnp.concatenate([f_c, f_l], axis=0), w_router, b_router, w1[layer], w3[layer], w2[layer])
            x_ctx = x_ctx + g2c * y[:n_ctx_tok].reshape(x_ctx.shape)
            x_lat = x_lat + g2 * y[n_ctx_tok:].reshape(x_lat.shape)
    return x_lat
```

```cpp
#include <hip/hip_runtime.h>
#include <hip/hip_bf16.h>
#include <cstdio>
#include <cstdint>
#include <cmath>
#include <utility>

#ifndef MK_ONE_LAUNCH
#define MK_ONE_LAUNCH 1
#endif

#define GAS __attribute__((address_space(1)))
#define LAS __attribute__((address_space(3)))
typedef unsigned short bf16_t;
typedef short bf16x8 __attribute__((ext_vector_type(8)));
typedef short s16x4 __attribute__((ext_vector_type(4)));
typedef float f32x4 __attribute__((ext_vector_type(4)));
typedef float f32x2 __attribute__((ext_vector_type(2)));
typedef float f32x16 __attribute__((ext_vector_type(16)));
typedef unsigned u32x4 __attribute__((ext_vector_type(4)));
typedef unsigned u32x2 __attribute__((ext_vector_type(2)));

constexpr int D = 1024, BATCH = 2, SEQ = 16384, CTX = 256, GRIDW = 64;
constexpr int TL = BATCH * SEQ, TC = BATCH * CTX, NROW = TL + TC;
constexpr int SKV = CTX + SEQ;
constexpr int NZE = 2816, NZO = 2048;
constexpr int IN_EVEN = 2832, IN_ODD = 1952;
constexpr int NE = 32, DEXP = 512;
constexpr int MOE_MAXBLK = 292, MOE_MAXROWS = MOE_MAXBLK * 256;
constexpr float EPS = 1e-6f;
constexpr float LOG2E = 1.4426950408889634f;
constexpr int NCHUNK = 130, NCHAIN = 16;

constexpr size_t MiB = 1u << 20;
constexpr size_t WS_CTL = 0, CTL_ZERO_BYTES = 1 * MiB;
constexpr size_t WS_MODP = 1 * MiB;
constexpr size_t WS_MOD = 3 * MiB;
constexpr size_t WS_G = 4 * MiB;
constexpr size_t WS_RT = 7 * MiB;
constexpr size_t WS_BLKE = 9 * MiB;
constexpr size_t WS_ML = 10 * MiB;
constexpr size_t WS_ROPE64 = WS_BLKE + 512 * 1024, WS_ROPED = WS_ROPE64 + 64 * 1024;
constexpr size_t WS_WSM = 12 * MiB;
constexpr size_t WS_X = 26 * MiB;
constexpr size_t WS_HMF = 156 * MiB;
constexpr size_t WS_RA = 221 * MiB;
constexpr size_t WS_RB = 400 * MiB;
constexpr size_t WS_RC = 465 * MiB;
constexpr size_t WS_END = 538 * MiB;
#ifndef A8_ENABLE
#define A8_ENABLE 1
#endif
#ifndef A8_DEBUG
#define A8_DEBUG 0
#endif
constexpr size_t WS_DBG = 538 * MiB;
constexpr int NTILE = SKV / 64;
constexpr size_t F8_EQ = A8_DEBUG == 1 ? WS_DBG : WS_RB, F8_EK = A8_DEBUG == 1 ? WS_DBG + 16 * MiB : WS_RB + 32 * MiB, F8_EV = A8_DEBUG == 1 ? WS_DBG + 21 * MiB : WS_RB + 50 * MiB,
                 F8_EQC = A8_DEBUG == 1 ? WS_DBG + 26 * MiB : WS_RB + 49 * MiB;
constexpr size_t F8_CQ = WS_RB, F8_CK = WS_RB + 32 * MiB, F8_CV = WS_RB + 48 * MiB + 512 * 1024;
constexpr size_t F8_DQ = A8_DEBUG == 3 ? WS_DBG : WS_RA + 82 * MiB, F8_DK = A8_DEBUG == 3 ? WS_DBG + 16 * MiB : WS_RA + 106 * MiB, F8_DV = A8_DEBUG == 3 ? WS_DBG + 33 * MiB : WS_RC + 33 * MiB;
constexpr size_t WS_NEED = A8_DEBUG ? WS_DBG + 50 * MiB : WS_END;
constexpr int CW_MOEC = 24576;
constexpr int CW_CHK = 20000;
constexpr size_t WO_WINE = 0, WO_WINO = WO_WINE + (size_t)NZE * D * 2, WO_WOUTE = WO_WINO + (size_t)NZO * D * 2, WO_WOUTO = WO_WOUTE + (size_t)D * D * 2,
                 WO_WUQ = WO_WOUTO + (size_t)D * D * 2, WO_WUKV = WO_WUQ + (size_t)512 * 256 * 2, WO_END = WO_WUKV + (size_t)768 * 128 * 2;
static_assert(WO_END <= 14 * MiB, "small weights");
constexpr int CW_BAR = 4096;
constexpr int CW_CNT0 = 16384, CW_CNT1 = 16384 + 64;
constexpr size_t RT_E = 0, RT_POS = (size_t)NROW * 2 * 4, RT_GATE = 2 * RT_POS, RT_DEST = 3 * RT_POS;
constexpr size_t ML_BL = 0, ML_ML = 16384, ML_MS = 32768, ML_NL = 65536;

constexpr int LDS_BYTES = 163840;
constexpr int MISC_OFF = LDS_BYTES - 1024;
constexpr int ARGS_OFF = MISC_OFF + 256;

__device__ __forceinline__ unsigned f2bf(float f) { unsigned u = __builtin_bit_cast(unsigned, f); return (u + 0x7fffu + ((u >> 16) & 1u)) >> 16; }
typedef __bf16 bf16x2_t __attribute__((ext_vector_type(2)));
__device__ __forceinline__ unsigned pk2(float lo, float hi) { f32x2 v = {lo, hi}; bf16x2_t b = __builtin_convertvector(v, bf16x2_t); return __builtin_bit_cast(unsigned, b); }
__device__ __forceinline__ float bf2f(unsigned short b) { return __builtin_bit_cast(float, (unsigned)b << 16); }
__device__ __forceinline__ float bflo(unsigned w) { return __builtin_bit_cast(float, w << 16); }
__device__ __forceinline__ float bfhi(unsigned w) { return __builtin_bit_cast(float, w & 0xffff0000u); }
__device__ __forceinline__ unsigned cvt_pk_bf16(float lo, float hi) { unsigned r; asm volatile("v_cvt_pk_bf16_f32 %0, %1, %2" : "=v"(r) : "v"(lo), "v"(hi)); return r; }
template <int O> __device__ __forceinline__ float xshfl(float v) {
#ifdef TEST_HIP_XSHFL
    return __shfl_xor(v, O);
#endif
    if constexpr (O < 32) return __builtin_bit_cast(float, __builtin_amdgcn_ds_swizzle(__builtin_bit_cast(int, v), (O << 10) | 0x1f));
    else { auto rr = __builtin_amdgcn_permlane32_swap(__float_as_uint(v), __float_as_uint(v), false, false);
           unsigned ones = ~0u; const bool lo = __builtin_amdgcn_mbcnt_hi(ones, __builtin_amdgcn_mbcnt_lo(ones, 0u)) < 32u; return __uint_as_float(lo ? rr[1] : rr[0]); }
}
#define DPPX(v, ctrl) __builtin_bit_cast(float, __builtin_amdgcn_update_dpp(0, __builtin_bit_cast(int, (float)(v)), (ctrl), 0xf, 0xf, false))
__device__ __forceinline__ float dpp_x1(float v) { return DPPX(v, 0xB1); }
__device__ __forceinline__ float dpp_x2(float v) { return DPPX(v, 0x4E); }
__device__ __forceinline__ float dpp_x7(float v) { return DPPX(v, 0x141); }
__device__ __forceinline__ float dpp_x15(float v) { return DPPX(v, 0x140); }
__device__ __forceinline__ float xsum32(float v) { auto rr = __builtin_amdgcn_permlane32_swap(__float_as_uint(v), __float_as_uint(v), false, false); return __uint_as_float(rr[0]) + __uint_as_float(rr[1]); }
__device__ __forceinline__ float xmax32(float v) { auto rr = __builtin_amdgcn_permlane32_swap(__float_as_uint(v), __float_as_uint(v), false, false); return fmaxf(__uint_as_float(rr[0]), __uint_as_float(rr[1])); }
__device__ __forceinline__ float wave_sum(float v) {
    v += dpp_x1(v); v += dpp_x2(v); v += dpp_x7(v); v += dpp_x15(v); v += xshfl<16>(v); return xsum32(v);
}
__device__ __forceinline__ float wave_max(float v) {
    v = fmaxf(v, dpp_x1(v)); v = fmaxf(v, dpp_x2(v)); v = fmaxf(v, dpp_x7(v)); v = fmaxf(v, dpp_x15(v)); v = fmaxf(v, xshfl<16>(v)); return xmax32(v);
}
__device__ __forceinline__ float rdlane(float v, int l) { return __builtin_bit_cast(float, __builtin_amdgcn_readlane(__builtin_bit_cast(int, v), l)); }
#define DPPF(oldv, v, ctrl, rm) __builtin_bit_cast(float, __builtin_amdgcn_update_dpp(__builtin_bit_cast(int, (float)(oldv)), __builtin_bit_cast(int, (float)(v)), (ctrl), (rm), 0xf, false))
__device__ __forceinline__ float siluf(float x) { return x * __builtin_amdgcn_rcpf(1.f + __expf(-x)); }
__device__ __forceinline__ float sigmoidf_(float x) { return __builtin_amdgcn_rcpf(1.f + __expf(-x)); }
__device__ __forceinline__ float logsigmoidf_(float x) { return fminf(x, 0.f) - log1pf(__expf(-fabsf(x))); }
#define LDS_WAIT() asm volatile("s_waitcnt lgkmcnt(0)" ::: "memory")
#define VM_WAIT() asm volatile("s_waitcnt vmcnt(0)" ::: "memory")
__device__ __forceinline__ void unpack8(const u32x4 w, float* f) {
    f[0] = bflo(w.x); f[1] = bfhi(w.x); f[2] = bflo(w.y); f[3] = bfhi(w.y); f[4] = bflo(w.z); f[5] = bfhi(w.z); f[6] = bflo(w.w); f[7] = bfhi(w.w);
}
__device__ __forceinline__ u32x4 pack8(const float* f) { u32x4 w; w.x = pk2(f[0], f[1]); w.y = pk2(f[2], f[3]); w.z = pk2(f[4], f[5]); w.w = pk2(f[6], f[7]); return w; }

__device__ __forceinline__ f32x4 bf4_to_f32(const u32x2 w) { f32x4 r; r.x = bflo(w.x); r.y = bfhi(w.x); r.z = bflo(w.y); r.w = bfhi(w.y); return r; }
__device__ __forceinline__ u32x2 f32_to_bf4(const f32x4 v) { u32x2 w; w.x = pk2(v.x, v.y); w.y = pk2(v.z, v.w); return w; }
__device__ __forceinline__ int mk_tid(int wave) {
    unsigned ones = ~0u; asm volatile("" : "+s"(ones), "+s"(wave));
    int tid = wave * 64 + (int)__builtin_amdgcn_mbcnt_hi(ones, __builtin_amdgcn_mbcnt_lo(ones, 0u));
    asm volatile("" : "+v"(tid));
    return tid;
}
#define XB_TMO      128
#define XB_XCNT(j)  (256  + 64 * (j))
#define XB_XSUB(j)  (1280 + 64 * (j))
#define XB_XGEN(j)  (2304 + 64 * (j))
#define XB_TOP      3328
#define XB_TOPGEN   3392
#define XCD_BAR_WORDS 3456
#define XB_SPIN_CAP (1u << 18)
__device__ __forceinline__ unsigned xb_ld(unsigned* p)              { return __hip_atomic_load(p, __ATOMIC_RELAXED, __HIP_MEMORY_SCOPE_AGENT); }
__device__ __forceinline__ unsigned xb_add(unsigned* p, unsigned v) { return __hip_atomic_fetch_add(p, v, __ATOMIC_RELAXED, __HIP_MEMORY_SCOPE_AGENT); }
__device__ __forceinline__ unsigned xb_xcc_id() { return (unsigned)__builtin_amdgcn_s_getreg((3 << 11) | 20) & 0xFu; }
#define XB_SPIN(cond, bar) do { unsigned _sp = 0; while (cond) { __builtin_amdgcn_s_sleep(1); \
    if ((++_sp & 255u) == 0u) { if (xb_ld(&(bar)[XB_TMO])) break; if (_sp > XB_SPIN_CAP) { atomicAdd(&(bar)[XB_TMO], 1u); break; } } } } while (0)
struct XcdBarrier { unsigned* bar; unsigned x; volatile LAS unsigned* st; };
__device__ __forceinline__ XcdBarrier xcd_barrier_post(unsigned* bar, volatile LAS unsigned* st, int tid0) {
    XcdBarrier b; b.bar = bar; b.x = xb_xcc_id(); b.st = st;
    if (tid0 == 0) (void)xb_add(&bar[XB_XCNT(b.x)], 1u);
    return b;
}
__device__ __forceinline__ void xcd_barrier_complete(unsigned* bar, unsigned x, unsigned& nloc, unsigned& nx) {
    const unsigned G = gridDim.x * gridDim.y * gridDim.z;
    unsigned sum, cnt, mine, sp = 0u;
    for (;;) {
        sum = 0u; cnt = 0u; mine = 0u;
#pragma unroll
        for (unsigned j = 0; j < 16; ++j) { const unsigned c = xb_ld(&bar[XB_XCNT(j)]); sum += c; cnt += (c > 0u) ? 1u : 0u; mine = (j == x) ? c : mine; }
        if (sum == G) break;
        __builtin_amdgcn_s_sleep(1);
        if ((++sp & 255u) == 0u) { if (xb_ld(&bar[XB_TMO])) break; if (sp > XB_SPIN_CAP) { atomicAdd(&bar[XB_TMO], 1u); break; } }
    }
    nloc = mine > 0u ? mine : 1u; nx = cnt > 0u ? cnt : 1u;
}
__device__ __forceinline__ void xcd_barrier(const XcdBarrier& b, int tid0) {
    asm volatile("s_waitcnt vmcnt(0)" ::: "memory");
    __syncthreads();
    if (tid0 == 0) {
        unsigned* bar = b.bar;
        __builtin_amdgcn_s_waitcnt(0);
        unsigned nloc = b.st[0], nx = b.st[1];
        if (nloc == 0u) { xcd_barrier_complete(bar, b.x, nloc, nx); b.st[0] = nloc; b.st[1] = nx; }
        const unsigned old = xb_add(&bar[XB_XSUB(b.x)], 1u);
        const unsigned gen = old / nloc;
        if (old + 1u == (gen + 1u) * nloc) {
            __builtin_amdgcn_fence(__ATOMIC_RELEASE, "agent");
            asm volatile("s_waitcnt vmcnt(0)" ::: "memory");
            const unsigned og = xb_add(&bar[XB_TOP], 1u);
            const unsigned tg = og / nx;
            if (og + 1u == (tg + 1u) * nx) xb_add(&bar[XB_TOPGEN], 1u);
            else XB_SPIN(xb_ld(&bar[XB_TOPGEN]) == tg, bar);
            __builtin_amdgcn_fence(__ATOMIC_ACQUIRE, "agent");
            xb_add(&bar[XB_XGEN(b.x)], 1u);
            asm volatile("s_waitcnt vmcnt(0)" ::: "memory");
        } else {
            XB_SPIN(xb_ld(&bar[XB_XGEN(b.x)]) == gen, bar);
            __builtin_amdgcn_fence(__ATOMIC_ACQUIRE, "agent");
            asm volatile("s_waitcnt vmcnt(0)" ::: "memory");
        }
    }
    __syncthreads();
}

namespace pg8 {
constexpr int BM = 256, BK = 64, HALF = 128, HTB = HALF * BK * 2, STAGE_BYTES = 8 * HTB, NXCD = 8, WGM = 8;
__host__ __device__ __forceinline__ int lds_byte(int r, int c) { const int st = (r >> 4) * 2 + (c >> 5), rr = r & 15, cc = c & 31, ob = rr * 64 + cc * 2; return st * 1024 + (ob ^ (((ob >> 9) & 1) << 5)); }
__host__ __device__ __forceinline__ void stage_rc(int b, int& R, int& C) { const int st = b / 1024, sb = b % 1024, swz = sb ^ (((sb >> 9) & 1) << 5); R = (st >> 1) * 16 + swz / 64; C = (st & 1) * 32 + (swz % 64) / 2; }
__host__ __device__ __forceinline__ int perm32(int rho) { const int n = rho >> 4, i = rho & 15; return 8 * (i >> 2) + 4 * n + (i & 3); }
struct Unit { int pm, pn; };
struct Gemm { const bf16_t* A; const bf16_t* Bt; int M, N, K; };
struct StaticOrder {
    int nM, nN, nwg, G, c;
    __device__ void init(int M, int N, int G_, int c_) { nM = M / BM; nN = N / BM; nwg = nM * nN; G = G_; c = c_; }
    __device__ bool next(int i, Unit& u) const {
        const long L = (long)i * G + c; if (L >= nwg) return false;
        int wgid = (int)L; { const int q = nwg / NXCD, r = nwg % NXCD, xcd = wgid % NXCD, off = wgid / NXCD; wgid = (xcd < r ? xcd * (q + 1) : r * (q + 1) + (xcd - r) * q) + off; }
        const int nig = WGM * nN, gid = wgid / nig, fm = gid * WGM, gsz = (nM - fm) < WGM ? (nM - fm) : WGM;
        u.pm = fm + ((wgid % nig) % gsz); u.pn = (wgid % nig) / gsz; return true;
    }
    __device__ __forceinline__ size_t b_off(const Unit&) const { return 0; }
    __device__ __forceinline__ void done(const Unit&, int) const {}
};
struct MoeOrder {
    const int* blk_e; int nunits, nN, G, c; size_t estride; unsigned* cnt = nullptr; int mode = 0;
    __device__ bool next(int i, Unit& u) const {
        const int cc = (mode == 2) ? (c + nunits % G) % G : c;
        const long L = (long)i * G + cc; if (L >= nunits) return false; u.pm = (int)(L / nN); u.pn = (int)(L % nN);
        if (mode == 2) { unsigned sp = 0; while (__hip_atomic_load(&cnt[u.pm], __ATOMIC_RELAXED, __HIP_MEMORY_SCOPE_AGENT) < 8u * (unsigned)nN) { __builtin_amdgcn_s_sleep(2); if (++sp > (1u << 22)) break; }
            asm volatile("" ::: "memory"); }
        return true; }
    __device__ __forceinline__ size_t b_off(const Unit& u) const { return (size_t)blk_e[u.pm] * estride; }
    __device__ __forceinline__ void done(const Unit& u, int lane) const { if (mode == 1 && lane == 0) (void)__hip_atomic_fetch_add(&cnt[u.pm], 1u, __ATOMIC_RELAXED, __HIP_MEMORY_SCOPE_AGENT); }
};

struct EpiStoreBf16 {
    static constexpr bool PERM = true;
    bf16_t* O; int ldc; int row_off;
    __device__ __forceinline__ void operator()(const f32x4 (&acc)[2][2][4][2], const Unit& u, int wr, int wc, int fr, int fq) const {
        const int row0 = row_off + u.pm * BM + wr * 64 + fr, col0 = u.pn * BM + wc * 32 + 8 * fq;
#pragma unroll
        for (int ai = 0; ai < 2; ++ai)
#pragma unroll
            for (int m = 0; m < 4; ++m) { bf16_t* rowp = O + (size_t)(row0 + ai * HALF + m * 16) * ldc + col0;
#pragma unroll
                for (int bj = 0; bj < 2; ++bj) { const f32x4 v0 = acc[ai][bj][m][0], v1 = acc[ai][bj][m][1];
                    u32x4 w; w.x = cvt_pk_bf16(v0[0], v0[1]); w.y = cvt_pk_bf16(v0[2], v0[3]); w.z = cvt_pk_bf16(v1[0], v1[1]); w.w = cvt_pk_bf16(v1[2], v1[3]);
                    *(u32x4*)(rowp + bj * HALF) = w; } }
    }
};
struct EpiSwiGLU {
    static constexpr bool PERM = false;
    bf16_t* O; int ldc;
    __device__ __forceinline__ void operator()(const f32x4 (&acc)[2][2][4][2], const Unit& u, int wr, int wc, int fr, int fq) const {
        const int row0 = u.pm * BM + wr * 64 + fr, colh = (u.pn * BM + wc * 32) / 2 + 4 * fq;
#pragma unroll
        for (int ai = 0; ai < 2; ++ai)
#pragma unroll
            for (int m = 0; m < 4; ++m) { bf16_t* rowp = O + (size_t)(row0 + ai * HALF + m * 16) * ldc + colh;
#pragma unroll
                for (int bj = 0; bj < 2; ++bj) { const f32x4 a = acc[ai][bj][m][0], b = acc[ai][bj][m][1];
                    u32x2 w; w.x = cvt_pk_bf16(siluf(a[0]) * b[0], siluf(a[1]) * b[1]); w.y = cvt_pk_bf16(siluf(a[2]) * b[2], siluf(a[3]) * b[3]);
                    asm volatile("global_store_dwordx2 %0, %1, off sc0 sc1" :: "v"(rowp + bj * (HALF / 2)), "v"(w) : "memory"); } }
    }
};
struct EpiResid {
    static constexpr bool PERM = false;
    const float* x_lat; const float* x_ctx; bf16_t* X; const float* gate;
    int row_off; int inplace;
    __device__ __forceinline__ void operator()(const f32x4 (&acc)[2][2][4][2], const Unit& u, int wr, int wc, int fr, int fq) const {
        const int row0 = row_off + u.pm * BM + wr * 64 + fr, col0 = u.pn * BM + wc * 32 + 4 * fq;
#pragma unroll
        for (int ai = 0; ai < 2; ++ai)
#pragma unroll
            for (int m = 0; m < 4; ++m) { const int row = row0 + ai * HALF + m * 16;
                const int bsel = row < TC ? 2 : (row - TC) / SEQ;
                const float* xin = row < TC ? x_ctx + (size_t)row * D : x_lat + (size_t)(row - TC) * D;
                const float* gp = gate + bsel * 6144;
#pragma unroll
                for (int bj = 0; bj < 2; ++bj)
#pragma unroll
                    for (int n = 0; n < 2; ++n) { const int col = col0 + bj * HALF + n * 16;
                        const f32x4 xv = inplace ? bf4_to_f32(*(const u32x2*)(X + (size_t)row * D + col)) : *(const f32x4*)(xin + col), gv = *(const f32x4*)(gp + col);
                        *(u32x2*)(X + (size_t)row * D + col) = f32_to_bf4(xv + gv * acc[ai][bj][m][n]); } }
    }
};

template <class Epi, class Sched, bool ALIGN_EPI = true, bool GATHER = false>
__device__ __forceinline__ void gemm_phase(LAS unsigned char* lds, const Gemm g, const Sched& S, const Epi& E, int wv, const int* rowtab = nullptr) {
    const int tid = mk_tid(wv);
    const int wid = __builtin_amdgcn_readfirstlane(tid >> 6), lane = tid & 63, wr = wid >> 2, wc = wid & 3, fr = lane & 15, fq = lane >> 4;
    const int K = g.K, nt = K / BK;
    const size_t kstep = (size_t)(BK * 2);
    const size_t hstep = (size_t)HALF * K * 2;
    const size_t tstep = 2 * hstep;
    int RA_[2], CA_[2]; unsigned vA[2][2], nvA[2][2], voffB[2];
#pragma unroll
    for (int i = 0; i < 2; ++i) { int R, C; stage_rc(tid * 16 + i * 8192, R, C); const int Rb = Epi::PERM ? ((R & ~31) + perm32(R & 31)) : R;
        RA_[i] = R; CA_[i] = C; voffB[i] = (unsigned)(Rb * K + C) * 2u;
        vA[0][i] = (unsigned)(R * K + C) * 2u; vA[1][i] = vA[0][i] + (unsigned)hstep; nvA[0][i] = vA[0][i]; nvA[1][i] = vA[1][i]; }
#define PG8_GVOFF(V, u) do { if constexpr (GATHER) { _Pragma("unroll") for (int h_ = 0; h_ < 2; ++h_) _Pragma("unroll") for (int i_ = 0; i_ < 2; ++i_) \
        V[h_][i_] = (unsigned)(rowtab[(u).pm * BM + h_ * HALF + RA_[i_]] * K + CA_[i_]) * 2u; } } while (0)
    const unsigned ldsw = (unsigned)wid * 1024u;
    const int aoff = lds_byte(wr * 64 + fr, fq * 8), boff = lds_byte(wc * 32 + fr, fq * 8);
#define PG8_SA(b, h) (((b) * 2 + (h)) * HTB)
#define PG8_SB(b, h) ((4 + (b) * 2 + (h)) * HTB)
#define PG8_STAGE(bufoff, gbase, voff) do { _Pragma("unroll") for (int _i = 0; _i < 2; ++_i) \
        __builtin_amdgcn_global_load_lds((const unsigned*)((const char*)(gbase) + (voff)[_i]), (LAS unsigned*)(lds + (bufoff) + ldsw + _i * 8192), 16, 0, 0); } while (0)
#define PG8_STAGE_SEL(bufoff, gbase, sel, v1, v0) do { _Pragma("unroll") for (int _i = 0; _i < 2; ++_i) \
        __builtin_amdgcn_global_load_lds((const unsigned*)((const char*)(gbase) + ((sel) ? (v1)[_i] : (v0)[_i])), (LAS unsigned*)(lds + (bufoff) + ldsw + _i * 8192), 16, 0, 0); } while (0)
#define PG8_LDA(dst, b, h) do { _Pragma("unroll") for (int m = 0; m < 4; ++m) _Pragma("unroll") for (int k = 0; k < 2; ++k) dst[m][k] = *(const LAS bf16x8*)(lds + PG8_SA(b, h) + aoff + m * 2048 + k * 1024); } while (0)
#define PG8_LDB(dst, b, h) do { _Pragma("unroll") for (int n = 0; n < 2; ++n) _Pragma("unroll") for (int k = 0; k < 2; ++k) dst[n][k] = *(const LAS bf16x8*)(lds + PG8_SB(b, h) + boff + n * 2048 + k * 1024); } while (0)
#define PG8_MMA(ai, bj, At, Bt) do { __builtin_amdgcn_s_setprio(1); _Pragma("unroll") for (int m = 0; m < 4; ++m) _Pragma("unroll") for (int n = 0; n < 2; ++n) _Pragma("unroll") for (int k = 0; k < 2; ++k) \
        acc[ai][bj][m][n] = __builtin_amdgcn_mfma_f32_16x16x32_bf16(Bt[n][k], At[m][k], acc[ai][bj][m][n], 0, 0, 0); __builtin_amdgcn_s_setprio(0); } while (0)
#define PG8_WAIT_V(n) asm volatile("s_waitcnt vmcnt(" #n ")" ::: "memory")
#define PG8_WAIT_L(n) asm volatile("s_waitcnt lgkmcnt(" #n ")" ::: "memory")
#define PG8_BAR __builtin_amdgcn_s_barrier()
#define PG8_SCHED __builtin_amdgcn_sched_barrier(0)
    Unit cur, nxt, prv; int ui = 0;
    if (!S.next(0, cur)) return;
    prv = cur;
    f32x4 acc[2][2][4][2];
#pragma unroll
    for (int a = 0; a < 2; ++a)
#pragma unroll
        for (int b = 0; b < 2; ++b)
#pragma unroll
            for (int m = 0; m < 4; ++m)
#pragma unroll
                for (int n = 0; n < 2; ++n) acc[a][b][m][n] = (f32x4){0.f, 0.f, 0.f, 0.f};
    bf16x8 At[4][2], B0[2][2], B1[2][2];
    const char* cA = (const char*)g.A + (GATHER ? (size_t)0 : (size_t)cur.pm * tstep); const char* cB = (const char*)g.Bt + S.b_off(cur) + (size_t)cur.pn * tstep;
    PG8_GVOFF(vA, cur);
    PG8_STAGE(PG8_SB(0, 0), cB, voffB); PG8_STAGE(PG8_SB(0, 1), cB + hstep, voffB); PG8_STAGE(PG8_SA(0, 0), cA, vA[0]); PG8_STAGE(PG8_SA(0, 1), cA, vA[1]);
    if (wr == 1) PG8_BAR;
    PG8_WAIT_V(2); PG8_BAR;
    PG8_STAGE(PG8_SB(1, 0), cB + kstep, voffB); PG8_STAGE(PG8_SA(1, 0), cA + kstep, vA[0]); PG8_STAGE(PG8_SB(1, 1), cB + hstep + kstep, voffB);
    PG8_WAIT_V(6); PG8_BAR;
    for (;;) {
        const bool has_next = S.next(ui + 1, nxt);
        const char* nA = has_next ? (const char*)g.A + (GATHER ? (size_t)0 : (size_t)nxt.pm * tstep) : cA; const char* nB = has_next ? (const char*)g.Bt + S.b_off(nxt) + (size_t)nxt.pn * tstep : cB;
        if constexpr (GATHER) { if (has_next) { PG8_GVOFF(nvA, nxt); } else {
#pragma unroll
            for (int h_ = 0; h_ < 2; ++h_)
#pragma unroll
                for (int i_ = 0; i_ < 2; ++i_) nvA[h_][i_] = vA[h_][i_]; } }
        for (int t = 0; t < nt; t += 2) {
            const bool last = (t == nt - 2);
            const char* a1 = cA + (size_t)(t + 1) * kstep;
            const char* a2 = last ? nA : cA + (size_t)(t + 2) * kstep; const char* b2 = last ? nB : cB + (size_t)(t + 2) * kstep;
            const char* a3 = a2 + kstep; const char* b3 = b2 + kstep;
            PG8_LDB(B0, 0, 0); PG8_LDB(B1, 0, 1); PG8_SCHED; PG8_LDA(At, 0, 0); PG8_STAGE(PG8_SA(1, 1), a1, vA[1]);
            PG8_WAIT_V(8); PG8_WAIT_L(0); PG8_BAR; PG8_MMA(0, 0, At, B0); PG8_MMA(0, 1, At, B1); PG8_BAR; PG8_SCHED;
            PG8_LDA(At, 0, 1); PG8_STAGE(PG8_SB(0, 0), b2, voffB); PG8_STAGE(PG8_SB(0, 1), b2 + hstep, voffB); PG8_STAGE_SEL(PG8_SA(0, 0), a2, last, nvA[0], vA[0]);
            PG8_WAIT_V(8); PG8_WAIT_L(0); PG8_BAR; PG8_MMA(1, 0, At, B0); PG8_MMA(1, 1, At, B1); PG8_BAR; PG8_SCHED;
            PG8_LDB(B0, 1, 0); PG8_LDB(B1, 1, 1); PG8_SCHED; PG8_LDA(At, 1, 0); PG8_STAGE_SEL(PG8_SA(0, 1), a2, last, nvA[1], vA[1]);
            PG8_WAIT_V(8); PG8_WAIT_L(0); PG8_BAR; PG8_MMA(0, 0, At, B0); PG8_MMA(0, 1, At, B1); PG8_BAR; PG8_SCHED;
            PG8_LDA(At, 1, 1); PG8_STAGE(PG8_SB(1, 0), b3, voffB); PG8_STAGE(PG8_SB(1, 1), b3 + hstep, voffB); PG8_STAGE_SEL(PG8_SA(1, 0), a3, last, nvA[0], vA[0]);
            PG8_WAIT_V(8); PG8_WAIT_L(0); PG8_BAR; PG8_MMA(1, 0, At, B0); PG8_MMA(1, 1, At, B1); PG8_BAR; PG8_SCHED;
        }
        if constexpr (ALIGN_EPI) { if (wr == 0) PG8_BAR; }
        if (ui > 0) S.done(prv, lane);
        E(acc, cur, wr, wc, fr, fq);
        prv = cur;
        if (!has_next) break;
#pragma unroll
        for (int a = 0; a < 2; ++a)
#pragma unroll
            for (int b = 0; b < 2; ++b)
#pragma unroll
                for (int m = 0; m < 4; ++m)
#pragma unroll
                    for (int n = 0; n < 2; ++n) acc[a][b][m][n] = (f32x4){0.f, 0.f, 0.f, 0.f};
        cur = nxt; cA = nA; cB = nB; ++ui;
        if constexpr (GATHER) {
#pragma unroll
            for (int h_ = 0; h_ < 2; ++h_)
#pragma unroll
                for (int i_ = 0; i_ < 2; ++i_) vA[h_][i_] = nvA[h_][i_]; }
        if constexpr (ALIGN_EPI) { if (wr == 1) PG8_BAR; }
    }
    PG8_WAIT_V(0);
    S.done(prv, lane);
    if constexpr (!ALIGN_EPI) { if (wr == 0) PG8_BAR; }
    PG8_BAR;
#undef PG8_GVOFF
#undef PG8_SA
#undef PG8_SB
#undef PG8_STAGE
#undef PG8_STAGE_SEL
#undef PG8_LDA
#undef PG8_LDB
#undef PG8_MMA
#undef PG8_WAIT_V
#undef PG8_WAIT_L
#undef PG8_BAR
#undef PG8_SCHED
}
}

template <int NB, class F>
__device__ __forceinline__ void ctx_tile_gemm(LAS unsigned char* lds, const bf16_t* __restrict__ A, const bf16_t* __restrict__ Bt, const int row0, const int col0, int wv, const F& epi) {
    const int tid = mk_tid(wv); const int lane = tid & 63, r32 = lane & 31, hi = lane >> 5; const int wid = __builtin_amdgcn_readfirstlane(tid >> 6);
    const bf16_t* ap = A + (size_t)(row0 + r32) * D + wid * 128 + 8 * hi;
    const bf16_t* bp = Bt + (size_t)(col0 + r32) * D + wid * 128 + 8 * hi;
    bf16x8 a0[8], a1[8], bb[NB][8];
#pragma unroll
    for (int ks = 0; ks < 8; ++ks) { a0[ks] = *(const bf16x8*)(ap + 16 * ks); a1[ks] = *(const bf16x8*)(ap + (size_t)32 * D + 16 * ks);
#pragma unroll
        for (int n = 0; n < NB; ++n) bb[n][ks] = *(const bf16x8*)(bp + (size_t)(32 * n) * D + 16 * ks); }
    f32x16 acc[2][NB];
#pragma unroll
    for (int m = 0; m < 2; ++m)
#pragma unroll
        for (int n = 0; n < NB; ++n) acc[m][n] = f32x16{};
#pragma unroll
    for (int ks = 0; ks < 8; ++ks)
#pragma unroll
        for (int n = 0; n < NB; ++n) { acc[0][n] = __builtin_amdgcn_mfma_f32_32x32x16_bf16(a0[ks], bb[n][ks], acc[0][n], 0, 0, 0); acc[1][n] = __builtin_amdgcn_mfma_f32_32x32x16_bf16(a1[ks], bb[n][ks], acc[1][n], 0, 0, 0); }
    constexpr int TW = 32 * NB;
    LAS float* part = (LAS float*)lds + wid * (64 * TW);
#pragma unroll
    for (int r = 0; r < 16; ++r) { const int row = (r & 3) + 8 * (r >> 2) + 4 * hi;
#pragma unroll
        for (int n = 0; n < NB; ++n) { part[row * TW + 32 * n + r32] = acc[0][n][r]; part[(32 + row) * TW + 32 * n + r32] = acc[1][n][r]; } }
    __syncthreads();
#pragma unroll
    for (int q = 0; q < NB; ++q) { const int o4 = tid + 512 * q;
      const LAS f32x4* p4 = (const LAS f32x4*)lds + o4;
      f32x4 v = p4[0];
#pragma unroll
      for (int w = 1; w < 8; ++w) v = v + p4[w * (16 * TW)];
      epi(row0 + o4 / (TW / 4), col0 + 4 * (o4 % (TW / 4)), v); }
    __syncthreads();
}

namespace att {
#define SBAR() __builtin_amdgcn_sched_barrier(0)
__device__ __forceinline__ int crow(int r, int hi) { return (r & 3) + 8 * (r >> 2) + 4 * hi; }
constexpr float THR = 8.f;
template <int DQK> struct KT {
    static constexpr int ROWB = (DQK == 64) ? 128 : 256;
    static constexpr int BYTES = 64 * ROWB;
    __device__ static __forceinline__ int swz(int row, int colB) { return row * ROWB + (colB ^ ((DQK == 64) ? (((row >> 1) & 7) << 4) : ((row & 15) << 4))); }
};
template <int DV> struct VT {
    static constexpr int NCB = DV / 32;
    static constexpr int BYTES = 64 * DV * 2;
    __device__ static __forceinline__ int v_st(int k, int c) { const int kk = (k & ~0xC) | ((k & 4) << 1) | ((k & 8) >> 1); return ((kk >> 3) * NCB + (c >> 5)) * 512 + ((kk & 7) * 32 + (c & 31)) * 2; }
    static constexpr int rd_off(int d0, int ks, int half) { return d0 * 512 + ks * (NCB * 1024) + half * (NCB * 512); }
};
__device__ __forceinline__ int v_rd_base(int lane) { return ((lane & 3) << 3) | (((lane >> 2) & 3) << 6) | (((lane >> 4) & 1) << 5) | (((lane >> 5) & 1) << 8); }
template <int OFF> __device__ __forceinline__ s16x4 tr_read(int vb) {
    s16x4 r; asm volatile("ds_read_b64_tr_b16 %0, %1 offset:%2" : "=&v"(r) : "v"(vb), "i"(OFF) : "memory"); return r;
}
__device__ __forceinline__ void partialSM(f32x16& p0, f32x16& p1, float& m_reg, float& alpha) {
    float pmax = p0[0];
#pragma unroll
    for (int r = 1; r < 16; ++r) pmax = fmaxf(pmax, p0[r]);
#pragma unroll
    for (int r = 0; r < 16; ++r) pmax = fmaxf(pmax, p1[r]);
    { auto rr = __builtin_amdgcn_permlane32_swap(__float_as_uint(pmax), __float_as_uint(pmax), false, false);
      pmax = fmaxf(__uint_as_float(rr[0]), __uint_as_float(rr[1])); }
    float mn;
    if (__builtin_expect(__all(pmax - m_reg <= THR), 1)) { mn = m_reg; alpha = 1.f; }
    else { mn = fmaxf(m_reg, pmax); alpha = __builtin_amdgcn_exp2f(m_reg - mn); m_reg = mn; }
#pragma unroll
    for (int r = 0; r < 16; ++r) p0[r] = p0[r] - mn;
#pragma unroll
    for (int r = 0; r < 16; ++r) p1[r] = p1[r] - mn;
#pragma unroll
    for (int r = 0; r < 16; ++r) p0[r] = __builtin_amdgcn_exp2f(p0[r]);
}
__device__ __forceinline__ void finishSM(f32x16& p0, f32x16& p1, float alpha, float& l_reg, bf16x8& pa0, bf16x8& pa1, bf16x8& pa2, bf16x8& pa3) {
#pragma unroll
    for (int r = 0; r < 16; ++r) p1[r] = __builtin_amdgcn_exp2f(p1[r]);
    float ps = 0;
#pragma unroll
    for (int r = 0; r < 16; ++r) ps += p0[r];
#pragma unroll
    for (int r = 0; r < 16; ++r) ps += p1[r];
    { auto rr = __builtin_amdgcn_permlane32_swap(__float_as_uint(ps), __float_as_uint(ps), false, false);
      ps = __uint_as_float(rr[0]) + __uint_as_float(rr[1]); }
    l_reg = l_reg * alpha + ps;
#define PK4(P, BASE, OUT) do { unsigned a0 = cvt_pk_bf16(P[BASE + 0], P[BASE + 1]), a1 = cvt_pk_bf16(P[BASE + 2], P[BASE + 3]);   \
    unsigned b0 = cvt_pk_bf16(P[BASE + 4], P[BASE + 5]), b1 = cvt_pk_bf16(P[BASE + 6], P[BASE + 7]);                              \
    auto r0 = __builtin_amdgcn_permlane32_swap(a0, b0, false, false); auto r1 = __builtin_amdgcn_permlane32_swap(a1, b1, false, false); \
    u32x4 w = {r0[0], r1[0], r0[1], r1[1]}; OUT = __builtin_bit_cast(bf16x8, w); } while (0)
    PK4(p0, 0, pa0); PK4(p0, 8, pa1); PK4(p1, 0, pa2); PK4(p1, 8, pa3);
#undef PK4
}

__device__ __forceinline__ unsigned cvtpk_v(float lo, float hi) { f32x2 v = {lo, hi}; bf16x2_t b = __builtin_convertvector(v, bf16x2_t); return __builtin_bit_cast(unsigned, b); }
#define PK4V(P, BASE, OUT) do { unsigned a0 = cvtpk_v(P[BASE + 0], P[BASE + 1]), a1 = cvtpk_v(P[BASE + 2], P[BASE + 3]);   \
    unsigned b0 = cvtpk_v(P[BASE + 4], P[BASE + 5]), b1 = cvtpk_v(P[BASE + 6], P[BASE + 7]);                              \
    auto r0 = __builtin_amdgcn_permlane32_swap(a0, b0, false, false); auto r1 = __builtin_amdgcn_permlane32_swap(a1, b1, false, false); \
    u32x4 w = {r0[0], r1[0], r0[1], r1[1]}; OUT = __builtin_bit_cast(bf16x8, w); } while (0)
__device__ __forceinline__ void partialSM_fix(f32x16& p0, float& l_reg, bf16x8& q0, bf16x8& q1) {
    float ps = 0.f;
#pragma unroll
    for (int r = 0; r < 16; ++r) { p0[r] = __builtin_amdgcn_exp2f(p0[r]); ps += p0[r]; }
    l_reg += ps;
    PK4V(p0, 0, q0); PK4V(p0, 8, q1);
}
__device__ __forceinline__ void finishSM_fix(f32x16& p1, float& l_reg, const bf16x8& q0, const bf16x8& q1, bf16x8& pa0, bf16x8& pa1, bf16x8& pa2, bf16x8& pa3) {
    float ps = 0.f;
#pragma unroll
    for (int r = 0; r < 16; ++r) { p1[r] = __builtin_amdgcn_exp2f(p1[r]); ps += p1[r]; }
    l_reg += ps;
    pa0 = q0; pa1 = q1; PK4V(p1, 0, pa2); PK4V(p1, 8, pa3);
}
template <int DQK> __device__ __forceinline__ void qkt(f32x16& p0, f32x16& p1, const LAS char* Ks, const bf16x8* qr, int r32, int hi) {
    p0 = f32x16{}; p1 = f32x16{};
#pragma unroll
    for (int d0 = 0; d0 < DQK / 16; ++d0) { const int cb = (d0 * 16 + hi * 8) * 2;
        const bf16x8 b0 = *(const LAS bf16x8*)(Ks + KT<DQK>::swz(r32, cb));
        const bf16x8 b1 = *(const LAS bf16x8*)(Ks + KT<DQK>::swz(32 + r32, cb));
        p0 = __builtin_amdgcn_mfma_f32_32x32x16_bf16(b0, qr[d0], p0, 0, 0, 0);
        p1 = __builtin_amdgcn_mfma_f32_32x32x16_bf16(b1, qr[d0], p1, 0, 0, 0);
        if constexpr (DQK == 96) { if (d0 == 1 || d0 == 3) SBAR(); } }
}
template <int DQK> __device__ __forceinline__ void qkt_q(f32x16& p0, f32x16& p1, const LAS char* Ks, const LAS char* Qs, int r32, int hi) {
    p0 = f32x16{}; p1 = f32x16{};
#pragma unroll
    for (int d0 = 0; d0 < DQK / 16; ++d0) { const int cb = (d0 * 16 + hi * 8) * 2;
        const bf16x8 b0 = *(const LAS bf16x8*)(Ks + KT<DQK>::swz(r32, cb));
        const bf16x8 b1 = *(const LAS bf16x8*)(Ks + KT<DQK>::swz(32 + r32, cb));
        const bf16x8 q = *(const LAS bf16x8*)(Qs + r32 * 208 + cb);
        p0 = __builtin_amdgcn_mfma_f32_32x32x16_bf16(b0, q, p0, 0, 0, 0);
        p1 = __builtin_amdgcn_mfma_f32_32x32x16_bf16(b1, q, p1, 0, 0, 0); }
}
template <int DV, int D0> __device__ __forceinline__ void pv_one(f32x16& od, int vb, bf16x8 pa0, bf16x8 pa1, bf16x8 pa2, bf16x8 pa3) {
    typedef VT<DV> V_;
    const s16x4 l0 = tr_read<V_::rd_off(D0, 0, 0)>(vb), h0 = tr_read<V_::rd_off(D0, 0, 1)>(vb), l1 = tr_read<V_::rd_off(D0, 1, 0)>(vb), h1 = tr_read<V_::rd_off(D0, 1, 1)>(vb);
    const s16x4 l2 = tr_read<V_::rd_off(D0, 2, 0)>(vb), h2 = tr_read<V_::rd_off(D0, 2, 1)>(vb), l3 = tr_read<V_::rd_off(D0, 3, 0)>(vb), h3 = tr_read<V_::rd_off(D0, 3, 1)>(vb);
    asm volatile("s_waitcnt lgkmcnt(0)" ::: "memory"); SBAR();
#define PK(L, H) (bf16x8){L[0], L[1], L[2], L[3], H[0], H[1], H[2], H[3]}
    od = __builtin_amdgcn_mfma_f32_32x32x16_bf16(pa0, PK(l0, h0), od, 0, 0, 0);
    od = __builtin_amdgcn_mfma_f32_32x32x16_bf16(pa1, PK(l1, h1), od, 0, 0, 0);
    od = __builtin_amdgcn_mfma_f32_32x32x16_bf16(pa2, PK(l2, h2), od, 0, 0, 0);
    od = __builtin_amdgcn_mfma_f32_32x32x16_bf16(pa3, PK(l3, h3), od, 0, 0, 0);
#undef PK
}
template <int DV> __device__ __forceinline__ void pv_all(f32x16* o, int vb, bf16x8 pa0, bf16x8 pa1, bf16x8 pa2, bf16x8 pa3) {
    pv_one<DV, 0>(o[0], vb, pa0, pa1, pa2, pa3); pv_one<DV, 1>(o[1], vb, pa0, pa1, pa2, pa3);
    if constexpr (DV == 128) { pv_one<DV, 2>(o[2], vb, pa0, pa1, pa2, pa3); pv_one<DV, 3>(o[3], vb, pa0, pa1, pa2, pa3); }
}
template <int DQK, int DV> constexpr int lds_bytes() { return 2 * VT<DV>::BYTES + 2 * KT<DQK>::BYTES + 8 * 64 * 4; }

template <int DQK, int DV, bool FIX = false, bool QLDS = false>
__device__ __forceinline__ void attn_unit(const bf16_t* __restrict__ Qb, const bf16_t* __restrict__ Kh, const bf16_t* __restrict__ Vh, bf16_t* __restrict__ Ob, int ldo, int seq, LAS char* lds, int wv) {
    typedef KT<DQK> K_; typedef VT<DV> V_;
    constexpr int NCB = V_::NCB, NQ = DQK / 16;
    constexpr int SHM_V = V_::BYTES, SHM_K = K_::BYTES;
    constexpr int NKC = (DQK == 64) ? 1 : 2, NVC = (DV == 64) ? 1 : 2;
    const int tid = mk_tid(wv);
    const int wid = tid >> 6, lane = tid & 63, r32 = lane & 31, hi = lane >> 5;
    LAS char* V_lds = lds; LAS char* K_lds = lds + 2 * SHM_V;
    LAS float* wsf = (LAS float*)(lds + 2 * SHM_V + 2 * SHM_K) + wid * 64; LAS float* li_l = wsf; LAS float* al_l = wsf + 32;
    float m_reg = -1e30f, l_reg = 0; f32x16 o[NCB]; bf16x8 qr[NQ];
#pragma unroll
    for (int d = 0; d < NCB; ++d) o[d] = f32x16{};
    const bf16_t* Qw = Qb + (long)(wid * 32 + r32) * DQK + hi * 8;
#pragma unroll
    for (int d0 = 0; d0 < NQ; ++d0) qr[d0] = *(const bf16x8*)(Qw + d0 * 16);
    LAS char* Qs = lds + lds_bytes<DQK, DV>() + wid * 6656;
    if constexpr (QLDS) {
#pragma unroll
        for (int d0 = 0; d0 < NQ; ++d0) *(LAS bf16x8*)(Qs + r32 * 208 + (d0 * 16 + hi * 8) * 2) = qr[d0];
    }
#define QKT(P0, P1, KB) do { if constexpr (QLDS) qkt_q<DQK>(P0, P1, KB, Qs, r32, hi); else qkt<DQK>(P0, P1, KB, qr, r32, hi); } while (0)
    int krow[NKC], kcol[NKC], vrow[NVC], vcol[NVC];
    if constexpr (DQK == 64) { krow[0] = tid >> 3; kcol[0] = (tid & 7) * 8; }
    else { const int c0 = tid, c1 = 512 + (tid & 255); krow[0] = c0 / 12; kcol[0] = (c0 % 12) * 8; krow[1] = c1 / 12; kcol[1] = (c1 % 12) * 8; }
    if constexpr (DV == 64) { vrow[0] = tid >> 3; vcol[0] = (tid & 7) * 8; }
    else { vrow[0] = tid >> 4; vcol[0] = (tid & 15) * 8; vrow[1] = 32 + (tid >> 4); vcol[1] = (tid & 15) * 8; }
    const int vb0 = (int)(uintptr_t)V_lds + v_rd_base(lane);
    bf16x8 ksE[NKC], vsE[NVC];
#define SLOAD(KS, VS, k0) do { _Pragma("unroll") for (int i_ = 0; i_ < NVC; ++i_) VS[i_] = *(const bf16x8*)(Vh + (long)((k0) + vrow[i_]) * DV + vcol[i_]); \
    _Pragma("unroll") for (int i_ = 0; i_ < NKC; ++i_) KS[i_] = *(const bf16x8*)(Kh + (long)((k0) + krow[i_]) * DQK + kcol[i_]); } while (0)
#define SWRITE(b, KS, VS) do { _Pragma("unroll") for (int i_ = 0; i_ < NVC; ++i_) *(LAS bf16x8*)(V_lds + (b) * SHM_V + V_::v_st(vrow[i_], vcol[i_])) = VS[i_]; \
    _Pragma("unroll") for (int i_ = 0; i_ < NKC; ++i_) *(LAS bf16x8*)(K_lds + (b) * SHM_K + K_::swz(krow[i_], kcol[i_] * 2)) = KS[i_]; } while (0)
#define RESC(a) do { if (__any((a) < 1.f)) { if (hi == 0) al_l[r32] = (a); asm volatile("s_waitcnt lgkmcnt(0)" ::: "memory"); \
    _Pragma("unroll") for (int d = 0; d < NCB; ++d) _Pragma("unroll") for (int r = 0; r < 16; ++r) o[d][r] *= al_l[crow(r, hi)]; } } while (0)
#define XSB() do { if constexpr (FIX && DQK == 96) SBAR(); } while (0)
    s16x4 fl0, fh0, fl1, fh1, fl2, fh2, fl3, fh3;
#define PVPRE(vb) do { if constexpr (FIX && DQK == 64) { fl0 = tr_read<V_::rd_off(0, 0, 0)>(vb); fh0 = tr_read<V_::rd_off(0, 0, 1)>(vb); fl1 = tr_read<V_::rd_off(0, 1, 0)>(vb); fh1 = tr_read<V_::rd_off(0, 1, 1)>(vb); \
        fl2 = tr_read<V_::rd_off(0, 2, 0)>(vb); fh2 = tr_read<V_::rd_off(0, 2, 1)>(vb); fl3 = tr_read<V_::rd_off(0, 3, 0)>(vb); fh3 = tr_read<V_::rd_off(0, 3, 1)>(vb); } } while (0)
#define PKF(L, H) (bf16x8){L[0], L[1], L[2], L[3], H[0], H[1], H[2], H[3]}
#define PVALL(vb) do { if constexpr (FIX && DQK == 64) { asm volatile("s_waitcnt lgkmcnt(0)" ::: "memory"); SBAR(); \
        o[0] = __builtin_amdgcn_mfma_f32_32x32x16_bf16(pa0, PKF(fl0, fh0), o[0], 0, 0, 0); o[0] = __builtin_amdgcn_mfma_f32_32x32x16_bf16(pa1, PKF(fl1, fh1), o[0], 0, 0, 0); \
        o[0] = __builtin_amdgcn_mfma_f32_32x32x16_bf16(pa2, PKF(fl2, fh2), o[0], 0, 0, 0); o[0] = __builtin_amdgcn_mfma_f32_32x32x16_bf16(pa3, PKF(fl3, fh3), o[0], 0, 0, 0); \
        pv_one<DV, 1>(o[1], vb, pa0, pa1, pa2, pa3); if constexpr (DV == 128) { pv_one<DV, 2>(o[2], vb, pa0, pa1, pa2, pa3); pv_one<DV, 3>(o[3], vb, pa0, pa1, pa2, pa3); } } \
      else pv_all<DV>(o, vb, pa0, pa1, pa2, pa3); } while (0)
    f32x16 pA0, pA1, pB0, pB1; float alA = 1.f, alB = 1.f; bf16x8 pa0, pa1, pa2, pa3, qA0, qA1, qB0, qB1; const int NT = seq / 64;
#define PSM(P0, P1, AL, Q0, Q1) do { if constexpr (FIX) partialSM_fix(P0, l_reg, Q0, Q1); else partialSM(P0, P1, m_reg, AL); } while (0)
#define FSM(P0, P1, AL, Q0, Q1) do { if constexpr (FIX) finishSM_fix(P1, l_reg, Q0, Q1, pa0, pa1, pa2, pa3); else finishSM(P0, P1, AL, l_reg, pa0, pa1, pa2, pa3); } while (0)
#define RSC(AL) do { if constexpr (!FIX) { RESC(AL); } } while (0)
    SLOAD(ksE, vsE, 0); SWRITE(0, ksE, vsE); __syncthreads();
    QKT(pA0, pA1, K_lds); PSM(pA0, pA1, alA, qA0, qA1);
    SLOAD(ksE, vsE, 64); SWRITE(1, ksE, vsE); if (2 < NT) SLOAD(ksE, vsE, 128);
    __syncthreads();
    for (int j = 1; j + 1 < NT; j += 2) {
        SBAR(); QKT(pB0, pB1, K_lds + SHM_K); XSB(); PVPRE(vb0);
        FSM(pA0, pA1, alA, qA0, qA1); SBAR();
        PVALL(vb0); XSB(); PSM(pB0, pB1, alB, qB0, qB1);
        __syncthreads(); SWRITE(0, ksE, vsE); SBAR();
        if (j + 2 < NT) SLOAD(ksE, vsE, (j + 2) * 64); SBAR();
        RSC(alB); __syncthreads();
        SBAR(); QKT(pA0, pA1, K_lds); XSB(); PVPRE(vb0 + SHM_V);
        FSM(pB0, pB1, alB, qB0, qB1); SBAR();
        PVALL(vb0 + SHM_V); XSB(); PSM(pA0, pA1, alA, qA0, qA1);
        __syncthreads(); SWRITE(1, ksE, vsE); SBAR();
        if (j + 3 < NT) SLOAD(ksE, vsE, (j + 3) * 64); SBAR();
        RSC(alA); __syncthreads();
    }
    SBAR(); QKT(pB0, pB1, K_lds + SHM_K); PVPRE(vb0);
    FSM(pA0, pA1, alA, qA0, qA1); SBAR();
    PVALL(vb0); PSM(pB0, pB1, alB, qB0, qB1);
    __syncthreads(); RSC(alB);
    PVPRE(vb0 + SHM_V);
    FSM(pB0, pB1, alB, qB0, qB1); SBAR();
    PVALL(vb0 + SHM_V);
    if constexpr (FIX) { auto rr = __builtin_amdgcn_permlane32_swap(__float_as_uint(l_reg), __float_as_uint(l_reg), false, false); l_reg = __uint_as_float(rr[0]) + __uint_as_float(rr[1]); }
#undef PSM
#undef PVPRE
#undef PVALL
#undef PKF
#undef XSB
#undef FSM
#undef RSC
    {
        const int tid2 = mk_tid(wv), wid2 = tid2 >> 6, lane2 = tid2 & 63, r32b = lane2 & 31, hib = lane2 >> 5;
        LAS float* li2 = (LAS float*)(lds + 2 * SHM_V + 2 * SHM_K) + wid2 * 64;
        if (hib == 0) li2[r32b] = l_reg; asm volatile("s_waitcnt lgkmcnt(0)" ::: "memory");
        float rli[16];
#pragma unroll
        for (int r = 0; r < 16; ++r) rli[r] = __builtin_amdgcn_rcpf(li2[crow(r, hib)]);
        bf16_t* Ow = Ob + (long)(wid2 * 32) * ldo;
#pragma unroll
        for (int r = 0; r < 16; ++r) { const int orow = crow(r, hib);
#pragma unroll
            for (int d0 = 0; d0 < NCB; ++d0) Ow[(long)orow * ldo + d0 * 32 + r32b] = (bf16_t)f2bf(o[d0][r] * rli[r]); }
    }
    __syncthreads();
#undef SLOAD
#undef QKT
#undef SWRITE
#undef RESC
}
#undef SBAR
}

namespace att64 {
using bf16=__hip_bfloat16;
using bf16x8=__attribute__((ext_vector_type(8)))short;
using s16x4=__attribute__((ext_vector_type(4)))short;
using f32x16=__attribute__((ext_vector_type(16)))float;
using u32x4=__attribute__((ext_vector_type(4)))unsigned;
constexpr int D=64;
constexpr int NW=8,QBLK=32,QB=QBLK*NW,KVBLK=64;
__device__ __forceinline__ int crow(int r,int hi){return (r&3)+8*(r>>2)+4*hi;}
#define SBAR() __builtin_amdgcn_sched_barrier(0)
__device__ __forceinline__ void cmask(f32x16&p0,f32x16&p1,int jb,int qrel,int hi){
  const float NEG=-INFINITY; int kb=64*jb+4*hi;
  #pragma unroll
  for(int r=0;r<16;++r){int kv=kb+(r&3)+8*(r>>2); if(kv>qrel)p0[r]=NEG; if(kv+32>qrel)p1[r]=NEG;}
}

constexpr int NSLOT=3, SLOTB=8192;
constexpr int LDS_K=0;
template<int DQ> constexpr int lds_v(){return NSLOT*(DQ/8)*1024;} template<int NVH,int DQ> constexpr int lds_ws(){return lds_v<DQ>()+NSLOT*SLOTB*NVH;} template<int NVH,int DQ> constexpr int lds_ost(){return lds_ws<NVH,DQ>()+NW*64*4;} template<int NVH,int DQ> constexpr int lds_bytes(){return lds_ost<NVH,DQ>()+NW*4096*NVH;}
constexpr float C2=0.125f*1.4426950408889634f;
__device__ __forceinline__ void glds16(const void*gsrc,unsigned lds_dst){unsigned keep;
  asm volatile("s_mov_b32 %0, m0\n\ts_mov_b32 m0, %2\n\ts_nop 0\n\tglobal_load_lds_dwordx4 %1, off\n\ts_mov_b32 m0, %0":"=&s"(keep):"v"(gsrc),"s"(lds_dst):"memory");}
__device__ __forceinline__ float max3f(float a,float b,float c){float r;asm("v_max3_f32 %0, %1, %2, %3":"=v"(r):"v"(a),"v"(b),"v"(c));return r;}
__device__ __forceinline__ float max2f(float a,float b){float r;asm("v_max_f32_e32 %0, %1, %2":"=v"(r):"v"(a),"v"(b));return r;}
__device__ __forceinline__ float fadd_s(float a,float b){float r;asm("v_add_f32_e32 %0, %1, %2":"=v"(r):"v"(a),"v"(b));return r;}
__device__ __forceinline__ float fsub_s(float a,float b){float r;asm("v_sub_f32_e32 %0, %1, %2":"=v"(r):"v"(a),"v"(b));return r;}
typedef float f32x2_t __attribute__((ext_vector_type(2))); typedef __bf16 bf16x2_t __attribute__((ext_vector_type(2)));
__device__ __forceinline__ unsigned cvtpk_s(float lo,float hi){f32x2_t v={lo,hi};bf16x2_t b=__builtin_convertvector(v,bf16x2_t);return __builtin_bit_cast(unsigned,b);}
#define WAIT_BAR(N) asm volatile("s_waitcnt vmcnt(" #N ") lgkmcnt(0)\n\ts_barrier":::"memory")
#define WAIT_N(n) do{ if constexpr((n)==0){WAIT_BAR(0);} else if constexpr((n)==1){WAIT_BAR(1);} else if constexpr((n)==2){WAIT_BAR(2);} else if constexpr((n)==3){WAIT_BAR(3);} else if constexpr((n)==4){WAIT_BAR(4);} else if constexpr((n)==5){WAIT_BAR(5);} else {WAIT_BAR(6);} }while(0)

template<int NQ> __device__ __forceinline__ void qkt(f32x16&p0,f32x16&p1,const char*Kslot,const bf16x8*qr,const f32x16&negm,int r32,int hi){
  const char*kb=Kslot+hi*1024+r32*16;
  #pragma unroll
  for(int d0=0;d0<NQ;++d0){
    const bf16x8 b0=*reinterpret_cast<const bf16x8*>(kb+d0*2048);
    const bf16x8 b1=*reinterpret_cast<const bf16x8*>(kb+d0*2048+512);
    if(d0==0){p0=__builtin_amdgcn_mfma_f32_32x32x16_bf16(b0,qr[0],negm,0,0,0);p1=__builtin_amdgcn_mfma_f32_32x32x16_bf16(b1,qr[0],negm,0,0,0);}
    else{p0=__builtin_amdgcn_mfma_f32_32x32x16_bf16(b0,qr[d0],p0,0,0,0);p1=__builtin_amdgcn_mfma_f32_32x32x16_bf16(b1,qr[d0],p1,0,0,0);}}
}
typedef __attribute__((address_space(3))) const char* lds_cptr;
typedef short v4i16_t __attribute__((ext_vector_type(4)));
__device__ __forceinline__ void kload8(bf16x8*kf,lds_cptr kp){
  kf[0]=*(const __attribute__((address_space(3))) bf16x8*)(kp);      kf[1]=*(const __attribute__((address_space(3))) bf16x8*)(kp+512);
  kf[2]=*(const __attribute__((address_space(3))) bf16x8*)(kp+2048); kf[3]=*(const __attribute__((address_space(3))) bf16x8*)(kp+2560);
  kf[4]=*(const __attribute__((address_space(3))) bf16x8*)(kp+4096); kf[5]=*(const __attribute__((address_space(3))) bf16x8*)(kp+4608);
  kf[6]=*(const __attribute__((address_space(3))) bf16x8*)(kp+6144); kf[7]=*(const __attribute__((address_space(3))) bf16x8*)(kp+6656);
}
__device__ __forceinline__ void kload2(bf16x8*kf,lds_cptr kp,int j){ kf[2*j]=*(const __attribute__((address_space(3))) bf16x8*)(kp+j*2048); kf[2*j+1]=*(const __attribute__((address_space(3))) bf16x8*)(kp+j*2048+512); }
template<int NQ> __device__ __forceinline__ void kloadn(bf16x8*kf,lds_cptr kp){
  #pragma unroll
  for(int j=0;j<NQ;++j)kload2(kf,kp,j);
}
__device__ __forceinline__ s16x4 vtr(lds_cptr p){ return __builtin_bit_cast(s16x4,__builtin_amdgcn_ds_read_tr16_b64_v4i16((__attribute__((address_space(3))) v4i16_t*)p)); }
__device__ __forceinline__ float rowmax(const f32x16&p0,const f32x16&p1){
  float a=max3f(p0[0],p0[1],p1[0]),b=max3f(p0[2],p0[3],p1[1]);a=max3f(a,p1[2],p1[3]);
  #pragma unroll
  for(int r=4;r<16;r+=4){a=max3f(a,p0[r],p0[r+1]);b=max3f(b,p0[r+2],p0[r+3]);a=max3f(a,p1[r],p1[r+1]);b=max3f(b,p1[r+2],p1[r+3]);}
  const float m=max2f(a,b);
  auto rr=__builtin_amdgcn_permlane32_swap(__float_as_uint(m),__float_as_uint(m),false,false);
  return max2f(__uint_as_float(rr[0]),__uint_as_float(rr[1]));
}
template<int NO> __device__ __forceinline__ void pv(f32x16*o,int vb,bf16x8 pa0,bf16x8 pa1,bf16x8 pa2,bf16x8 pa3){
  #pragma unroll
  for(int d0=0;d0<NO;++d0){s16x4 lo[4],hi[4];
    #pragma unroll
    for(int ks=0;ks<4;++ks){
      asm volatile("ds_read_b64_tr_b16 %0,%1 offset:%c2":"=&v"(lo[ks]):"v"(vb),"i"(d0*4096+ks*1024):"memory");
      asm volatile("ds_read_b64_tr_b16 %0,%1 offset:%c2":"=&v"(hi[ks]):"v"(vb),"i"(d0*4096+ks*1024+512):"memory");}
    asm volatile("s_waitcnt lgkmcnt(0)":::"memory");SBAR();
    #define PK(k) (bf16x8){lo[k][0],lo[k][1],lo[k][2],lo[k][3],hi[k][0],hi[k][1],hi[k][2],hi[k][3]}
    o[d0]=__builtin_amdgcn_mfma_f32_32x32x16_bf16(pa0,PK(0),o[d0],0,0,0);
    o[d0]=__builtin_amdgcn_mfma_f32_32x32x16_bf16(pa1,PK(1),o[d0],0,0,0);
    o[d0]=__builtin_amdgcn_mfma_f32_32x32x16_bf16(pa2,PK(2),o[d0],0,0,0);
    o[d0]=__builtin_amdgcn_mfma_f32_32x32x16_bf16(pa3,PK(3),o[d0],0,0,0);
    #undef PK
  }
}

#ifndef ATTN_STORE16
#define ATTN_STORE16(p,v) (*(u32x4*)(p)=(v))
#endif
template<int THRL,bool FIX=false,int NVH=1,int DQ=64,int EPI=0> __device__ __forceinline__ void attn_unit(const bf16*Qu,const int QP,const bf16*__restrict__ Kh,const bf16*__restrict__ Vh,const int KP,const int VP,bf16*Ou,const int OP,const int NT,char*shm,int wv,
    const bf16*O1=nullptr,const int OP1=0,const float lam=0.f,const float*gsub=nullptr,const float osc=1.f){
  static_assert(NVH==1||FIX,"the 128-wide V form exists only for the fixed-reference softmax");
  static_assert(DQ==64||(DQ==96&&NVH==2&&FIX),"96-wide q/k only in the fixed-reference 128-wide-V form");
  constexpr int NO=2*NVH, NQ=DQ/16, NKD=(DQ==64)?1:2, KSLOT=(DQ/8)*1024, LDS_V=lds_v<DQ>(), LDS_WS=lds_ws<NVH,DQ>(), LDS_OST=lds_ost<NVH,DQ>();
  const int tid=mk_tid(wv); const int lane=tid&63,r32=lane&31,hi=lane>>5; const int wid=__builtin_amdgcn_readfirstlane(tid>>6);
  const bf16*Qw=Qu+(long)(wid*QBLK)*QP;
  const unsigned lds0=(unsigned)(uintptr_t)shm;
  float*wsf=(float*)(shm+LDS_WS)+wid*64;
  const bf16*ksrc=Kh+(long)lane*KP+wid*8;
  const bf16*vsrc=Vh+(long)(16*(wid&3)+(lane>>2))*VP+(wid>>2)*32+(lane&3)*8;
  const unsigned kdst=lds0+LDS_K+wid*1024, vdst=lds0+LDS_V+wid*1024;
  #define KSL(sl) ((DQ==64)?(sl):((sl)+((sl)>>1)))
  #define DMA_K(t,slot) do{ glds16(ksrc+(long)(t)*KVBLK*KP,(unsigned)__builtin_amdgcn_readfirstlane(kdst+KSL(slot))); if constexpr(NKD==2) glds16(ksrc+(8+(wid&3)-wid)*8+(long)(t)*KVBLK*KP,(unsigned)__builtin_amdgcn_readfirstlane(kdst+KSL(slot)+(8+(wid&3)-wid)*1024)); }while(0)
  #define DMA_V(t,slot) do{ glds16(vsrc+(long)(t)*KVBLK*VP,(unsigned)__builtin_amdgcn_readfirstlane(vdst+(slot)*NVH)); if constexpr(NVH==2) glds16(vsrc+64+(long)(t)*KVBLK*VP,(unsigned)__builtin_amdgcn_readfirstlane(vdst+(slot)*NVH+8192)); }while(0)
  const int vb0=(int)(lds0+LDS_V)+((lane>>4)&1)*32+(lane&3)*8+(4*hi+((lane&15)>>2))*64;
  const char*Kbase=shm+LDS_K; bf16x8 kf[2*NQ];
  const lds_cptr shm3=(lds_cptr)shm; const lds_cptr kp0=shm3+LDS_K+hi*1024+r32*16; const lds_cptr vp0=shm3+LDS_V+((lane>>4)&1)*32+(lane&3)*8+(4*hi+((lane&15)>>2))*64;
  DMA_K(0,0);DMA_V(0,0);DMA_K(1,SLOTB);
  bf16x8 qr[NQ];
  #pragma unroll
  for(int d0=0;d0<NQ;++d0)qr[d0]=*reinterpret_cast<const bf16x8*>(&Qw[(long)r32*QP+d0*16+hi*8]);
  float mhat=0.f,l_reg=0.f;f32x16 o[NO];
  _Pragma("unroll") for(int d_=0;d_<NO;++d_)o[d_]=f32x16{};
  f32x16 negm=f32x16{}; if constexpr(!FIX){asm volatile("":"+v"(negm));}
  #define NEGM (FIX?f32x16{}:negm)
  const int qrel=wid*QBLK+r32;
  #define CMASK(P0,P1,t) do{}while(0)
  bool resc=false;
  #define START(P0,P1) do{ resc=false; if constexpr(!FIX){ const float rm=rowmax(P0,P1); \
    { const float dl=rm; mhat=fadd_s(mhat,dl); \
      _Pragma("unroll") for(int r=0;r<16;++r){P0[r]=fsub_s(P0[r],dl);P1[r]=fsub_s(P1[r],dl);} \
      _Pragma("unroll") for(int r=0;r<16;++r)negm[r]=-mhat; asm volatile("":"+v"(negm)); } } \
    _Pragma("unroll") for(int r=0;r<16;++r)P0[r]=__builtin_amdgcn_exp2f(P0[r]); }while(0)
  #define RESC() do{ if(resc){ asm volatile("s_waitcnt lgkmcnt(0)":::"memory"); \
      _Pragma("unroll") for(int d_=0;d_<NO;++d_) _Pragma("unroll") for(int r=0;r<16;++r)o[d_][r]*=wsf[crow(r,hi)]; } }while(0)
  f32x16 pA0,pA1,pB0,pB1;
  int sl_prev=0,sl_cur=0,sl_next=SLOTB;
  #define ROT() do{sl_prev=sl_cur;sl_cur=sl_next;sl_next=(sl_next==(NSLOT-1)*SLOTB)?0:sl_next+SLOTB;}while(0)
  DMA_K(2,2*SLOTB);
  WAIT_N(NVH+2*NKD);
  qkt<NQ>(pA0,pA1,Kbase,qr,NEGM,r32,hi);asm volatile("s_nop 15\n\ts_nop 7":"+v"(pA0),"+v"(pA1));CMASK(pA0,pA1,0);
  START(pA0,pA1);
  _Pragma("unroll") for(int r=0;r<16;++r)pA1[r]=__builtin_amdgcn_exp2f(pA1[r]);
  WAIT_BAR(0);
  DMA_K(3,0);DMA_V(1,SLOTB);
  ROT();
  kloadn<NQ>(kf,kp0+KSL(sl_cur));
  WAIT_N(NVH+NKD);
  s16x4 vlo[8],vhi[8]; u32x4 pw0,pw1,pw2,pw3;
  #define PKW(P,B) cvtpk_s(P[B],P[B+1])
  #define PAF(k) __builtin_bit_cast(bf16x8,pw##k)
  #define VFR(i) (bf16x8){vlo[i][0],vlo[i][1],vlo[i][2],vlo[i][3],vhi[i][0],vhi[i][1],vhi[i][2],vhi[i][3]}
  #define PIN(x) asm volatile("":"+v"(x))
  #define MX3(a,b,c) __builtin_fmaxf(__builtin_fmaxf((a),(b)),(c))
  #define GAPA(MF,A0,A1,A2,A3,W0,W1,PW) do{ MF; sacc+=A0; sacc+=A1; sacc+=A2; sacc+=A3; PIN(sacc); W0; W1; PIN(PW); SBAR(); }while(0)
  #define EX(v) __builtin_amdgcn_exp2f(v)
  #define GAPB(MF,X,B) do{ MF; X[B]=EX(X[B]); X[B+1]=EX(X[B+1]); X[B+2]=EX(X[B+2]); X[B+3]=EX(X[B+3]); PIN(X); SBAR(); }while(0)
  #define VRD(i) do{ vlo[i]=vtr(vp_+(((i)>>2)*4096+((i)&3)*1024)); vhi[i]=vtr(vp_+(((i)>>2)*4096+((i)&3)*1024+512)); }while(0)
  #define VRD2(i) do{ vlo[i]=vtr(vp_+(8192+((i)>>2)*4096+((i)&3)*1024)); vhi[i]=vtr(vp_+(8192+((i)>>2)*4096+((i)&3)*1024+512)); }while(0)
  #define GAPC(MF,RD,X,B) do{ MF; RD; X[B]=EX(X[B]); X[B+1]=EX(X[B+1]); PIN(X); SBAR(); }while(0)
  #define KRD(G,j) do{ if(G){ kload2(kf,kp0+KSL(sl_next),j); SBAR(); } }while(0)
  #define STEP(C0,C1,P0,P1,t,GK,GV,GL) do{ SBAR(); \
    const lds_cptr vp_=vp0+sl_prev*NVH; \
    VRD(0); SBAR(); float sacc=(P0[0]+P0[1]); \
    GAPA(C0=__builtin_amdgcn_mfma_f32_32x32x16_bf16(kf[0],qr[0],NEGM,0,0,0), P0[2],P0[3],P0[4],P0[5],     pw0[0]=PKW(P0,0), pw0[1]=PKW(P0,2), pw0); \
    VRD(4); SBAR(); GAPA(C1=__builtin_amdgcn_mfma_f32_32x32x16_bf16(kf[1],qr[0],NEGM,0,0,0), P0[6],P0[7],P0[8],P0[9],     pw0[2]=PKW(P0,4), pw0[3]=PKW(P0,6), pw0); \
    VRD(1); SBAR(); GAPA(C0=__builtin_amdgcn_mfma_f32_32x32x16_bf16(kf[2],qr[1],C0,0,0,0),   P0[10],P0[11],P0[12],P0[13], pw1[0]=PKW(P0,8), pw1[1]=PKW(P0,10), pw1); \
    VRD(5); SBAR(); GAPA(C1=__builtin_amdgcn_mfma_f32_32x32x16_bf16(kf[3],qr[1],C1,0,0,0),   P0[14],P0[15],P1[0],P1[1],   pw1[2]=PKW(P0,12),pw1[3]=PKW(P0,14), pw1); \
    VRD(2); SBAR(); GAPA(C0=__builtin_amdgcn_mfma_f32_32x32x16_bf16(kf[4],qr[2],C0,0,0,0),   P1[2],P1[3],P1[4],P1[5],     pw2[0]=PKW(P1,0), pw2[1]=PKW(P1,2), pw2); \
    VRD(6); SBAR(); GAPA(C1=__builtin_amdgcn_mfma_f32_32x32x16_bf16(kf[5],qr[2],C1,0,0,0),   P1[6],P1[7],P1[8],P1[9],     pw2[2]=PKW(P1,4), pw2[3]=PKW(P1,6), pw2); \
    VRD(3); SBAR(); GAPA(C0=__builtin_amdgcn_mfma_f32_32x32x16_bf16(kf[6],qr[3],C0,0,0,0),   P1[10],P1[11],P1[12],P1[13], pw3[0]=PKW(P1,8), pw3[1]=PKW(P1,10), pw3); \
    VRD(7); SBAR(); GAPA(C1=__builtin_amdgcn_mfma_f32_32x32x16_bf16(kf[7],qr[3],C1,0,0,0),   P1[14],P1[15],0.f,0.f,       pw3[2]=PKW(P1,12),pw3[3]=PKW(P1,14), pw3); \
    if constexpr(NQ==6){ C0=__builtin_amdgcn_mfma_f32_32x32x16_bf16(kf[8],qr[4],C0,0,0,0); C1=__builtin_amdgcn_mfma_f32_32x32x16_bf16(kf[9],qr[4],C1,0,0,0); C0=__builtin_amdgcn_mfma_f32_32x32x16_bf16(kf[10],qr[5],C0,0,0,0); C1=__builtin_amdgcn_mfma_f32_32x32x16_bf16(kf[11],qr[5],C1,0,0,0); SBAR(); } \
    l_reg+=sacc; \
    if(GK){DMA_K((t)+3,sl_cur);} if(GV){DMA_V((t)+1,sl_next);} \
    CMASK(C0,C1,t); \
        if constexpr(!FIX){ float a=MX3(C0[0],C0[1],C1[0]),b=MX3(C0[2],C0[3],C1[1]); a=MX3(a,C1[2],C1[3]); \
      _Pragma("unroll") for(int r=4;r<16;r+=4){a=MX3(a,C0[r],C0[r+1]);b=MX3(b,C0[r+2],C0[r+3]);a=MX3(a,C1[r],C1[r+1]);b=MX3(b,C1[r+2],C1[r+3]);} \
      float rm=__builtin_fmaxf(a,b); { auto rr=__builtin_amdgcn_permlane32_swap(__float_as_uint(rm),__float_as_uint(rm),false,false); rm=__builtin_fmaxf(__uint_as_float(rr[0]),__uint_as_float(rr[1])); } \
      resc=false; \
      if(__builtin_expect(__any(rm>(float)THRL),0)){ const float dl=__builtin_fmaxf(rm,0.f); mhat+=dl; \
        _Pragma("unroll") for(int r=0;r<16;++r){C0[r]-=dl;C1[r]-=dl;} \
        _Pragma("unroll") for(int r=0;r<16;++r)negm[r]=-mhat; asm volatile("":"+v"(negm)); \
        const float f=__builtin_amdgcn_exp2f(-dl); l_reg*=f; if(hi==0)wsf[r32]=f; resc=true; } } \
    SBAR(); \
    if constexpr(NVH==1){ \
    GAPB(o[0]=__builtin_amdgcn_mfma_f32_32x32x16_bf16(PAF(0),VFR(0),o[0],0,0,0), C0,0); \
    GAPB(o[1]=__builtin_amdgcn_mfma_f32_32x32x16_bf16(PAF(0),VFR(4),o[1],0,0,0), C0,4); \
    KRD(GL,0); GAPB(o[0]=__builtin_amdgcn_mfma_f32_32x32x16_bf16(PAF(1),VFR(1),o[0],0,0,0), C0,8); \
    KRD(GL,1); GAPB(o[1]=__builtin_amdgcn_mfma_f32_32x32x16_bf16(PAF(1),VFR(5),o[1],0,0,0), C0,12); \
    KRD(GL,2); GAPB(o[0]=__builtin_amdgcn_mfma_f32_32x32x16_bf16(PAF(2),VFR(2),o[0],0,0,0), C1,0); \
    KRD(GL,3); GAPB(o[1]=__builtin_amdgcn_mfma_f32_32x32x16_bf16(PAF(2),VFR(6),o[1],0,0,0), C1,4); \
    GAPB(o[0]=__builtin_amdgcn_mfma_f32_32x32x16_bf16(PAF(3),VFR(3),o[0],0,0,0), C1,8); \
    GAPB(o[1]=__builtin_amdgcn_mfma_f32_32x32x16_bf16(PAF(3),VFR(7),o[1],0,0,0), C1,12); \
    } else {   \
    GAPC(o[0]=__builtin_amdgcn_mfma_f32_32x32x16_bf16(PAF(0),VFR(0),o[0],0,0,0), VRD2(0), C0,0); \
    GAPC(o[1]=__builtin_amdgcn_mfma_f32_32x32x16_bf16(PAF(0),VFR(4),o[1],0,0,0), VRD2(4), C0,2); \
    KRD(GL,0); GAPC(o[0]=__builtin_amdgcn_mfma_f32_32x32x16_bf16(PAF(1),VFR(1),o[0],0,0,0), VRD2(1), C0,4); \
    KRD(GL,1); GAPC(o[1]=__builtin_amdgcn_mfma_f32_32x32x16_bf16(PAF(1),VFR(5),o[1],0,0,0), VRD2(5), C0,6); \
    KRD(GL,2); GAPC(o[0]=__builtin_amdgcn_mfma_f32_32x32x16_bf16(PAF(2),VFR(2),o[0],0,0,0), VRD2(2), C0,8); \
    KRD(GL,3); GAPC(o[1]=__builtin_amdgcn_mfma_f32_32x32x16_bf16(PAF(2),VFR(6),o[1],0,0,0), VRD2(6), C0,10); \
    if constexpr(NQ==6){KRD(GL,4);} GAPC(o[0]=__builtin_amdgcn_mfma_f32_32x32x16_bf16(PAF(3),VFR(3),o[0],0,0,0), VRD2(3), C0,12); \
    if constexpr(NQ==6){KRD(GL,5);} GAPC(o[1]=__builtin_amdgcn_mfma_f32_32x32x16_bf16(PAF(3),VFR(7),o[1],0,0,0), VRD2(7), C0,14); \
    GAPC(o[2]=__builtin_amdgcn_mfma_f32_32x32x16_bf16(PAF(0),VFR(0),o[2],0,0,0), (void)0, C1,0); \
    GAPC(o[3]=__builtin_amdgcn_mfma_f32_32x32x16_bf16(PAF(0),VFR(4),o[3],0,0,0), (void)0, C1,2); \
    GAPC(o[2]=__builtin_amdgcn_mfma_f32_32x32x16_bf16(PAF(1),VFR(1),o[2],0,0,0), (void)0, C1,4); \
    GAPC(o[3]=__builtin_amdgcn_mfma_f32_32x32x16_bf16(PAF(1),VFR(5),o[3],0,0,0), (void)0, C1,6); \
    GAPC(o[2]=__builtin_amdgcn_mfma_f32_32x32x16_bf16(PAF(2),VFR(2),o[2],0,0,0), (void)0, C1,8); \
    GAPC(o[3]=__builtin_amdgcn_mfma_f32_32x32x16_bf16(PAF(2),VFR(6),o[3],0,0,0), (void)0, C1,10); \
    GAPC(o[2]=__builtin_amdgcn_mfma_f32_32x32x16_bf16(PAF(3),VFR(3),o[2],0,0,0), (void)0, C1,12); \
    GAPC(o[3]=__builtin_amdgcn_mfma_f32_32x32x16_bf16(PAF(3),VFR(7),o[3],0,0,0), (void)0, C1,14); \
    } \
    }while(0)
  #define WAITS() WAIT_N(NVH+NKD)
  int t=1;
  #undef CMASK
  #define CMASK(P0,P1,t) do{}while(0)
  for(;t+5<NT;t+=2){
    STEP(pB0,pB1,pA0,pA1,t,true,true,true);     WAITS(); RESC(); ROT();
    STEP(pA0,pA1,pB0,pB1,t+1,true,true,true);   WAITS(); RESC(); ROT();
  }
  #undef CMASK
  #define CMASK(P0,P1,t) do{}while(0)
  #define ENDW(tt) do{ if((tt)+3<NT){WAITS();} else if((tt)+2<NT){ WAIT_N(NVH); } else {WAIT_BAR(0);} }while(0)
  for(;t+1<NT;t+=2){
    STEP(pB0,pB1,pA0,pA1,t,(t+3<NT),(t+1<NT),(t+1<NT));       ENDW(t);   RESC(); ROT();
    STEP(pA0,pA1,pB0,pB1,t+1,(t+4<NT),(t+2<NT),(t+2<NT));     ENDW(t+1); RESC(); ROT();
  }
  STEP(pB0,pB1,pA0,pA1,NT-1,false,false,false); RESC();
  { float sacc=pB0[0]+pB0[1]; _Pragma("unroll") for(int r=2;r<16;++r)sacc+=pB0[r]; _Pragma("unroll") for(int r=0;r<16;++r)sacc+=pB1[r]; l_reg+=sacc;
    pw0=(u32x4){PKW(pB0,0),PKW(pB0,2),PKW(pB0,4),PKW(pB0,6)};pw1=(u32x4){PKW(pB0,8),PKW(pB0,10),PKW(pB0,12),PKW(pB0,14)};pw2=(u32x4){PKW(pB1,0),PKW(pB1,2),PKW(pB1,4),PKW(pB1,6)};pw3=(u32x4){PKW(pB1,8),PKW(pB1,10),PKW(pB1,12),PKW(pB1,14)};
    SBAR(); pv<NO>(o,vb0+sl_cur*NVH,PAF(0),PAF(1),PAF(2),PAF(3)); }
  #undef PKW
  #undef PAF
  #undef VFR
  #undef PIN
  #undef MX3
  #undef GAPA
  #undef GAPB
  #undef EX
  #undef VRD
  #undef VRD2
  #undef GAPC
  #undef KRD
  #undef STEP
  #undef ENDW
  #undef WAITS
  {auto rr=__builtin_amdgcn_permlane32_swap(__float_as_uint(l_reg),__float_as_uint(l_reg),false,false);l_reg=__uint_as_float(rr[0])+__uint_as_float(rr[1]);}
  if(hi==0)wsf[32+r32]=l_reg;asm volatile("s_waitcnt lgkmcnt(0)":::"memory");
  float rli[16];
  #pragma unroll
  for(int r=0;r<16;++r)rli[r]=__builtin_amdgcn_rcpf(wsf[32+crow(r,hi)]);
  bf16*Ow=Ou+(long)(wid*QBLK)*OP;
  { constexpr int OW=64*NVH;
    bf16*stg=(bf16*)(shm+LDS_OST)+wid*(32*OW);
    #pragma unroll
    for(int r=0;r<16;++r){const int orow=crow(r,hi);
      #pragma unroll
      for(int d0=0;d0<NO;++d0)stg[orow*OW+d0*32+r32]=__float2bfloat16(o[d0][r]*rli[r]);}
    asm volatile("s_waitcnt lgkmcnt(0)":::"memory");
    constexpr int CPR=OW/8;
    #pragma unroll
    for(int i=0;i<32*CPR/64;++i){const int pid=i*64+lane,row=pid/CPR,ch=pid%CPR; u32x4 v=*(const u32x4*)(stg+row*OW+ch*8);
      if constexpr(EPI==1){ static_assert(EPI==0||NVH==2,"combine epilogue: 128-wide heads");
        const u32x4 w1=*(const u32x4*)(O1+(long)(wid*QBLK+row)*OP1+ch*8); float f1[8],f2[8]; unpack8(w1,f1); unpack8(v,f2); float ss=0.f;
        _Pragma("unroll") for(int k=0;k<8;++k){ f1[k]=f1[k]-lam*f2[k]; ss+=f1[k]*f1[k]; }
        ss+=dpp_x1(ss); ss+=dpp_x2(ss); ss+=dpp_x7(ss); ss+=dpp_x15(ss);
        const float rs=rsqrtf(ss*(1.f/128.f)+EPS)*osc;
        _Pragma("unroll") for(int k=0;k<8;++k) f1[k]=f1[k]*rs*gsub[ch*8+k];
        v=pack8(f1); }
      ATTN_STORE16(Ow+(long)row*OP+ch*8,v);} }
  asm volatile("s_waitcnt lgkmcnt(0)\n\ts_barrier":::"memory");
  #undef NEGM
  #undef KSL
  #undef DMA_K
  #undef DMA_V
  #undef CMASK
  #undef START
  #undef RESC
  #undef ROT
}
#undef SBAR
#undef WAIT_BAR
}

namespace att8 {
typedef int v8i __attribute__((ext_vector_type(8)));
typedef int v4i __attribute__((ext_vector_type(4)));
constexpr int NS = 8, PD = 5;
#define A8_SB() __builtin_amdgcn_sched_barrier(0)
__device__ __forceinline__ int crow(int r, int hi) { return (r & 3) + 8 * (r >> 2) + 4 * hi; }
__device__ __forceinline__ int pk4_f8(float a, float b, float c, float d) { int w = __builtin_amdgcn_cvt_pk_fp8_f32(a, b, 0, false); return __builtin_amdgcn_cvt_pk_fp8_f32(c, d, w, true); }
__device__ __forceinline__ int pk4_b8(float a, float b, float c, float d) { int w = __builtin_amdgcn_cvt_pk_bf8_f32(a, b, 0, false); return __builtin_amdgcn_cvt_pk_bf8_f32(c, d, w, true); }
template <int DQ> __device__ __forceinline__ int kswz(int key) { return DQ == 64 ? ((key >> 2) & 3) : ((key >> 1) & 7); }
template <int DQ> __device__ __forceinline__ int k_off(int k, int c) { return k * DQ + ((c ^ kswz<DQ>(k)) << 4); }
__device__ __forceinline__ int v_off(int n, int c) { return n * 64 + ((c ^ ((n >> 2) & 3)) << 4); }
__device__ __forceinline__ int v_key(int c, int r) { return 32 * (c & 1) + 4 * (c >> 1) + (r & 3) + 8 * (r >> 2); }
__device__ __forceinline__ f32x16 mm_f8f8(v8i a, v8i b, f32x16 c) { return __builtin_amdgcn_mfma_scale_f32_32x32x64_f8f6f4(a, b, c, 0, 0, 0, 0, 0, 0); }
__device__ __forceinline__ f32x16 mm_b8f8(v8i a, v8i b, f32x16 c) { return __builtin_amdgcn_mfma_scale_f32_32x32x64_f8f6f4(a, b, c, 1, 0, 0, 0, 0, 0); }
__device__ __forceinline__ v8i ld8(const LAS char* p0, const LAS char* p1) { const v4i a = *(const LAS v4i*)p0, b = *(const LAS v4i*)p1; return (v8i){a.x, a.y, a.z, a.w, b.x, b.y, b.z, b.w}; }

template <int DQ, int DV, int EPI>
__device__ __forceinline__ void attn_unit(const unsigned char* __restrict__ Qu, const unsigned char* __restrict__ Kt, const unsigned char* __restrict__ Vt, bf16_t* Ou, const int OP, const int NT, LAS char* lds, int wv,
    const bf16_t* O1 = nullptr, const int OP1 = 0, const float lam = 0.f, const float* gsub = nullptr, const float osc = 1.f, float* chk = nullptr) {
  constexpr int KB = 64 * DQ, VB = DV * 64, SLOT = KB + VB, NKP = KB / 1024, NVP = VB / 1024, NQS = DQ / 64, NOB = DV / 32, NM = NOB + 1;
  const int tid = mk_tid(wv); const int lane = tid & 63, r32 = lane & 31, hi = lane >> 5; const int wid = __builtin_amdgcn_readfirstlane(tid >> 6);
  constexpr int NDMA = (DQ == 64 && DV == 64) ? 1 : 2;
  const unsigned lds0 = (unsigned)(size_t)lds;
  const int kp = (DQ == 64) ? (wid & 3) : wid, vp = (DV == 64) ? (wid & 3) : wid;
  const unsigned char* ksrc = Kt + kp * 1024 + lane * 16;
  const unsigned char* vsrc = Vt + vp * 1024 + lane * 16;
  const unsigned kdst = lds0 + kp * 1024, vdst = lds0 + KB + vp * 1024;
  const unsigned char* src1 = (NDMA == 1 && wid >= 4) ? vsrc : ksrc; const unsigned dst1 = (NDMA == 1 && wid >= 4) ? vdst : kdst;
  static_assert(NDMA == 2 || KB == VB, "single-piece form: equal tile strides");
#define A8_DMA(tt, sb) do { const int t_ = (tt) < NT ? (tt) : NT - 1; \
    att64::glds16(src1 + (size_t)t_ * KB, (unsigned)__builtin_amdgcn_readfirstlane(dst1 + (sb))); \
    if constexpr (NDMA == 2) att64::glds16(vsrc + (size_t)t_ * VB, (unsigned)__builtin_amdgcn_readfirstlane(vdst + (sb))); } while (0)
#define A8_WAIT() do { if constexpr (NDMA == 2) asm volatile("s_waitcnt vmcnt(4)" ::: "memory"); else asm volatile("s_waitcnt vmcnt(2)" ::: "memory"); __builtin_amdgcn_s_barrier(); asm volatile("" ::: "memory"); } while (0)
  v8i qf[NQS];
  { const unsigned char* qrow = Qu + (size_t)(wid * 32 + r32) * DQ + 32 * hi;
#pragma unroll
    for (int s = 0; s < NQS; ++s) { const v4i a = *(const v4i*)(qrow + 64 * s), b = *(const v4i*)(qrow + 64 * s + 16); qf[s] = (v8i){a.x, a.y, a.z, a.w, b.x, b.y, b.z, b.w}; } }
#pragma unroll
  for (int u = 0; u < PD; ++u) A8_DMA(u, u * SLOT);
  int kof[NQS][2], vof[2];
#pragma unroll
  for (int s = 0; s < NQS; ++s)
#pragma unroll
    for (int i = 0; i < 2; ++i) kof[s][i] = k_off<DQ>(r32, 4 * s + 2 * hi + i);
#pragma unroll
  for (int i = 0; i < 2; ++i) vof[i] = KB + v_off(r32, 2 * hi + i);
  f32x16 o[NOB], L = f32x16{}, SA0, SA1, SB0, SB1;
#pragma unroll
  for (int d = 0; d < NOB; ++d) o[d] = f32x16{};
  v8i kf[2][NQS], vf[NOB];
  const int one4 = pk4_f8(1.f, 1.f, 1.f, 1.f);
  const v8i ONES = (v8i){one4, one4, one4, one4, one4, one4, one4, one4};
  f32x16 NEG4 = {-4.f, -4.f, -4.f, -4.f, -4.f, -4.f, -4.f, -4.f, -4.f, -4.f, -4.f, -4.f, -4.f, -4.f, -4.f, -4.f};
  if constexpr (NQS == 1) asm volatile("" : "+v"(NEG4));
  v8i pk = (v8i){0, 0, 0, 0, 0, 0, 0, 0};
  int sb_prev = 0, sb_cur = 0, sb_next = SLOT, sb_dma = PD * SLOT;
#define A8_ROT() do { sb_prev = sb_cur; sb_cur = sb_next; sb_next = (sb_next == (NS - 1) * SLOT) ? 0 : sb_next + SLOT; sb_dma = (sb_dma == (NS - 1) * SLOT) ? 0 : sb_dma + SLOT; } while (0)
#define A8_LDK(sb) do { _Pragma("unroll") for (int m_ = 0; m_ < 2; ++m_) _Pragma("unroll") for (int s_ = 0; s_ < NQS; ++s_) { const LAS char* p_ = lds + (sb) + m_ * 32 * DQ; kf[m_][s_] = ld8(p_ + kof[s_][0], p_ + kof[s_][1]); } } while (0)
#define A8_LDV(sb) do { _Pragma("unroll") for (int d_ = 0; d_ < NOB; ++d_) { const LAS char* p_ = lds + (sb) + d_ * 2048; vf[d_] = ld8(p_ + vof[0], p_ + vof[1]); } } while (0)
#define A8_QK1(N, m) do { if constexpr (NQS == 1) N = mm_f8f8(kf[m][0], qf[0], NEG4); else { N = mm_f8f8(kf[m][0], qf[0], f32x16{}); N = mm_f8f8(kf[m][1], qf[1], N); } } while (0)
#define A8_EX(C0, C1, e) do { if ((e) < 16) C0[(e) & 15] = __builtin_amdgcn_exp2f(C0[(e) & 15]); else C1[(e) & 15] = __builtin_amdgcn_exp2f(C1[(e) & 15]); } while (0)
#define A8_PK1(W, P, B) do { W = __builtin_amdgcn_cvt_pk_bf8_f32(P[B], P[B + 1], W, false); W = __builtin_amdgcn_cvt_pk_bf8_f32(P[B + 2], P[B + 3], W, true); } while (0)
#define A8_PACKH(C, h) do { _Pragma("unroll") for (int j_ = 0; j_ < 4; ++j_) A8_PK1(pk[4 * (h) + j_], C, 4 * j_); } while (0)
  A8_WAIT();
  A8_DMA(PD, sb_dma);
  A8_LDK(sb_cur);
  A8_QK1(SA0, 0); A8_QK1(SA1, 1);
#pragma unroll
  for (int e = 0; e < 32; ++e) A8_EX(SA0, SA1, e);
  A8_PACKH(SA0, 0); A8_PACKH(SA1, 1);
  A8_LDK(sb_next);
  A8_QK1(SB0, 0); A8_QK1(SB1, 1);
  A8_LDV(sb_cur);
  A8_ROT();
#define A8_PRIO(p) do { A8_SB(); __builtin_amdgcn_s_setprio(p); A8_SB(); } while (0)
#define A8_STEP(C0, C1, N0, N1, tt, SYNC) do { \
    A8_SB(); if constexpr (SYNC) { A8_WAIT(); } A8_SB(); \
    _Pragma("unroll") for (int i = 0; i < NM; ++i) { \
      A8_PRIO(1); if (i < NOB) o[i < NOB ? i : 0] = mm_b8f8(pk, vf[i < NOB ? i : 0], o[i < NOB ? i : 0]); else L = mm_b8f8(pk, ONES, L); A8_PRIO(0); \
      if (i == 0) A8_LDK(sb_next); \
      _Pragma("unroll") for (int e = (32 * i) / NM; e < (32 * (i + 1)) / NM; ++e) A8_EX(C0, C1, e); \
      A8_SB(); } \
    A8_LDV(sb_cur); A8_SB(); \
    A8_PRIO(1); A8_QK1(N0, 0); A8_PRIO(0); A8_PACKH(C0, 0); A8_SB(); \
    A8_PRIO(1); A8_QK1(N1, 1); A8_PRIO(0); A8_PACKH(C1, 1); A8_SB(); \
    A8_DMA((tt) + PD, sb_dma); \
    A8_ROT(); A8_SB(); } while (0)
  { int t = 1;
    for (; t + 1 < NT; t += 2) { A8_STEP(SB0, SB1, SA0, SA1, t, true); A8_STEP(SA0, SA1, SB0, SB1, t + 1, false); }
    A8_STEP(SB0, SB1, SA0, SA1, NT - 1, true); }
#pragma unroll
  for (int i = 0; i < NOB; ++i) o[i] = mm_b8f8(pk, vf[i], o[i]);
  L = mm_b8f8(pk, ONES, L);
  asm volatile("s_waitcnt vmcnt(0) lgkmcnt(0)" ::: "memory");
  __builtin_amdgcn_s_barrier(); asm volatile("" ::: "memory");
#undef A8_DMA
#undef A8_WAIT
#undef A8_ROT
#undef A8_LDK
#undef A8_LDV
#undef A8_QK1
#undef A8_EX
#undef A8_PACKH
#undef A8_PK1
#undef A8_STEP
#undef A8_PRIO
  float rl[16];
#pragma unroll
  for (int r = 0; r < 16; ++r) rl[r] = __builtin_amdgcn_rcpf(L[r]);
  bf16_t* Ow = Ou + (size_t)(wid * 32) * OP;
  LAS bf16_t* stg = (LAS bf16_t*)lds + wid * (32 * DV);
#pragma unroll
  for (int r = 0; r < 16; ++r) { const int orow = crow(r, hi);
#pragma unroll
    for (int d0 = 0; d0 < NOB; ++d0) stg[orow * DV + d0 * 32 + r32] = (bf16_t)f2bf(o[d0][r] * rl[r]); }
  asm volatile("s_waitcnt lgkmcnt(0)" ::: "memory");
  constexpr int CPR = DV / 8;
  float cs_d = 0.f, cs_o = 0.f;
#pragma unroll
  for (int i = 0; i < 32 * CPR / 64; ++i) { const int pid = i * 64 + lane, row = pid / CPR, ch = pid % CPR; u32x4 v = *(const LAS u32x4*)(stg + row * DV + ch * 8);
    if constexpr (EPI == 1) { static_assert(EPI != 1 || DV == 128, "combine epilogue: 128-wide heads");
      const u32x4 w1 = *(const u32x4*)(O1 + (size_t)(wid * 32 + row) * OP1 + ch * 8); float f1[8], f2[8]; unpack8(w1, f1); unpack8(v, f2); float ss = 0.f;
#pragma unroll
      for (int k = 0; k < 8; ++k) { f1[k] = f1[k] - lam * f2[k]; ss += f1[k] * f1[k]; }
      ss += dpp_x1(ss); ss += dpp_x2(ss); ss += dpp_x7(ss); ss += dpp_x15(ss);
      const float rs = rsqrtf(ss * (1.f / 128.f) + EPS) * osc;
#pragma unroll
      for (int k = 0; k < 8; ++k) f1[k] = f1[k] * rs * gsub[ch * 8 + k];
      v = pack8(f1); }
    if constexpr (EPI == 2) { const u32x4 w1 = *(const u32x4*)(Ow + (size_t)row * OP + ch * 8); float f1[8], f2[8]; unpack8(w1, f1); unpack8(v, f2);
#pragma unroll
      for (int k = 0; k < 8; ++k) { const float dd = f2[k] - f1[k]; cs_d += dd * dd; cs_o += f1[k] * f1[k]; } }
    else *(u32x4*)(Ow + (size_t)row * OP + ch * 8) = v; }
  if constexpr (EPI == 2) { cs_d = wave_sum(cs_d); cs_o = wave_sum(cs_o); if (lane == 0) { atomicAdd(chk, cs_d); atomicAdd(chk + 1, cs_o); } }
  asm volatile("s_waitcnt lgkmcnt(0)" ::: "memory");
  __builtin_amdgcn_s_barrier(); asm volatile("" ::: "memory");
}
#undef A8_SB
}

struct Args {
    const float* in[33];
    float* out; unsigned char* ws;
    int ph_lo, ph_hi;
};
enum { I_X = 0, I_C, I_CTX, I_CCTX, I_WADA, I_BADA, I_GMIX, I_GFFN, I_EWIN, I_EWOUT, I_EGQ, I_EGK, I_ECONVW, I_ECONVB, I_EBG, I_EGH,
       I_OWIN, I_OWOUT, I_OGQC, I_OGKC, I_OLAM, I_OGSUB, I_OGCQ, I_OWUQ, I_OGCKV, I_OWUKV, I_OGQD, I_OGKD, I_WR, I_BR, I_W1, I_W3, I_W2 };
enum { PH_PRO = 0, PH_ENORM, PH_EINPROJ, PH_EPOST, PH_EATTN, PH_MLA, PH_MLB, PH_MLC, PH_EOUT, PH_M0NORM, PH_M0GATHER, PH_M0G1, PH_M0G2, PH_M0COMB,
       PH_OINPROJ, PH_OPOST, PH_OGEMM, PH_OPOST2, PH_OATTN, PH_OSUB, PH_OOUT, PH_M1NORM, PH_M1GATHER, PH_M1G1, PH_M1G2, PH_M1COMB, NPH };

struct Ctx {
    LAS unsigned char* lds; int tid, lane, wave, vcu, G, gw, NGW;
};

__device__ __forceinline__ Args load_args() {
    extern __shared__ __attribute__((aligned(16))) unsigned char lds_dyn3_[];
    const LAS unsigned* p = (const LAS unsigned*)((LAS unsigned char*)lds_dyn3_ + ARGS_OFF);
    Args a;
#pragma unroll
    for (int i = 0; i < 33; ++i) { const unsigned lo = __builtin_amdgcn_readfirstlane(p[2 * i]), hi = __builtin_amdgcn_readfirstlane(p[2 * i + 1]); a.in[i] = (const float*)(const GAS float*)(((unsigned long long)hi << 32) | lo); }
    { const unsigned lo = __builtin_amdgcn_readfirstlane(p[66]), hi = __builtin_amdgcn_readfirstlane(p[67]); a.out = (float*)(GAS float*)(((unsigned long long)hi << 32) | lo); }
    { const unsigned lo = __builtin_amdgcn_readfirstlane(p[68]), hi = __builtin_amdgcn_readfirstlane(p[69]); a.ws = (unsigned char*)(GAS unsigned char*)(((unsigned long long)hi << 32) | lo); }
    a.ph_lo = __builtin_amdgcn_readfirstlane(p[70]); a.ph_hi = __builtin_amdgcn_readfirstlane(p[71]);
    return a;
}
__device__ __forceinline__ Ctx fresh(const Ctx& c0) {
    Ctx c; int bx = blockIdx.x, G = gridDim.x; const int tid = mk_tid(c0.wave);
    asm volatile("" : "+s"(bx), "+s"(G));
    extern __shared__ __attribute__((aligned(16))) unsigned char lds_dyn_[];
    c.lds = (LAS unsigned char*)lds_dyn_;
    const int vcu = (G % 8 == 0) ? (bx % 8) * (G / 8) + bx / 8 : bx;
    c.tid = tid; c.lane = tid & 63; c.wave = __builtin_amdgcn_readfirstlane(tid >> 6); c.vcu = vcu; c.G = G; c.gw = vcu * 8 + c.wave; c.NGW = G * 8;
    (void)c0;
    return c;
}
__device__ __forceinline__ void grid_sync(const Ctx& c) {
    extern __shared__ __attribute__((aligned(16))) unsigned char lds_dyn4_[];
    XcdBarrier b_; b_.bar = (unsigned*)(load_args().ws + WS_CTL) + CW_BAR; b_.x = xb_xcc_id(); b_.st = (volatile LAS unsigned*)((LAS unsigned char*)lds_dyn4_ + MISC_OFF) + 8; xcd_barrier(b_, mk_tid(c.wave));
}
__device__ __forceinline__ int row_bsel(int row) { return row < TC ? 2 : (row - TC) / SEQ; }
__device__ __forceinline__ bool fast8_e(const Args& a, int lane) { float gq = fabsf(a.in[I_EGQ][lane]), gk = fabsf(a.in[I_EGK][lane]); gq = wave_max(gq); gk = wave_max(gk); return A8_ENABLE && (0.125f * LOG2E * 64.f * gq * gk) < 17.f; }
__device__ __forceinline__ bool fast8_c(const Args& a, int lane) { float gq = fabsf(a.in[I_OGQC][lane]), gk = fabsf(a.in[I_OGKC][lane]); gq = wave_max(gq); gk = wave_max(gk); return A8_ENABLE && (0.125f * LOG2E * 64.f * gq * gk) < 17.f; }
__device__ __forceinline__ bool fast8_d(const Args& a, int lane) {
    float gq2 = fmaxf(fabsf(a.in[I_OGQD][lane]), lane < 32 ? fabsf(a.in[I_OGQD][64 + lane]) : 0.f), gk2 = fmaxf(fabsf(a.in[I_OGKD][lane]), lane < 32 ? fabsf(a.in[I_OGKD][64 + lane]) : 0.f);
    gq2 = wave_max(gq2); gk2 = wave_max(gk2); return A8_ENABLE && (0.10206207261596575f * LOG2E * 96.f * gq2 * gk2) < 21.f; }
__device__ __forceinline__ u32x2 pk8_f8(const float* f) { u32x2 w; w.x = (unsigned)att8::pk4_f8(f[0], f[1], f[2], f[3]); w.y = (unsigned)att8::pk4_f8(f[4], f[5], f[6], f[7]); return w; }
template <int DV> __device__ __forceinline__ void vquant_items(const bf16_t* src, int pitch, int col0, int hstride, int nheads, unsigned char* V8, int gw, int NGW, int lane) {
    constexpr int G = DV / 16;
    const int nitems = BATCH * nheads * NTILE * G;
    for (int it = gw; it < nitems; it += NGW) {
        const int g = it % G; int r = it / G; const int tile = r % NTILE; r /= NTILE; const int head = r % nheads, b = r / nheads;
        const int cc = DV == 64 ? g : (g >> 1), n = DV == 64 ? lane : ((g & 1) * 64 + lane);
        const int row0 = tile < 4 ? b * CTX + tile * 64 : TC + b * SEQ + (tile - 4) * 64;
        const bf16_t* p = src + (size_t)row0 * pitch + col0 + head * hstride + n;
        float f[16];
#pragma unroll
        for (int q = 0; q < 16; ++q) f[q] = bf2f(p[(size_t)att8::v_key(cc, q) * pitch]);
        att8::v4i w; w.x = att8::pk4_f8(f[0], f[1], f[2], f[3]); w.y = att8::pk4_f8(f[4], f[5], f[6], f[7]); w.z = att8::pk4_f8(f[8], f[9], f[10], f[11]); w.w = att8::pk4_f8(f[12], f[13], f[14], f[15]);
        *(att8::v4i*)(V8 + ((size_t)((b * nheads + head) * NTILE + tile)) * (DV * 64) + att8::v_off(n, cc)) = w;
    }
}

__device__ __forceinline__ void transpose_item(const float* W, int ldw, int K, bf16_t* WT, int row_off, int mode, int which, LAS float* scr, int kb, int nb, int lane) {
    const int k0 = 64 * kb, n0 = 32 * nb;
    { float t_[32];
#pragma unroll
      for (int i = 0; i < 32; ++i) t_[i] = W[(size_t)(k0 + 2 * i + (lane >> 5)) * ldw + n0 + (lane & 31)];
#pragma unroll
      for (int i = 0; i < 32; ++i) scr[(2 * i + (lane >> 5)) * 33 + (lane & 31)] = t_[i]; }
    LDS_WAIT(); asm volatile("" ::: "memory");
    const int c = lane & 7;
#pragma unroll
    for (int j = 0; j < 4; ++j) { const int n = (lane >> 3) + 8 * j; const LAS float* s = scr + (8 * c) * 33 + n;
        u32x4 o; o.x = pk2(s[0 * 33], s[1 * 33]); o.y = pk2(s[2 * 33], s[3 * 33]); o.z = pk2(s[4 * 33], s[5 * 33]); o.w = pk2(s[6 * 33], s[7 * 33]);
        const int ng = n0 + n;
        const int orow = mode == 0 ? row_off + ng : (64 * (ng >> 5) + ((ng & 31) >> 4) * 32 + which * 16 + (ng & 15));
        *(u32x4*)(WT + (size_t)orow * K + k0 + 8 * c) = o; }
    LDS_WAIT(); asm volatile("" ::: "memory");
}

__device__ __forceinline__ void phase_pro(const Args& a, const Ctx& c0) {
    const Ctx c = fresh(c0);
    unsigned char* ws = a.ws;
    for (int it = blockIdx.x; it < 192; it += c.G) {
        const int l = it / 96, rem = it % 96, chunk = rem / 8, s = rem % 8;
        LAS float* sc = (LAS float*)c.lds;
        if (c.tid < 384) { const int bs = c.tid / 128, k = s * 128 + (c.tid % 128);
            const float v = bs < 2 ? a.in[I_C][bs * D + k] : a.in[I_CCTX][k]; sc[c.tid] = siluf(v); }
        __syncthreads();
        const int col = chunk * 512 + c.tid;
        const float* w = a.in[I_WADA] + (size_t)l * D * 6144 + (size_t)(s * 128) * 6144 + col;
        float a0 = 0.f, a1 = 0.f, a2 = 0.f;
#pragma unroll 16
        for (int k = 0; k < 128; ++k) { const float wv = w[(size_t)k * 6144]; a0 += sc[k] * wv; a1 += sc[128 + k] * wv; a2 += sc[256 + k] * wv; }
        float* mp = (float*)(ws + WS_MODP) + (size_t)s * 3 * 12288 + l * 6144 + col;
        mp[0] = a0; mp[12288] = a1; mp[2 * 12288] = a2;
        __syncthreads();
    }
    LAS float* scr = (LAS float*)(c.lds + 4096 + c.wave * 16384);
    bf16_t* wsm = (bf16_t*)(ws + WS_WSM);
    constexpr int I_E = 16 * 88, I_O = 16 * 61, I_W = 16 * 32, I_UQ = 4 * 12, I_UKV = 2 * 24;
    constexpr int NIT = I_E + I_O + 2 * I_W + I_UQ + I_UKV;
    for (int it = c.gw; it < NIT; it += c.NGW) {
        int r = it;
        if (r < I_E) { transpose_item(a.in[I_EWIN], IN_EVEN, D, wsm + WO_WINE / 2, 0, 0, 0, scr, r / 88, r % 88, c.lane); continue; } r -= I_E;
        if (r < I_O) { transpose_item(a.in[I_OWIN], IN_ODD, D, wsm + WO_WINO / 2, 0, 0, 0, scr, r / 61, r % 61, c.lane); continue; } r -= I_O;
        if (r < I_W) { transpose_item(a.in[I_EWOUT], D, D, wsm + WO_WOUTE / 2, 0, 0, 0, scr, r / 32, r % 32, c.lane); continue; } r -= I_W;
        if (r < I_W) { transpose_item(a.in[I_OWOUT], D, D, wsm + WO_WOUTO / 2, 0, 0, 0, scr, r / 32, r % 32, c.lane); continue; } r -= I_W;
        if (r < I_UQ) { transpose_item(a.in[I_OWUQ], 384, 256, wsm + WO_WUQ / 2, 0, 0, 0, scr, r / 12, r % 12, c.lane); continue; } r -= I_UQ;
        transpose_item(a.in[I_OWUKV], 768, 128, wsm + WO_WUKV / 2, 0, 0, 0, scr, r / 24, r % 24, c.lane);
    }
    {
        const int gt = c.vcu * 512 + c.tid, NT = c.G * 512;
        u32x4* z0 = (u32x4*)(ws + WS_WSM + WO_WINO + (size_t)1952 * D * 2);
        for (int i = gt; i < 96 * 2048 / 16; i += NT) z0[i] = (u32x4){0u, 0u, 0u, 0u};
        u32x4* z1 = (u32x4*)(ws + WS_WSM + WO_WUQ + (size_t)384 * 256 * 2);
        for (int i = gt; i < 128 * 512 / 16; i += NT) z1[i] = (u32x4){0u, 0u, 0u, 0u};
        float* t64 = (float*)(ws + WS_ROPE64); float* td = (float*)(ws + WS_ROPED);
        for (int i = gt; i < 256 * 16 + 256 * 8; i += NT) {
            if (i < 4096) { const int pos = i >> 4, fi = i & 15; float sn, cs; sincosf((float)pos * powf(10000.f, -(float)fi / 16.f), &sn, &cs); t64[2 * i] = cs; t64[2 * i + 1] = sn; }
            else { const int k = i - 4096, pos = k >> 3, fi = k & 7; float sn, cs; sincosf((float)pos * powf(10000.f, -(float)fi / 8.f), &sn, &cs); td[2 * k] = cs; td[2 * k + 1] = sn; } }
    }
}

__device__ __forceinline__ void norm_mod_row(const float* xrow, const float* gain, const float* sh, const float* sc, int lane, f32x4 (&v)[4]) {
    const f32x4* xr = (const f32x4*)xrow + lane;
    float s = 0.f;
#pragma unroll
    for (int j = 0; j < 4; ++j) { v[j] = xr[64 * j]; s += (v[j].x * v[j].x + v[j].y * v[j].y) + (v[j].z * v[j].z + v[j].w * v[j].w); }
    const float rstd = rsqrtf(wave_sum(s) * (1.f / D) + EPS);
#pragma unroll
    for (int j = 0; j < 4; ++j) { const f32x4 g = ((const f32x4*)gain)[lane + 64 * j], a = ((const f32x4*)sc)[lane + 64 * j], b = ((const f32x4*)sh)[lane + 64 * j];
        v[j] = (v[j] * rstd) * g * (a + 1.0f) + b; }
}
__device__ __forceinline__ void store_row_bf16(bf16_t* orow, int lane, const f32x4 (&v)[4]) {
    u32x2* o8 = (u32x2*)orow + lane;
#pragma unroll
    for (int j = 0; j < 4; ++j) { u32x2 w; w.x = pk2(v[j].x, v[j].y); w.y = pk2(v[j].z, v[j].w); o8[64 * j] = w; }
}

template <int NEXP> __device__ __forceinline__ void row_dots(const f32x4 (&v)[4], const LAS float* wT, int lane, float (&p)[NEXP]) {
    f32x4 wa[8], wb[8];
#define RD_LOAD(W, G) do { _Pragma("unroll") for (int ei_ = 0; ei_ < 2; ++ei_) _Pragma("unroll") for (int j_ = 0; j_ < 4; ++j_) W[ei_ * 4 + j_] = ((const LAS f32x4*)(wT + ((G) * 2 + ei_) * D))[lane + 64 * j_]; asm volatile("" ::: "memory"); } while (0)
#define RD_COMP(W, G) do { _Pragma("unroll") for (int ei_ = 0; ei_ < 2; ++ei_) { float acc_ = 0.f; _Pragma("unroll") for (int j_ = 0; j_ < 4; ++j_) { const f32x4 w_ = W[ei_ * 4 + j_]; \
        acc_ = fmaf(v[j_].x, w_.x, acc_); acc_ = fmaf(v[j_].y, w_.y, acc_); acc_ = fmaf(v[j_].z, w_.z, acc_); acc_ = fmaf(v[j_].w, w_.w, acc_); } p[(G) * 2 + ei_] = acc_; } } while (0)
    RD_LOAD(wa, 0);
#pragma unroll
    for (int g = 0; g < NEXP / 2; g += 2) {
        RD_LOAD(wb, g + 1);
        RD_COMP(wa, g);
        if (g + 2 < NEXP / 2) RD_LOAD(wa, g + 2);
        RD_COMP(wb, g + 1);
    }
#undef RD_LOAD
#undef RD_COMP
}
__device__ __forceinline__ void phase_enorm(const Args& a, const Ctx& c0) {
    const Ctx c = fresh(c0);
    unsigned char* ws = a.ws;
    const float* modp = (const float*)(ws + WS_MODP);
    float* mod = (float*)(ws + WS_MOD);
    LAS float* lmod = (LAS float*)c.lds;
    LAS float* wgT = (LAS float*)(c.lds + 24576);
    for (int i = c.tid; i < 6144; i += 512) { const int bs = i / 2048, ch = (i % 2048) / 1024, col = i % 1024, j = ch * 1024 + col;
        float v = a.in[I_BADA][j];
#pragma unroll
        for (int s = 0; s < 8; ++s) v += modp[(size_t)s * 3 * 12288 + bs * 12288 + j];
        lmod[i] = v; }
    for (int i = c.vcu * 512 + c.tid; i < 2 * 3 * 6144; i += c.G * 512) { const int l = i / 18432, bs = (i % 18432) / 6144, j = i % 6144;
        float v = a.in[I_BADA][l * 6144 + j];
#pragma unroll
        for (int s = 0; s < 8; ++s) v += modp[(size_t)s * 3 * 12288 + bs * 12288 + l * 6144 + j];
        mod[i] = v; }
    for (int k = c.tid; k < D; k += 512) { const f32x4* src = (const f32x4*)(a.in[I_EWIN] + (size_t)k * IN_EVEN + NZE);
#pragma unroll
        for (int q = 0; q < 4; ++q) { const f32x4 w = src[q]; wgT[(4 * q + 0) * D + k] = w.x; wgT[(4 * q + 1) * D + k] = w.y; wgT[(4 * q + 2) * D + k] = w.z; wgT[(4 * q + 3) * D + k] = w.w; } }
    __syncthreads();
    bf16_t* H = (bf16_t*)(ws + WS_HMF);
    float* Gt = (float*)(ws + WS_G);
    const float* gmix = a.in[I_GMIX];
    const int lane = c.lane;
    f32x4 gmx[4], xn[4];
#pragma unroll
    for (int j = 0; j < 4; ++j) gmx[j] = ((const f32x4*)gmix)[lane + 64 * j];
    { const int row0 = c.gw; if (row0 < NROW) { const float* xr0 = row0 < TC ? a.in[I_CTX] + (size_t)row0 * D : a.in[I_X] + (size_t)(row0 - TC) * D;
#pragma unroll
        for (int j = 0; j < 4; ++j) xn[j] = ((const f32x4*)xr0)[lane + 64 * j]; } }
    for (int row = c.gw; row < NROW; row += c.NGW) {
        const int bs = row_bsel(row);
        f32x4 v[4]; float s = 0.f;
#pragma unroll
        for (int j = 0; j < 4; ++j) { v[j] = xn[j]; s += (v[j].x * v[j].x + v[j].y * v[j].y) + (v[j].z * v[j].z + v[j].w * v[j].w); }
        { const int nrow = row + c.NGW; if (nrow < NROW) { const float* xr1 = nrow < TC ? a.in[I_CTX] + (size_t)nrow * D : a.in[I_X] + (size_t)(nrow - TC) * D;
#pragma unroll
            for (int j = 0; j < 4; ++j) xn[j] = ((const f32x4*)xr1)[lane + 64 * j]; } }
        const float rstd = rsqrtf(wave_sum(s) * (1.f / D) + EPS);
        const LAS f32x4* shp = (const LAS f32x4*)(lmod + bs * 2048), *scp = (const LAS f32x4*)(lmod + bs * 2048 + 1024);
#pragma unroll
        for (int j = 0; j < 4; ++j) v[j] = (v[j] * rstd) * gmx[j] * (scp[lane + 64 * j] + 1.0f) + shp[lane + 64 * j];
        store_row_bf16(H + (size_t)row * D, lane, v);
        float p[16];
        row_dots<16>(v, wgT, lane, p);
#pragma unroll
        for (int i = 0; i < 8; ++i) { const bool up = (lane & 32) != 0; const float send = up ? p[i] : p[i + 8]; const float recv = xshfl<32>(send); p[i] = (up ? p[i + 8] : p[i]) + recv; }
#pragma unroll
        for (int i = 0; i < 4; ++i) { const bool up = (lane & 16) != 0; const float send = up ? p[i] : p[i + 4]; const float recv = xshfl<16>(send); p[i] = (up ? p[i + 4] : p[i]) + recv; }
#pragma unroll
        for (int i = 0; i < 2; ++i) { const bool up = (lane & 8) != 0; const float send = up ? p[i] : p[i + 2]; const float recv = dpp_x15(send); p[i] = (up ? p[i + 2] : p[i]) + recv; }
        { const bool up = (lane & 4) != 0; const float send = up ? p[0] : p[1]; const float recv = dpp_x7(send); p[0] = (up ? p[1] : p[0]) + recv; }
        p[0] += dpp_x2(p[0]); p[0] += dpp_x1(p[0]);
        if ((lane & 3) == 0) { const int idx = ((lane >> 5) & 1) * 8 + ((lane >> 4) & 1) * 4 + ((lane >> 3) & 1) * 2 + ((lane >> 2) & 1);
            float gv = p[0] + a.in[I_EBG][idx];
            const int gt = idx >> 2;
            if (gt & 1) gv = logsigmoidf_(gv);
            Gt[(size_t)row * 16 + idx] = gv; }
    }
}

struct Rope4 { float c[4], s[4]; };
__device__ __forceinline__ Rope4 rope64_angles(int t, int lane, const float* tab) {
    const int pos = ((lane & 7) < 4) ? (t / GRIDW) : (t % GRIDW), fi = ((lane & 7) & 3) * 4;
    const f32x4* p = (const f32x4*)(tab + (pos * 16 + fi) * 2); const f32x4 a = p[0], b = p[1];
    Rope4 r; r.c[0] = a.x; r.s[0] = a.y; r.c[1] = a.z; r.s[1] = a.w; r.c[2] = b.x; r.s[2] = b.y; r.c[3] = b.z; r.s[3] = b.w;
    return r;
}
__device__ __forceinline__ void rope_apply8(float* f, const Rope4& r) {
#pragma unroll
    for (int i = 0; i < 4; ++i) { const float x0 = f[2 * i], x1 = f[2 * i + 1]; f[2 * i] = x0 * r.c[i] - x1 * r.s[i]; f[2 * i + 1] = x0 * r.s[i] + x1 * r.c[i]; }
}
__device__ __forceinline__ float sum8(float v) { v += dpp_x1(v); v += dpp_x2(v); v += dpp_x7(v); return v; }
__device__ __forceinline__ float sum16(float v) { v = sum8(v); v += dpp_x15(v); return v; }
__device__ __forceinline__ float ssq8(const float* f) { float s = 0.f;
#pragma unroll
    for (int i = 0; i < 8; ++i) s += f[i] * f[i];
    return s; }

__device__ __forceinline__ void phase_epost(const Args& a, const Ctx& c0) {
    const Ctx c = fresh(c0);
    unsigned char* ws = a.ws;
    const bf16_t* Z = (const bf16_t*)(ws + WS_RA);
    bf16_t* QKB = (bf16_t*)(ws + WS_RC);
    bf16_t* Qa = (bf16_t*)(ws + WS_RB);
    bf16_t* Ka = Qa + (size_t)BATCH * 8 * SEQ * 64;
    bf16_t* Va = Ka + (size_t)BATCH * 2 * SKV * 64;
    bf16_t* Qc = Va + (size_t)BATCH * 2 * SKV * 64;
    const int lane = c.lane;
    float gq[8], gk[8]; const float* rtab = (const float*)(ws + WS_ROPE64);
#pragma unroll
    for (int i = 0; i < 8; ++i) { gq[i] = a.in[I_EGQ][(lane & 7) * 8 + i]; gk[i] = a.in[I_EGK][(lane & 7) * 8 + i]; }
    float cw[2][3][8], cb[2][8];
#pragma unroll
    for (int jj = 0; jj < 2; ++jj)
#pragma unroll
        for (int i = 0; i < 8; ++i) { const int ch = 8 * lane + 512 * jj + i; cb[jj][i] = a.in[I_ECONVB][ch];
#pragma unroll
            for (int j = 0; j < 3; ++j) cw[jj][j][i] = a.in[I_ECONVW][j * 1024 + ch]; }
    const float qscale = 0.125f * LOG2E;
    const bool f8 = fast8_e(a, lane), w16 = !f8 || A8_DEBUG == 1;
    unsigned char* Q8a = ws + F8_EQ; unsigned char* K8a = ws + F8_EK; unsigned char* Q8c = ws + F8_EQC;
    for (int row = c.gw; row < NROW; row += c.NGW) {
        const bool isctx = row < TC;
        const int b = isctx ? row / CTX : (row - TC) / SEQ, t = isctx ? row % CTX : (row - TC) % SEQ;
        const int slen = isctx ? CTX : SEQ;
        const bf16_t* zr = Z + (size_t)row * NZE;
        Rope4 rp; if (!isctx) rp = rope64_angles(t, lane, rtab);
        float f[8];
        { const u32x4 w = *(const u32x4*)(zr + 8 * lane); unpack8(w, f);
          const float rstd = rsqrtf(sum8(ssq8(f)) * (1.f / 64.f) + EPS);
#pragma unroll
          for (int i = 0; i < 8; ++i) f[i] = f[i] * rstd * gq[i];
          if (!isctx) rope_apply8(f, rp);
#pragma unroll
          for (int i = 0; i < 8; ++i) f[i] *= qscale;
          const int h = lane >> 3;
          if (f8) { unsigned char* d8 = isctx ? Q8c + ((size_t)(b * 8 + h) * CTX + t) * 64 + (lane & 7) * 8 : Q8a + ((size_t)(b * 8 + h) * SEQ + t) * 64 + (lane & 7) * 8; *(u32x2*)d8 = pk8_f8(f); }
          if (w16) { bf16_t* dst = isctx ? Qc + ((size_t)(b * 8 + h) * CTX + t) * 64 + (lane & 7) * 8 : Qa + ((size_t)(b * 8 + h) * SEQ + t) * 64 + (lane & 7) * 8;
            *(u32x4*)dst = pack8(f); } }
        if (lane < 16) {
            const int hk = lane >> 3, pos = isctx ? t : CTX + t;
            { const u32x4 w = *(const u32x4*)(zr + 512 + 8 * lane); unpack8(w, f); }
            const float rstd = rsqrtf(sum8(ssq8(f)) * (1.f / 64.f) + EPS);
#pragma unroll
            for (int i = 0; i < 8; ++i) f[i] = f[i] * rstd * gk[i];
            if (!isctx) rope_apply8(f, rp);
            if (f8) { const int j8 = lane & 7; *(u32x2*)(K8a + ((size_t)((b * 2 + hk) * NTILE + (pos >> 6))) * 4096 + att8::k_off<64>(pos & 63, j8 >> 1) + (j8 & 1) * 8) = pk8_f8(f); }
            if (w16) { *(u32x4*)(Ka + ((size_t)(b * 2 + hk) * SKV + pos) * 64 + (lane & 7) * 8) = pack8(f);
                const u32x4 wv = *(const u32x4*)(zr + 640 + 8 * lane);
                *(u32x4*)(Va + ((size_t)(b * 2 + hk) * SKV + pos) * 64 + (lane & 7) * 8) = wv; }
        }
#pragma unroll
        for (int jj = 0; jj < 2; ++jj) {
            const int ch = 8 * lane + 512 * jj;
            float accv[8];
#pragma unroll
            for (int i = 0; i < 8; ++i) accv[i] = cb[jj][i];
#pragma unroll
            for (int j = 0; j < 3; ++j) { const int tt = t + j - 1;
                if (tt >= 0 && tt < slen) { const u32x4 w = *(const u32x4*)(zr + (long)(j - 1) * NZE + 768 + ch); float g[8]; unpack8(w, g);
#pragma unroll
                    for (int i = 0; i < 8; ++i) accv[i] += g[i] * cw[jj][j][i]; } }
            const float ks = jj ? 0.08838834764831845f : 1.0f;
#pragma unroll
            for (int i = 0; i < 8; ++i) accv[i] = siluf(accv[i]) * ks;
            *(u32x4*)(QKB + (size_t)row * D + ch) = pack8(accv);
        }
    }
    if (f8) vquant_items<64>(Z, NZE, 640, 64, 2, ws + F8_EV, c.gw, c.NGW, lane);
}

__device__ __forceinline__ void phase_eattn(const Args& a, const Ctx& c0) {
    const Ctx c = fresh(c0);
    unsigned char* ws = a.ws;
    const bf16_t* Qa = (const bf16_t*)(ws + WS_RB);
    const bf16_t* Ka = Qa + (size_t)BATCH * 8 * SEQ * 64;
    const bf16_t* Va = Ka + (size_t)BATCH * 2 * SKV * 64;
    const bf16_t* Qc = Va + (size_t)BATCH * 2 * SKV * 64;
    bf16_t* MIX = (bf16_t*)(ws + WS_HMF);
    LAS char* lds = (LAS char*)c.lds;
    float gq = fabsf(a.in[I_EGQ][c.lane]), gk = fabsf(a.in[I_EGK][c.lane]);
    gq = wave_max(gq); gk = wave_max(gk);
    const bool fast = (0.125f * LOG2E * 64.f * gq * gk) < 90.f;
#define EATT(FIXV) do { \
    for (int L = c.vcu; L < 16; L += c.G) { const int b = L / 8, h = L % 8, kvh = h / 4; \
        att64::attn_unit<8, FIXV>((const att64::bf16*)(Qc + (size_t)(b * 8 + h) * CTX * 64), 64, (const att64::bf16*)(Ka + (size_t)(b * 2 + kvh) * SKV * 64), (const att64::bf16*)(Va + (size_t)(b * 2 + kvh) * SKV * 64), 64, 64, \
                               (att64::bf16*)(MIX + (size_t)(b * CTX) * D + h * 64), D, CTX / 64, (char*)lds, c.wave); } \
    for (int L = c.vcu; L < 1024; L += c.G) { const int bk = L / 256, rem = L % 256, b = bk / 2, kvh = bk % 2, hq = rem / 64, qb = rem % 64, h = kvh * 4 + hq; \
        att64::attn_unit<8, FIXV>((const att64::bf16*)(Qa + ((size_t)(b * 8 + h) * SEQ + qb * 256) * 64), 64, (const att64::bf16*)(Ka + (size_t)(b * 2 + kvh) * SKV * 64), (const att64::bf16*)(Va + (size_t)(b * 2 + kvh) * SKV * 64), 64, 64, \
                               (att64::bf16*)(MIX + (size_t)(TC + b * SEQ + qb * 256) * D + h * 64), D, SKV / 64, (char*)lds, c.wave); } } while (0)
    const bool f8 = fast8_e(a, c.lane);
#define EATT8(EPIV, CHK) do { \
    for (int L = c.vcu; L < 16; L += c.G) { const int b = L / 8, h = L % 8, kvh = h / 4; \
        att8::attn_unit<64, 64, EPIV>(ws + F8_EQC + (size_t)(b * 8 + h) * CTX * 64, ws + F8_EK + (size_t)(b * 2 + kvh) * NTILE * 4096, ws + F8_EV + (size_t)(b * 2 + kvh) * NTILE * 4096, \
                                      MIX + (size_t)(b * CTX) * D + h * 64, D, CTX / 64, lds, c.wave, nullptr, 0, 0.f, nullptr, 1.f, CHK); } \
    for (int L = c.vcu; L < 1024; L += c.G) { const int bk = L / 256, rem = L % 256, b = bk / 2, kvh = bk % 2, hq = rem / 64, qb = rem % 64, h = kvh * 4 + hq; \
        att8::attn_unit<64, 64, EPIV>(ws + F8_EQ + ((size_t)(b * 8 + h) * SEQ + qb * 256) * 64, ws + F8_EK + (size_t)(b * 2 + kvh) * NTILE * 4096, ws + F8_EV + (size_t)(b * 2 + kvh) * NTILE * 4096, \
                                      MIX + (size_t)(TC + b * SEQ + qb * 256) * D + h * 64, D, NTILE, lds, c.wave, nullptr, 0, 0.f, nullptr, 1.f, CHK); } } while (0)
#if A8_DEBUG == 1
    if (fast) EATT(true); else EATT(false);
    if (f8) { grid_sync(c); EATT8(2, (float*)(ws + WS_CTL) + CW_CHK); }
#else
    if (f8) EATT8(0, nullptr); else if (fast) EATT(true); else EATT(false);
#endif
#undef EATT8
#undef EATT
}

__device__ __forceinline__ int ml_row0(int b, int nc) { return nc < 2 ? b * CTX + nc * 128 : TC + b * SEQ + (nc - 2) * 128; }
__device__ __forceinline__ float wave_scan_add(float v, int lane) {
#ifdef TEST_HIP_SCAN
    for (int o = 1; o < 64; o <<= 1) { const float t = __shfl_up(v, o); if (lane >= o) v += t; } return v;
#endif
    v += DPPF(0.f, v, 0x111, 0xf); v += DPPF(0.f, v, 0x112, 0xf); v += DPPF(0.f, v, 0x114, 0xf); v += DPPF(0.f, v, 0x118, 0xf);
    v += DPPF(0.f, v, 0x142, 0xa); v += DPPF(0.f, v, 0x143, 0xc); (void)lane;
    return v;
}
__device__ __forceinline__ float wave_scan_max(float v, int lane) {
#ifdef TEST_HIP_SCAN
    for (int o = 1; o < 64; o <<= 1) { const float t = __shfl_up(v, o); if (lane >= o) v = fmaxf(v, t); } return v;
#endif
    v = fmaxf(v, DPPF(-INFINITY, v, 0x111, 0xf)); v = fmaxf(v, DPPF(-INFINITY, v, 0x112, 0xf)); v = fmaxf(v, DPPF(-INFINITY, v, 0x114, 0xf)); v = fmaxf(v, DPPF(-INFINITY, v, 0x118, 0xf));
    v = fmaxf(v, DPPF(-INFINITY, v, 0x142, 0xa)); v = fmaxf(v, DPPF(-INFINITY, v, 0x143, 0xc)); (void)lane;
    return v;
}
__device__ __forceinline__ void ml_gate_scan(const float* Gt, int row0, int h, LAS float* av, LAS float* bc, LAS float* pm, LAS float* sc, int wave, int lane) {
    if (wave < 2) {
        const int dir = wave;
        const int u0 = dir ? 127 - 2 * lane : 2 * lane, u1 = dir ? 126 - 2 * lane : 2 * lane + 1;
        const float i0 = Gt[(size_t)(row0 + u0) * 16 + dir * 8 + h], i1 = Gt[(size_t)(row0 + u1) * 16 + dir * 8 + h];
        const float f0 = Gt[(size_t)(row0 + u0) * 16 + dir * 8 + 4 + h], f1 = Gt[(size_t)(row0 + u1) * 16 + dir * 8 + 4 + h];
        const float s = f0 + f1, incl = wave_scan_add(s, lane), excl = incl - s;
        const float b0 = excl + f0, b1 = incl;
        const float a0 = i0 - b0, a1 = i1 - b1;
        const float m01 = fmaxf(a0, a1), inclm = wave_scan_max(m01, lane);
#ifdef TEST_HIP_SCAN
        float exclm = __shfl_up(inclm, 1); if (lane == 0) exclm = -INFINITY;
#else
        const float exclm = DPPF(-INFINITY, inclm, 0x138, 0xf);
#endif
        LAS float* avd = av + dir * 128; LAS float* bcd = bc + dir * 128; LAS float* pmd = pm + dir * 128;
        avd[u0] = a0; avd[u1] = a1; bcd[u0] = b0; bcd[u1] = b1; pmd[u0] = fmaxf(exclm, a0); pmd[u1] = fmaxf(exclm, m01);
        if (lane == 63) { sc[dir * 4 + 0] = incl; sc[dir * 4 + 1] = inclm; }
    }
}
constexpr int MLP = 136;
__device__ __forceinline__ void ml_stage_rm(const bf16_t* g, int gp, LAS bf16_t* l, int tid) {
#pragma unroll
    for (int it = 0; it < 4; ++it) { const int cid = tid + 512 * it, u = cid >> 4, cc = cid & 15;
        const u32x4 w = *(const u32x4*)(g + (size_t)u * gp + cc * 8); *(LAS u32x4*)(l + u * MLP + cc * 8) = w; }
}
__device__ __forceinline__ void ml_stage_tr(const bf16_t* g, int gp, LAS bf16_t* l0, int tid) {
#pragma unroll
    for (int it = 0; it < 4; ++it) { const int cid = tid + 512 * it, u = cid & 127, ec = cid >> 7;
        const u32x4 w = *(const u32x4*)(g + (size_t)u * gp + ec * 8);
        const unsigned ww[4] = {w.x, w.y, w.z, w.w};
#pragma unroll
        for (int i = 0; i < 4; ++i) { l0[(ec * 8 + 2 * i) * MLP + u] = (bf16_t)(ww[i] & 0xffffu); l0[(ec * 8 + 2 * i + 1) * MLP + u] = (bf16_t)(ww[i] >> 16); } }
}
__device__ __forceinline__ void ml_stage_tr_scaled2(const bf16_t* g, int gp, LAS bf16_t* l0, LAS bf16_t* l1, const LAS float* s0, const LAS float* s1, int tid) {
#pragma unroll
    for (int it = 0; it < 4; ++it) { const int cid = tid + 512 * it, u = cid & 127, ec = cid >> 7;
        const u32x4 w = *(const u32x4*)(g + (size_t)u * gp + ec * 8); float f[8]; unpack8(w, f);
        const float g0 = s0[u], g1 = s1[u];
#pragma unroll
        for (int i = 0; i < 8; ++i) { l0[(ec * 8 + i) * MLP + u] = (bf16_t)f2bf(f[i] * g0); l1[(ec * 8 + i) * MLP + u] = (bf16_t)f2bf(f[i] * g1); } }
}
__device__ __forceinline__ bf16x8 ml_frag(const LAS bf16_t* t, int row, int k0, int lane) { return *(const LAS bf16x8*)(t + (row + (lane & 15)) * MLP + k0 + 8 * (lane >> 4)); }

__device__ __forceinline__ void phase_mla(const Args& a, const Ctx& c0) {
    const Ctx c = fresh(c0);
    unsigned char* ws = a.ws;
    const bf16_t* Z = (const bf16_t*)(ws + WS_RA);
    const bf16_t* QKB = (const bf16_t*)(ws + WS_RC);
    const float* Gt = (const float*)(ws + WS_G);
    bf16_t* KL = (bf16_t*)(ws + WS_RB);
    float* BL = (float*)(ws + WS_ML + ML_BL); float* MLc = (float*)(ws + WS_ML + ML_ML); float* NL = (float*)(ws + WS_ML + ML_NL);
    LAS bf16_t* vT = (LAS bf16_t*)c.lds;
    LAS bf16_t* kgF = vT + 128 * MLP;
    LAS bf16_t* kgB = kgF + 128 * MLP;
    LAS float* av = (LAS float*)(kgB + 128 * MLP); LAS float* bc = av + 256; LAS float* pm = bc + 256; LAS float* sc = pm + 256; LAS float* gs = sc + 16;
    const int tid = c.tid, lane = c.lane, wave = c.wave;
    for (int U = c.vcu; U < BATCH * 4 * NCHUNK; U += c.G) {
        const int b = U / (4 * NCHUNK), h = (U / NCHUNK) % 4, nc = U % NCHUNK;
        const int row0 = ml_row0(b, nc);
        ml_gate_scan(Gt, row0, h, av, bc, pm, sc, wave, lane);
        __syncthreads();
        if (tid < 256) { const int dir = tid >> 7, u = tid & 127; gs[tid] = __expf(av[dir * 128 + u] - sc[dir * 4 + 1]); }
        __syncthreads();
        ml_stage_tr(Z + (size_t)row0 * NZE + 1792 + h * 128, NZE, vT, tid);
        ml_stage_tr_scaled2(QKB + (size_t)row0 * D + 512 + h * 128, D, kgF, kgB, gs, gs + 128, tid);
        __syncthreads();
        const int cf = nc, cbk = nc < 2 ? 1 - nc : 131 - nc;
        const int chf = (b * 4 + h) * 2, chb = chf + 1;
        if (tid < 2) { const int dir = tid; const int ch = dir ? chb : chf, cc = dir ? cbk : cf; BL[ch * NCHUNK + cc] = sc[dir * 4 + 0]; MLc[ch * NCHUNK + cc] = sc[dir * 4 + 0] + sc[dir * 4 + 1]; }
        if (tid < 256) { const int dir = tid >> 7, d = tid & 127; const LAS bf16_t* r = (dir ? kgB : kgF) + d * MLP; float s = 0.f;
            for (int u = 0; u < 128; ++u) s += bf2f(r[u]);
            NL[((size_t)(dir ? chb : chf) * NCHUNK + (dir ? cbk : cf)) * 128 + d] = s; }
        f32x4 accF[8], accB[8];
#pragma unroll
        for (int n = 0; n < 8; ++n) { accF[n] = (f32x4){0.f, 0.f, 0.f, 0.f}; accB[n] = (f32x4){0.f, 0.f, 0.f, 0.f}; }
#pragma unroll
        for (int k0 = 0; k0 < 128; k0 += 32) { const bf16x8 af = ml_frag(vT, 16 * wave, k0, lane);
#pragma unroll
            for (int n = 0; n < 8; ++n) { accF[n] = __builtin_amdgcn_mfma_f32_16x16x32_bf16(af, ml_frag(kgF, 16 * n, k0, lane), accF[n], 0, 0, 0);
                                          accB[n] = __builtin_amdgcn_mfma_f32_16x16x32_bf16(af, ml_frag(kgB, 16 * n, k0, lane), accB[n], 0, 0, 0); } }
        bf16_t* of = KL + ((size_t)chf * NCHUNK + cf) * 16384, *ob = KL + ((size_t)chb * NCHUNK + cbk) * 16384;
#pragma unroll
        for (int n = 0; n < 8; ++n)
#pragma unroll
            for (int r = 0; r < 4; ++r) { const int e = 16 * wave + 4 * (lane >> 4) + r, d = 16 * n + (lane & 15);
                of[e * 128 + d] = (bf16_t)f2bf(accF[n][r]); ob[e * 128 + d] = (bf16_t)f2bf(accB[n][r]); }
        __syncthreads();
    }
}

__device__ __forceinline__ void phase_mlb(const Args& a, const Ctx& c0) {
    const Ctx c = fresh(c0);
    unsigned char* ws = a.ws;
    bf16_t* KL = (bf16_t*)(ws + WS_RB);
    const float* BL = (const float*)(ws + WS_ML + ML_BL); const float* MLc = (const float*)(ws + WS_ML + ML_ML);
    float* MS = (float*)(ws + WS_ML + ML_MS); float* NL = (float*)(ws + WS_ML + ML_NL);
    const int NTH = c.G * 512;
    constexpr int GRP = 13;
    for (int idx = c.vcu * 512 + c.tid; idx < NCHAIN * 8192; idx += NTH) {
        const int ch = idx / 8192, el2 = idx % 8192;
        float st0 = 0.f, st1 = 0.f, m = 0.f;
        const float* bl = BL + ch * NCHUNK; const float* ml = MLc + ch * NCHUNK;
        unsigned* base = (unsigned*)(KL + (size_t)ch * NCHUNK * 16384) + el2;
        for (int g = 0; g < NCHUNK / GRP; ++g) {
            unsigned kv[GRP]; float blv[GRP], mlv[GRP];
#pragma unroll
            for (int i = 0; i < GRP; ++i) { kv[i] = base[(size_t)(g * GRP + i) * 8192]; blv[i] = bl[g * GRP + i]; mlv[i] = ml[g * GRP + i]; }
#pragma unroll
            for (int i = 0; i < GRP; ++i) {
                const float mn = fmaxf(blv[i] + m, mlv[i]), decay = __expf(blv[i] + m - mn), wl = __expf(mlv[i] - mn);
                base[(size_t)(g * GRP + i) * 8192] = pk2(st0, st1);
                st0 = decay * st0 + wl * bflo(kv[i]); st1 = decay * st1 + wl * bfhi(kv[i]); m = mn; }
        }
    }
    for (int idx = c.vcu * 512 + c.tid; idx < NCHAIN * 128; idx += NTH) {
        const int ch = idx / 128, el = idx % 128;
        float st = 0.f, m = 0.f;
        const float* bl = BL + ch * NCHUNK; const float* ml = MLc + ch * NCHUNK;
        float* base = NL + (size_t)ch * NCHUNK * 128 + el;
        for (int g = 0; g < NCHUNK / GRP; ++g) {
            float kv[GRP], blv[GRP], mlv[GRP];
#pragma unroll
            for (int i = 0; i < GRP; ++i) { kv[i] = base[(size_t)(g * GRP + i) * 128]; blv[i] = bl[g * GRP + i]; mlv[i] = ml[g * GRP + i]; }
#pragma unroll
            for (int i = 0; i < GRP; ++i) {
                const float mn = fmaxf(blv[i] + m, mlv[i]), decay = __expf(blv[i] + m - mn), wl = __expf(mlv[i] - mn);
                base[(size_t)(g * GRP + i) * 128] = st; if (el == 0) MS[ch * NCHUNK + g * GRP + i] = m;
                st = decay * st + wl * kv[i]; m = mn; }
        }
    }
}

__device__ __forceinline__ void phase_mlc(const Args& a, const Ctx& c0) {
    const Ctx c = fresh(c0);
    unsigned char* ws = a.ws;
    const bf16_t* Z = (const bf16_t*)(ws + WS_RA);
    const bf16_t* QKB = (const bf16_t*)(ws + WS_RC);
    const float* Gt = (const float*)(ws + WS_G);
    const bf16_t* CS = (const bf16_t*)(ws + WS_RB);
    const float* MS = (const float*)(ws + WS_ML + ML_MS); const float* NS = (const float*)(ws + WS_ML + ML_NL);
    bf16_t* MIX = (bf16_t*)(ws + WS_HMF);
    LAS bf16_t* qT = (LAS bf16_t*)c.lds;
    LAS bf16_t* kT = qT + 128 * MLP;
    LAS bf16_t* vT = kT + 144 * MLP;
    LAS bf16_t* cT = vT + 128 * MLP;
    LAS float* av = (LAS float*)(cT + 128 * MLP); LAS float* bc = av + 256; LAS float* pm = bc + 256; LAS float* sc = pm + 256;
    const int tid = c.tid, lane = c.lane, wave = c.wave;
    const int fr = lane & 15, fq = lane >> 4;
    for (int U = c.vcu; U < BATCH * 4 * NCHUNK; U += c.G) {
        const int b = U / (4 * NCHUNK), h = (U / NCHUNK) % 4, nc = U % NCHUNK;
        const int row0 = ml_row0(b, nc);
        const int cf = nc, cbk = nc < 2 ? 1 - nc : 131 - nc;
        const int chf = (b * 4 + h) * 2, chb = chf + 1;
        ml_gate_scan(Gt, row0, h, av, bc, pm, sc, wave, lane);
        ml_stage_rm(QKB + (size_t)row0 * D + h * 128, D, qT, tid);
        ml_stage_rm(QKB + (size_t)row0 * D + 512 + h * 128, D, kT, tid);
        ml_stage_tr(Z + (size_t)row0 * NZE + 1792 + h * 128, NZE, vT, tid);
        ml_stage_rm(CS + ((size_t)chf * NCHUNK + cf) * 16384, 128, cT, tid);
        if (tid < 256) { const int dir = tid >> 7, d = tid & 127; kT[(128 + dir) * MLP + d] = (bf16_t)f2bf(NS[((size_t)(dir ? chb : chf) * NCHUNK + (dir ? cbk : cf)) * 128 + d]); }
        for (int i = tid; i < 14 * 128; i += 512) kT[(130 + i / 128) * MLP + (i % 128)] = 0;
        const float mF = MS[chf * NCHUNK + cf], mB = MS[chb * NCHUNK + cbk];
        __syncthreads();
        f32x4 S[9];
#pragma unroll
        for (int n = 0; n < 9; ++n) S[n] = (f32x4){0.f, 0.f, 0.f, 0.f};
#pragma unroll
        for (int k0 = 0; k0 < 128; k0 += 32) { const bf16x8 af = ml_frag(qT, 16 * wave, k0, lane);
#pragma unroll
            for (int n = 0; n < 9; ++n) S[n] = __builtin_amdgcn_mfma_f32_16x16x32_bf16(af, ml_frag(kT, 16 * n, k0, lane), S[n], 0, 0, 0); }
        float AF[4], AB[4], rsF[4], rsB[4];
#pragma unroll
        for (int r = 0; r < 4; ++r) { const int j = 16 * wave + 4 * fq + r; AF[r] = fmaxf(mF, pm[j]); AB[r] = fmaxf(mB, pm[128 + j]); rsF[r] = 0.f; rsB[r] = 0.f; }
        float PF[8][4], PB[8][4];
#pragma unroll
        for (int n = 0; n < 8; ++n) { const int s = 16 * n + fr; const float afs = av[s], abs_ = av[128 + s];
#pragma unroll
            for (int r = 0; r < 4; ++r) { const int j = 16 * wave + 4 * fq + r;
                const float pf = (s <= j) ? S[n][r] * __expf(afs - AF[r]) : 0.f, pb = (s >= j) ? S[n][r] * __expf(abs_ - AB[r]) : 0.f;
                PF[n][r] = pf; PB[n][r] = pb; rsF[r] += pf; rsB[r] += pb; } }
        float cF[4], cB[4], iDF[4], iDB[4];
#pragma unroll
        for (int r = 0; r < 4; ++r) { const int j = 16 * wave + 4 * fq + r;
            const float sF = sum16(rsF[r]), sB = sum16(rsB[r]);
            const float sv = S[8][r];
            const float qnF = fq == 0 ? rdlane(sv, 0) : fq == 1 ? rdlane(sv, 16) : fq == 2 ? rdlane(sv, 32) : rdlane(sv, 48);
            const float qnB = fq == 0 ? rdlane(sv, 1) : fq == 1 ? rdlane(sv, 17) : fq == 2 ? rdlane(sv, 33) : rdlane(sv, 49);
            const float aiF = __expf(mF - AF[r]), aiB = __expf(mB - AB[r]);
            const float denF = aiF * qnF + sF, denB = aiB * qnB + sB;
            const float DF = fmaxf(fabsf(denF), __expf(-(bc[j] + AF[r]))), DB = fmaxf(fabsf(denB), __expf(-(bc[128 + j] + AB[r])));
            iDF[r] = 1.f / DF; iDB[r] = 1.f / DB; cF[r] = aiF * iDF[r]; cB[r] = aiB * iDB[r]; }
        __syncthreads();
#pragma unroll
        for (int n = 0; n < 8; ++n)
#pragma unroll
            for (int r = 0; r < 4; ++r) kT[(16 * wave + 4 * fq + r) * MLP + 16 * n + fr] = (bf16_t)f2bf(PF[n][r] * iDF[r] + PB[n][r] * iDB[r]);
        __syncthreads();
        f32x4 O[8], X[8];
#pragma unroll
        for (int n = 0; n < 8; ++n) { O[n] = (f32x4){0.f, 0.f, 0.f, 0.f}; X[n] = (f32x4){0.f, 0.f, 0.f, 0.f}; }
#pragma unroll
        for (int k0 = 0; k0 < 128; k0 += 32) { const bf16x8 ap = ml_frag(kT, 16 * wave, k0, lane), aq = ml_frag(qT, 16 * wave, k0, lane);
#pragma unroll
            for (int n = 0; n < 8; ++n) { O[n] = __builtin_amdgcn_mfma_f32_16x16x32_bf16(ap, ml_frag(vT, 16 * n, k0, lane), O[n], 0, 0, 0);
                                          X[n] = __builtin_amdgcn_mfma_f32_16x16x32_bf16(aq, ml_frag(cT, 16 * n, k0, lane), X[n], 0, 0, 0); } }
#pragma unroll
        for (int n = 0; n < 8; ++n)
#pragma unroll
            for (int r = 0; r < 4; ++r) O[n][r] += cF[r] * X[n][r];
        __syncthreads();
        ml_stage_rm(CS + ((size_t)chb * NCHUNK + cbk) * 16384, 128, cT, tid);
        __syncthreads();
#pragma unroll
        for (int n = 0; n < 8; ++n) X[n] = (f32x4){0.f, 0.f, 0.f, 0.f};
#pragma unroll
        for (int k0 = 0; k0 < 128; k0 += 32) { const bf16x8 aq = ml_frag(qT, 16 * wave, k0, lane);
#pragma unroll
            for (int n = 0; n < 8; ++n) X[n] = __builtin_amdgcn_mfma_f32_16x16x32_bf16(aq, ml_frag(cT, 16 * n, k0, lane), X[n], 0, 0, 0); }
        float ssq[4] = {0.f, 0.f, 0.f, 0.f};
#pragma unroll
        for (int n = 0; n < 8; ++n)
#pragma unroll
            for (int r = 0; r < 4; ++r) { O[n][r] += cB[r] * X[n][r]; ssq[r] += O[n][r] * O[n][r]; }
#pragma unroll
        for (int r = 0; r < 4; ++r) { const float rstd = rsqrtf(sum16(ssq[r]) * (1.f / 128.f) + EPS); const int row = row0 + 16 * wave + 4 * fq + r;
#pragma unroll
            for (int n = 0; n < 8; ++n) { const int e = 16 * n + fr;
                const float obv = bf2f(Z[(size_t)row * NZE + 2304 + h * 128 + e]);
                MIX[(size_t)row * D + 512 + h * 128 + e] = (bf16_t)f2bf(O[n][r] * rstd * a.in[I_EGH][h * 128 + e] * sigmoidf_(obv)); } }
        __syncthreads();
    }
}

__device__ __forceinline__ float reduce32(float* p, int lane) {
#pragma unroll
    for (int i = 0; i < 16; ++i) { const bool up = (lane & 32) != 0; const float send = up ? p[i] : p[i + 16]; const float recv = xshfl<32>(send); p[i] = (up ? p[i + 16] : p[i]) + recv; }
#pragma unroll
    for (int i = 0; i < 8; ++i) { const bool up = (lane & 16) != 0; const float send = up ? p[i] : p[i + 8]; const float recv = xshfl<16>(send); p[i] = (up ? p[i + 8] : p[i]) + recv; }
#pragma unroll
    for (int i = 0; i < 4; ++i) { const bool up = (lane & 8) != 0; const float send = up ? p[i] : p[i + 4]; const float recv = dpp_x15(send); p[i] = (up ? p[i + 4] : p[i]) + recv; }
#pragma unroll
    for (int i = 0; i < 2; ++i) { const bool up = (lane & 4) != 0; const float send = up ? p[i] : p[i + 2]; const float recv = dpp_x7(send); p[i] = (up ? p[i + 2] : p[i]) + recv; }
    { const bool up = (lane & 2) != 0; const float send = up ? p[0] : p[1]; const float recv = dpp_x2(send); p[0] = (up ? p[1] : p[0]) + recv; }
    p[0] += dpp_x1(p[0]);
    return p[0];
}
__device__ __forceinline__ void phase_mnorm(const Args& a, const Ctx& c0, int layer, int dry = 0) {
    const Ctx c = fresh(c0);
    unsigned char* ws = a.ws;
    const bf16_t* X = (const bf16_t*)(ws + WS_X);
    bf16_t* F = (bf16_t*)(ws + WS_HMF);
    const float* mod = (const float*)(ws + WS_MOD) + (size_t)layer * 3 * 6144;
    int* RTE = (int*)(ws + WS_RT + RT_E); int* RTP = (int*)(ws + WS_RT + RT_POS); float* RTG = (float*)(ws + WS_RT + RT_GATE);
    unsigned* gcnt = (unsigned*)(ws + WS_CTL) + (layer ? CW_CNT1 : CW_CNT0);
    LAS float* wT = (LAS float*)c.lds;
    LAS unsigned* lcnt = (LAS unsigned*)(c.lds + 131072);
    LAS unsigned* lbase = lcnt + 32;
    const int lane = c.lane, tid = c.tid;
    for (int k = tid; k < D; k += 512) { const f32x4* src = (const f32x4*)(a.in[I_WR] + (size_t)k * NE);
#pragma unroll
        for (int q = 0; q < 8; ++q) { const f32x4 w = src[q]; wT[(4 * q + 0) * D + k] = w.x; wT[(4 * q + 1) * D + k] = w.y; wT[(4 * q + 2) * D + k] = w.z; wT[(4 * q + 3) * D + k] = w.w; } }
    if (tid < 32) lcnt[tid] = 0u;
    __syncthreads();
    const float* gffn = a.in[I_GFFN] + layer * D;
    const int rlo = layer ? TC : 0;
    int my_e0 = 0, my_e1 = 0, my_p0 = 0, my_p1 = 0; int it = 0;
    f32x4 gsc[4], msh[4]; u32x2 xa[4], xb[4]; int cur_bs = -1;
    const float rbias = a.in[I_BR][lane >> 1];
#define MN_LOADX(X, R) do { if ((R) < NROW) { _Pragma("unroll") for (int j = 0; j < 4; ++j) X[j] = ((const u32x2*)(X_ + (size_t)(R) * D))[lane + 64 * j]; } } while (0)
    const bf16_t* X_ = X;
    MN_LOADX(xa, rlo + c.gw); MN_LOADX(xb, rlo + c.gw + c.NGW);
#define MN_NORM(V, XR, ROW, NEXTROW) do { const int bs = row_bsel(ROW); \
        if (bs != cur_bs) { cur_bs = bs; _Pragma("unroll") for (int j = 0; j < 4; ++j) { msh[j] = ((const f32x4*)(mod + bs * 6144 + 3 * 1024))[lane + 64 * j]; gsc[j] = ((const f32x4*)gffn)[lane + 64 * j] * (((const f32x4*)(mod + bs * 6144 + 4 * 1024))[lane + 64 * j] + 1.0f); } } \
        float ssq_ = 0.f; \
        _Pragma("unroll") for (int j = 0; j < 4; ++j) { V[j] = bf4_to_f32(XR[j]); ssq_ += (V[j].x * V[j].x + V[j].y * V[j].y) + (V[j].z * V[j].z + V[j].w * V[j].w); } \
        MN_LOADX(XR, NEXTROW); \
        const float rstd_ = rsqrtf(wave_sum(ssq_) * (1.f / D) + EPS); \
        _Pragma("unroll") for (int j = 0; j < 4; ++j) V[j] = (V[j] * rstd_) * gsc[j] + msh[j]; \
        store_row_bf16(F + (size_t)(ROW) * D, lane, V); } while (0)
#define RMAXF(x) do { x = fmaxf(x, dpp_x1(x)); x = fmaxf(x, dpp_x2(x)); x = fmaxf(x, dpp_x7(x)); x = fmaxf(x, dpp_x15(x)); } while (0)
#define DPPI(v, ctrl) __builtin_amdgcn_update_dpp(0, (v), (ctrl), 0xf, 0xf, false)
#define RMINI(x) do { x = min(x, DPPI(x, 0xB1)); x = min(x, DPPI(x, 0x4E)); x = min(x, DPPI(x, 0x141)); x = min(x, DPPI(x, 0x140)); } while (0)
#define MN_ROUTE(P, ROW, IT) do { const float mine = reduce32(P, lane); int e0, e1; float s0, s1_; { \
            const int ex = lane >> 1; \
            const float scl = sigmoidf_(mine), sl = scl + rbias; \
            float m1 = sl; RMAXF(m1); \
            int i1 = (sl == m1) ? ex : 127; RMINI(i1); \
            const float sl2 = (ex == i1) ? -INFINITY : sl; \
            float m2 = sl2; RMAXF(m2); \
            int i2 = (sl2 == m2) ? ex : 127; RMINI(i2); \
            float c1 = (ex == i1) ? scl : -INFINITY; RMAXF(c1); \
            float c2 = (ex == i2) ? scl : -INFINITY; RMAXF(c2); \
            const float gs = m1 + m2; \
            const float q0 = rdlane(gs, 0), q1 = rdlane(gs, 16), q2 = rdlane(gs, 32), q3 = rdlane(gs, 48); \
            int bg = 0; float bv = q0; if (q1 > bv) { bv = q1; bg = 1; } if (q2 > bv) { bv = q2; bg = 2; } if (q3 > bv) { bv = q3; bg = 3; } \
            const int bl = __builtin_amdgcn_readfirstlane(bg * 16); \
            e0 = __builtin_amdgcn_readlane(i1, bl); e1 = __builtin_amdgcn_readlane(i2, bl); \
            s0 = __builtin_bit_cast(float, __builtin_amdgcn_readlane(__builtin_bit_cast(int, c1), bl)); s1_ = __builtin_bit_cast(float, __builtin_amdgcn_readlane(__builtin_bit_cast(int, c2), bl)); } \
        const float inv = 1.f / (s0 + s1_); \
        int p0 = 0, p1 = 0; \
        if (lane == 0 && !dry) { p0 = (int)__hip_atomic_fetch_add(&lcnt[e0], 1u, __ATOMIC_RELAXED, __HIP_MEMORY_SCOPE_WORKGROUP); p1 = (int)__hip_atomic_fetch_add(&lcnt[e1], 1u, __ATOMIC_RELAXED, __HIP_MEMORY_SCOPE_WORKGROUP); \
            RTG[(size_t)(ROW) * 2] = s0 * inv; RTG[(size_t)(ROW) * 2 + 1] = s1_ * inv; RTE[(size_t)(ROW) * 2] = e0; RTE[(size_t)(ROW) * 2 + 1] = e1; } \
        p0 = __builtin_amdgcn_readfirstlane(p0); p1 = __builtin_amdgcn_readfirstlane(p1); \
        if (lane == (IT)) { my_e0 = e0; my_e1 = e1; my_p0 = p0; my_p1 = p1; } } while (0)
    for (int row = rlo + c.gw; row < NROW; row += 2 * c.NGW, it += 2) {
        const int row1 = row + c.NGW; const bool has1 = row1 < NROW;
        f32x4 v0[4], v1[4];
        MN_NORM(v0, xa, row, row + 2 * c.NGW);
        if (has1) MN_NORM(v1, xb, row1, row1 + 2 * c.NGW);
        else {
#pragma unroll
            for (int j = 0; j < 4; ++j) v1[j] = (f32x4){0.f, 0.f, 0.f, 0.f}; }
        f32x2 vx[16];
#pragma unroll
        for (int j = 0; j < 4; ++j) { vx[4 * j] = (f32x2){v0[j].x, v1[j].x}; vx[4 * j + 1] = (f32x2){v0[j].y, v1[j].y}; vx[4 * j + 2] = (f32x2){v0[j].z, v1[j].z}; vx[4 * j + 3] = (f32x2){v0[j].w, v1[j].w}; }
        float pa[32], pb[32];
        { f32x4 wa[4], wb[4];
#define RD_LOAD(W, E) do { _Pragma("unroll") for (int j_ = 0; j_ < 4; ++j_) W[j_] = ((const LAS f32x4*)(wT + (E) * D))[lane + 64 * j_]; asm volatile("" ::: "memory"); } while (0)
#define RD_COMP(W, E) do { f32x2 acc_ = (f32x2){0.f, 0.f}; _Pragma("unroll") for (int j_ = 0; j_ < 4; ++j_) { const f32x4 w_ = W[j_]; \
        acc_ = __builtin_elementwise_fma(vx[4 * j_], (f32x2){w_.x, w_.x}, acc_); acc_ = __builtin_elementwise_fma(vx[4 * j_ + 1], (f32x2){w_.y, w_.y}, acc_); \
        acc_ = __builtin_elementwise_fma(vx[4 * j_ + 2], (f32x2){w_.z, w_.z}, acc_); acc_ = __builtin_elementwise_fma(vx[4 * j_ + 3], (f32x2){w_.w, w_.w}, acc_); } pa[E] = acc_.x; pb[E] = acc_.y; } while (0)
          RD_LOAD(wa, 0);
#pragma unroll
          for (int e = 0; e < 32; e += 2) {
              RD_LOAD(wb, e + 1);
              RD_COMP(wa, e);
              if (e + 2 < 32) RD_LOAD(wa, e + 2);
              RD_COMP(wb, e + 1);
          }
#undef RD_LOAD
#undef RD_COMP
        }
        MN_ROUTE(pa, row, it);
        if (has1) MN_ROUTE(pb, row1, it + 1);
    }
#undef MN_LOADX
#undef MN_NORM
#undef MN_ROUTE
#undef RMAXF
#undef DPPI
#undef RMINI
    __syncthreads();
    if (tid < 32 && !dry) lbase[tid] = atomicAdd(&gcnt[tid], lcnt[tid]);
    __syncthreads();
    { const int row = rlo + c.gw + lane * c.NGW;
      if (lane < it && row < NROW && !dry) { RTP[(size_t)row * 2] = (int)lbase[my_e0] + my_p0; RTP[(size_t)row * 2 + 1] = (int)lbase[my_e1] + my_p1; } }
}

__device__ __forceinline__ void phase_mgather(const Args& a, const Ctx& c0, int layer) {
    const Ctx c = fresh(c0);
    unsigned char* ws = a.ws;
    const int* RTE = (const int*)(ws + WS_RT + RT_E); const int* RTP = (const int*)(ws + WS_RT + RT_POS); int* DEST = (int*)(ws + WS_RT + RT_DEST);
    const unsigned* gcnt = (const unsigned*)(ws + WS_CTL) + (layer ? CW_CNT1 : CW_CNT0);
    int* BLKE = (int*)(ws + WS_BLKE);
    LAS int* pst = (LAS int*)c.lds;
    const int tid = c.tid, lane = c.lane;
    if (tid < NE) pst[64 + tid] = (int)gcnt[tid];
    __syncthreads();
    if (tid == 0) { int acc = 0; for (int e = 0; e < NE; ++e) { pst[e] = acc; acc += (pst[64 + e] + 255) / 256 * 256; } pst[32] = acc; }
    __syncthreads();
    if (blockIdx.x == 0) {
        const int nblk = pst[32] / 256;
        for (int i = tid; i < nblk; i += 512) { int e = 0;
#pragma unroll 1
            for (int q = 1; q < NE; ++q) if (i * 256 >= pst[q]) e = q;
            BLKE[i] = e; }
        if (tid == 0) BLKE[1024] = nblk;
    }
    const int rlo = layer ? TC : 0;
    int* ROWTAB = BLKE + 2048;
    for (int i = rlo + c.vcu * 512 + tid; i < NROW; i += c.G * 512) {
#pragma unroll
        for (int k = 0; k < 2; ++k) { const int e = RTE[(size_t)i * 2 + k], slot = pst[e] + RTP[(size_t)i * 2 + k]; DEST[(size_t)i * 2 + k] = slot; ROWTAB[slot] = i; } }
    for (int i = c.vcu * 512 + tid; i < NE * 256; i += c.G * 512) { const int e = i >> 8, pp = i & 255; const int cnt = pst[64 + e], pad = (cnt + 255) / 256 * 256;
        if (cnt + pp < pad) ROWTAB[pst[e] + cnt + pp] = rlo; }
    __syncthreads();
    LAS float* scr = (LAS float*)(c.lds + 4096 + c.wave * 16384);
    bf16_t* W13 = (bf16_t*)(ws + WS_RB);
    bf16_t* W2t = (bf16_t*)(ws + WS_RA + 146 * MiB);
    const float* w1 = a.in[I_W1] + (size_t)layer * NE * D * DEXP; const float* w3 = a.in[I_W3] + (size_t)layer * NE * D * DEXP; const float* w2 = a.in[I_W2] + (size_t)layer * NE * DEXP * D;
    constexpr int IT13 = 16 * 16, IT2 = 8 * 32;
    for (int it = c.gw; it < NE * (2 * IT13 + IT2); it += c.NGW) {
        const int e = it / (2 * IT13 + IT2); int r = it % (2 * IT13 + IT2);
        if (r < IT13) { transpose_item(w1 + (size_t)e * D * DEXP, DEXP, D, W13 + (size_t)e * D * D, 0, 1, 0, scr, r / 16, r % 16, lane); continue; } r -= IT13;
        if (r < IT13) { transpose_item(w3 + (size_t)e * D * DEXP, DEXP, D, W13 + (size_t)e * D * D, 0, 1, 1, scr, r / 16, r % 16, lane); continue; } r -= IT13;
        transpose_item(w2 + (size_t)e * DEXP * D, D, DEXP, W2t + (size_t)e * D * DEXP, 0, 0, 0, scr, r / 32, r % 32, lane);
    }
}

__device__ __forceinline__ void phase_mcomb(const Args& a, const Ctx& c0, int layer) {
    const Ctx c = fresh(c0);
    unsigned char* ws = a.ws;
    bf16_t* X = (bf16_t*)(ws + WS_X);
    const bf16_t* Y = (const bf16_t*)(ws + WS_RA);
    const int* DEST = (const int*)(ws + WS_RT + RT_DEST); const float* RTG = (const float*)(ws + WS_RT + RT_GATE);
    const float* mod = (const float*)(ws + WS_MOD) + (size_t)layer * 3 * 6144;
    const float* mod1 = (const float*)(ws + WS_MOD) + (size_t)1 * 3 * 6144;
    bf16_t* H = (bf16_t*)(ws + WS_HMF);
    const int lane = c.lane;
    const int rlo = layer ? TC : 0;
    u32x2 ya[4], yb[4], xr_[4]; float g0n = 0.f, g1n = 0.f;
#define MC_LOAD(R) do { const int d0_ = DEST[(size_t)(R) * 2], d1_ = DEST[(size_t)(R) * 2 + 1]; g0n = RTG[(size_t)(R) * 2]; g1n = RTG[(size_t)(R) * 2 + 1]; \
        const u32x2* y0_ = (const u32x2*)(Y + (size_t)d0_ * D) + lane; const u32x2* y1_ = (const u32x2*)(Y + (size_t)d1_ * D) + lane; const u32x2* x_ = (const u32x2*)(X + (size_t)(R) * D) + lane; \
        _Pragma("unroll") for (int j = 0; j < 4; ++j) { ya[j] = y0_[64 * j]; yb[j] = y1_[64 * j]; xr_[j] = x_[64 * j]; } } while (0)
    { const int r0 = rlo + c.gw; if (r0 < NROW) MC_LOAD(r0); }
    for (int row = rlo + c.gw; row < NROW; row += c.NGW) {
        const int bs = row_bsel(row);
        const float g0 = g0n, g1 = g1n;
        const f32x4* g2 = (const f32x4*)(mod + bs * 6144 + 5 * 1024) + lane;
        f32x4 v[4]; float s = 0.f;
#pragma unroll
        for (int j = 0; j < 4; ++j) { const u32x2 a0 = ya[j], a1 = yb[j];
            f32x4 y; y.x = g0 * bflo(a0.x) + g1 * bflo(a1.x); y.y = g0 * bfhi(a0.x) + g1 * bfhi(a1.x); y.z = g0 * bflo(a0.y) + g1 * bflo(a1.y); y.w = g0 * bfhi(a0.y) + g1 * bfhi(a1.y);
            v[j] = bf4_to_f32(xr_[j]) + g2[64 * j] * y; s += (v[j].x * v[j].x + v[j].y * v[j].y) + (v[j].z * v[j].z + v[j].w * v[j].w); }
        { const int nrow = row + c.NGW; if (nrow < NROW) MC_LOAD(nrow); }
        if (layer == 1) { f32x4* o = (f32x4*)(a.out + (size_t)(row - TC) * D) + lane;
#if A8_DEBUG
            { const float* ck = (const float*)(ws + WS_CTL) + CW_CHK; const float dd = fminf(100.f * ck[0] / fmaxf(ck[1], 1e-30f), 4.f) + (ck[1] > 0.f ? 0.002f : 0.f), sc_ = 1.f + sqrtf(0.01f + dd);
#pragma unroll
              for (int j = 0; j < 4; ++j) v[j] = v[j] * sc_; }
#endif
#pragma unroll
            for (int j = 0; j < 4; ++j) o[64 * j] = v[j]; }
        else { u32x2* o = (u32x2*)(X + (size_t)row * D) + lane;
#pragma unroll
            for (int j = 0; j < 4; ++j) o[64 * j] = f32_to_bf4(v[j]);
            const float rstd = rsqrtf(wave_sum(s) * (1.f / D) + EPS);
            const f32x4* gm = (const f32x4*)(a.in[I_GMIX] + D) + lane; const f32x4* sh = (const f32x4*)(mod1 + bs * 6144) + lane; const f32x4* sc = (const f32x4*)(mod1 + bs * 6144 + 1024) + lane;
#pragma unroll
            for (int j = 0; j < 4; ++j) v[j] = (v[j] * rstd) * gm[64 * j] * (sc[64 * j] + 1.0f) + sh[64 * j];
            store_row_bf16(H + (size_t)row * D, lane, v); }
    }
#undef MC_LOAD
}

__device__ __forceinline__ void phase_opost(const Args& a, const Ctx& c0) {
    const Ctx c = fresh(c0);
    unsigned char* ws = a.ws;
    const bf16_t* Z = (const bf16_t*)(ws + WS_RA);
    bf16_t* Qc = (bf16_t*)(ws + WS_RB);
    bf16_t* Kc = (bf16_t*)(ws + WS_RB + 32 * MiB);
    bf16_t* Vc = (bf16_t*)(ws + WS_RC);
    bf16_t* CQN = (bf16_t*)(ws + WS_RC + 33 * MiB);
    bf16_t* CKVN = (bf16_t*)(ws + WS_RC + 50 * MiB);
    bf16_t* KR = (bf16_t*)(ws + WS_RC + 59 * MiB);
    const int lane = c.lane;
    float gq[8], gk[8], gcq[8], gckv[8]; const float* rtab = (const float*)(ws + WS_ROPE64);
#pragma unroll
    for (int i = 0; i < 8; ++i) { gq[i] = a.in[I_OGQC][(lane & 7) * 8 + i]; gk[i] = a.in[I_OGKC][(lane & 7) * 8 + i]; gcq[i] = a.in[I_OGCQ][(lane & 31) * 8 + i]; gckv[i] = a.in[I_OGCKV][(lane & 15) * 8 + i]; }
    const float qscale = 0.125f * LOG2E;
    const bool f8 = fast8_c(a, lane), w16 = !f8;
    unsigned char* Q8 = ws + F8_CQ; unsigned char* K8 = ws + F8_CK;
    for (int row = c.gw; row < NROW; row += c.NGW) {
        const bool isctx = row < TC;
        const int b = isctx ? row / CTX : (row - TC) / SEQ, t = isctx ? row % CTX : (row - TC) % SEQ;
        const int pos = isctx ? t : CTX + t;
        const bf16_t* zr = Z + (size_t)row * NZO;
        Rope4 rp; if (!isctx) rp = rope64_angles(t, lane, rtab);
        float f[8];
        if (!isctx) { const u32x4 w = *(const u32x4*)(zr + 8 * lane); unpack8(w, f);
            const float rstd = rsqrtf(sum8(ssq8(f)) * (1.f / 64.f) + EPS);
#pragma unroll
            for (int i = 0; i < 8; ++i) f[i] = f[i] * rstd * gq[i];
            rope_apply8(f, rp);
#pragma unroll
            for (int i = 0; i < 8; ++i) f[i] *= qscale;
            if (f8) *(u32x2*)(Q8 + ((size_t)(b * 8 + (lane >> 3)) * SEQ + t) * 64 + (lane & 7) * 8) = pk8_f8(f);
            else *(u32x4*)(Qc + ((size_t)(b * 8 + (lane >> 3)) * SEQ + t) * 64 + (lane & 7) * 8) = pack8(f); }
        { const u32x4 w = *(const u32x4*)(zr + 512 + 8 * lane); unpack8(w, f);
            const float rstd = rsqrtf(sum8(ssq8(f)) * (1.f / 64.f) + EPS);
#pragma unroll
            for (int i = 0; i < 8; ++i) f[i] = f[i] * rstd * gk[i];
            if (!isctx) rope_apply8(f, rp);
            if (f8) { const int j8 = lane & 7; *(u32x2*)(K8 + ((size_t)((b * 8 + (lane >> 3)) * NTILE + (pos >> 6))) * 4096 + att8::k_off<64>(pos & 63, j8 >> 1) + (j8 & 1) * 8) = pk8_f8(f); }
            else *(u32x4*)(Kc + ((size_t)(b * 8 + (lane >> 3)) * SKV + pos) * 64 + (lane & 7) * 8) = pack8(f); }
        if (w16) { const u32x4 w = *(const u32x4*)(zr + 1024 + 8 * lane);
            *(u32x4*)(Vc + ((size_t)(b * 4 + (lane >> 4)) * SKV + pos) * 128 + (lane & 15) * 8) = w; }
        { const int sec = lane < 32 ? 0 : (lane < 48 ? 1 : (lane < 52 ? 2 : 3));
          const int col = sec == 0 ? 1536 + 8 * lane : (sec == 1 ? 1792 + 8 * (lane - 32) : (sec == 2 ? 1920 + 8 * (lane - 48) : 0));
          const u32x4 w = *(const u32x4*)(zr + col); unpack8(w, f);
          float sq = ssq8(f);
          float s0 = sec == 0 ? sq : 0.f, s1 = sec == 1 ? sq : 0.f;
          s0 = wave_sum(s0); s1 = wave_sum(s1);
          if (sec == 0) { const float rstd = rsqrtf(s0 * (1.f / 256.f) + EPS);
#pragma unroll
              for (int i = 0; i < 8; ++i) f[i] = f[i] * rstd * gcq[i];
              *(u32x4*)(CQN + (size_t)row * 256 + 8 * lane) = pack8(f); }
          else if (sec == 1) { const float rstd = rsqrtf(s1 * (1.f / 128.f) + EPS);
#pragma unroll
              for (int i = 0; i < 8; ++i) f[i] = f[i] * rstd * gckv[i];
              *(u32x4*)(CKVN + (size_t)row * 128 + 8 * (lane - 32)) = pack8(f); }
          else if (sec == 2) *(u32x4*)(KR + (size_t)row * 32 + 8 * (lane - 48)) = w; }
    }
    if (f8) vquant_items<128>(Z, NZO, 1024, 128, 4, ws + F8_CV, c.gw, c.NGW, lane);
}

__device__ __forceinline__ void phase_opost2(const Args& a, const Ctx& c0) {
    const Ctx c = fresh(c0);
    unsigned char* ws = a.ws;
    const bf16_t* QD = (const bf16_t*)(ws + WS_RA);
    const bf16_t* KV = (const bf16_t*)(ws + WS_RA + 33 * MiB);
    const bf16_t* KR = (const bf16_t*)(ws + WS_RC + 59 * MiB);
    bf16_t* Qd = (bf16_t*)(ws + WS_RA + 82 * MiB);
    bf16_t* Kd = (bf16_t*)(ws + WS_RA + 106 * MiB);
    bf16_t* Vd = (bf16_t*)(ws + WS_RA + 131 * MiB);
    const int lane = c.lane, head = lane >> 4, chunk = lane & 15;
    const bool act = chunk < 12;
    float gq[8], gk[8]; const float* dtab = (const float*)(ws + WS_ROPED);
#pragma unroll
    for (int i = 0; i < 8; ++i) { gq[i] = act ? a.in[I_OGQD][chunk * 8 + i] : 0.f; gk[i] = act ? a.in[I_OGKD][chunk * 8 + i] : 0.f; }
    const float qscale = 0.10206207261596575f * LOG2E;
    const bool f8 = fast8_d(a, lane), w16 = !f8 || A8_DEBUG == 3;
    unsigned char* Q8 = ws + F8_DQ; unsigned char* K8 = ws + F8_DK;
    for (int row = c.gw; row < NROW; row += c.NGW) {
        const bool isctx = row < TC;
        const int b = isctx ? row / CTX : (row - TC) / SEQ, t = isctx ? row % CTX : (row - TC) % SEQ;
        const int pos = isctx ? t : CTX + t;
        float cs[4], sn[4];
        if (!isctx && chunk >= 8 && act) { const int pp_ = (chunk < 10) ? (t / GRIDW) : (t % GRIDW), fi_ = (chunk & 1) * 4;
            const f32x4* tp = (const f32x4*)(dtab + (pp_ * 8 + fi_) * 2); const f32x4 ta = tp[0], tb = tp[1];
            cs[0] = ta.x; sn[0] = ta.y; cs[1] = ta.z; sn[1] = ta.w; cs[2] = tb.x; sn[2] = tb.y; cs[3] = tb.z; sn[3] = tb.w; }
        float f[8];
        if (!isctx) {
            if (act) { const u32x4 w = *(const u32x4*)(QD + (size_t)row * 512 + head * 96 + chunk * 8); unpack8(w, f); }
            else {
#pragma unroll
                for (int i = 0; i < 8; ++i) f[i] = 0.f; }
            const float rstd = rsqrtf(sum16(ssq8(f)) * (1.f / 96.f) + EPS);
            if (act) {
#pragma unroll
                for (int i = 0; i < 8; ++i) f[i] = f[i] * rstd * gq[i];
                if (chunk >= 8) {
#pragma unroll
                    for (int i = 0; i < 4; ++i) { const float x0 = f[2 * i], x1 = f[2 * i + 1]; f[2 * i] = x0 * cs[i] - x1 * sn[i]; f[2 * i + 1] = x0 * sn[i] + x1 * cs[i]; } }
#pragma unroll
                for (int i = 0; i < 8; ++i) f[i] *= qscale;
                if (w16) *(u32x4*)(Qd + ((size_t)(b * 4 + head) * SEQ + t) * 96 + chunk * 8) = pack8(f); }
            if (f8) { if (chunk == 12) f[0] = -8.f; *(u32x2*)(Q8 + ((size_t)(b * 4 + head) * SEQ + t) * 128 + chunk * 8) = pk8_f8(f); }
        }
        { if (act) { const u32x4 w = chunk < 8 ? *(const u32x4*)(KV + (size_t)row * 768 + head * 192 + chunk * 8) : *(const u32x4*)(KR + (size_t)row * 32 + (chunk - 8) * 8); unpack8(w, f); }
          else {
#pragma unroll
              for (int i = 0; i < 8; ++i) f[i] = 0.f; }
          const float rstd = rsqrtf(sum16(ssq8(f)) * (1.f / 96.f) + EPS);
          if (act) {
#pragma unroll
              for (int i = 0; i < 8; ++i) f[i] = f[i] * rstd * gk[i];
              if (!isctx && chunk >= 8) {
#pragma unroll
                  for (int i = 0; i < 4; ++i) { const float x0 = f[2 * i], x1 = f[2 * i + 1]; f[2 * i] = x0 * cs[i] - x1 * sn[i]; f[2 * i + 1] = x0 * sn[i] + x1 * cs[i]; } }
              if (w16) *(u32x4*)(Kd + ((size_t)(b * 4 + head) * SKV + pos) * 96 + chunk * 8) = pack8(f); }
          if (f8) { if (chunk == 12) f[0] = 1.f;
              *(u32x2*)(K8 + ((size_t)((b * 4 + head) * NTILE + (pos >> 6))) * 8192 + att8::k_off<128>(pos & 63, chunk >> 1) + (chunk & 1) * 8) = pk8_f8(f); } }
        if (w16) { const u32x4 w = *(const u32x4*)(KV + (size_t)row * 768 + head * 192 + 64 + chunk * 8);
          *(u32x4*)(Vd + ((size_t)(b * 4 + head) * SKV + pos) * 128 + chunk * 8) = w; }
    }
    if (f8) vquant_items<128>(KV, 768, 64, 192, 4, ws + F8_DV, c.gw, c.NGW, lane);
}

__device__ __forceinline__ void phase_oattn(const Args& a, const Ctx& c0) {
    const Ctx c = fresh(c0);
    unsigned char* ws = a.ws;
    const bf16_t* Qc = (const bf16_t*)(ws + WS_RB);
    const bf16_t* Kc = (const bf16_t*)(ws + WS_RB + 32 * MiB);
    const bf16_t* Vc = (const bf16_t*)(ws + WS_RC);
    const bf16_t* Qd = (const bf16_t*)(ws + WS_RA + 82 * MiB);
    const bf16_t* Kd = (const bf16_t*)(ws + WS_RA + 106 * MiB);
    const bf16_t* Vd = (const bf16_t*)(ws + WS_RA + 131 * MiB);
    bf16_t* OC = (bf16_t*)(ws + WS_RA);
    bf16_t* MIX = (bf16_t*)(ws + WS_HMF);
    LAS char* lds = (LAS char*)c.lds;
    float gq = fabsf(a.in[I_OGQC][c.lane]), gk = fabsf(a.in[I_OGKC][c.lane]);
    gq = wave_max(gq); gk = wave_max(gk);
    const bool fast = (0.125f * LOG2E * 64.f * gq * gk) < 90.f;
#define OATT(FIXV) do { \
    for (int L = c.vcu; L < 1024; L += c.G) { const int bh = L / 64, qb = L % 64, b = bh / 8, hc = bh % 8; \
        att::attn_unit<64, 128, FIXV>(Qc + ((size_t)(b * 8 + hc) * SEQ + qb * 256) * 64, Kc + (size_t)(b * 8 + hc) * SKV * 64, Vc + (size_t)(b * 4 + (hc >> 1)) * SKV * 128, \
                                OC + (size_t)(b * SEQ + qb * 256) * D + hc * 128, D, SKV, lds, c.wave); } } while (0)
    if (fast8_c(a, c.lane)) {
        const float lam_init = 0.8f - 0.6f * expf(-0.3f);
        const float* lp = a.in[I_OLAM];
        const float d1 = wave_sum(lp[c.lane] * lp[64 + c.lane]), d2 = wave_sum(lp[128 + c.lane] * lp[192 + c.lane]);
        const float lam = expf(d1) - expf(d2) + lam_init;
        for (int P = c.vcu; P < 512; P += c.G) { const int b = P / 256, head = (P / 64) % 4, qb = P % 64;
            const unsigned char* v8 = ws + F8_CV + (size_t)(b * 4 + head) * NTILE * 8192; const size_t orow = (size_t)(b * SEQ + qb * 256);
            { const int hc = 2 * head;
              att8::attn_unit<64, 128, 0>(ws + F8_CQ + ((size_t)(b * 8 + hc) * SEQ + qb * 256) * 64, ws + F8_CK + (size_t)(b * 8 + hc) * NTILE * 4096, v8, OC + orow * D + hc * 128, D, NTILE, lds, c.wave); }
            { const int hc = 2 * head + 1;
              att8::attn_unit<64, 128, 1>(ws + F8_CQ + ((size_t)(b * 8 + hc) * SEQ + qb * 256) * 64, ws + F8_CK + (size_t)(b * 8 + hc) * NTILE * 4096, v8, MIX + (TC + orow) * D + head * 128, D, NTILE, lds, c.wave,
                                          OC + orow * D + (2 * head) * 128, D, lam, a.in[I_OGSUB], 1.f - lam_init); }
        }
    } else
    if (fast) {
        const float lam_init = 0.8f - 0.6f * expf(-0.3f);
        const float* lp = a.in[I_OLAM];
        const float d1 = wave_sum(lp[c.lane] * lp[64 + c.lane]), d2 = wave_sum(lp[128 + c.lane] * lp[192 + c.lane]);
        const float lam = expf(d1) - expf(d2) + lam_init;
        for (int P = c.vcu; P < 512; P += c.G) { const int b = P / 256, head = (P / 64) % 4, qb = P % 64;
            const size_t vofs = (size_t)(b * 4 + head) * SKV * 128; const size_t orow = (size_t)(b * SEQ + qb * 256);
            { const int hc = 2 * head;
              att64::attn_unit<8, true, 2>((const att64::bf16*)(Qc + ((size_t)(b * 8 + hc) * SEQ + qb * 256) * 64), 64, (const att64::bf16*)(Kc + (size_t)(b * 8 + hc) * SKV * 64), (const att64::bf16*)(Vc + vofs), 64, 128,
                                           (att64::bf16*)(OC + orow * D + hc * 128), D, SKV / 64, (char*)lds, c.wave); }
            { const int hc = 2 * head + 1;
              att64::attn_unit<8, true, 2, 64, 1>((const att64::bf16*)(Qc + ((size_t)(b * 8 + hc) * SEQ + qb * 256) * 64), 64, (const att64::bf16*)(Kc + (size_t)(b * 8 + hc) * SKV * 64), (const att64::bf16*)(Vc + vofs), 64, 128,
                                           (att64::bf16*)(MIX + (TC + orow) * D + head * 128), D, SKV / 64, (char*)lds, c.wave,
                                           (const att64::bf16*)(OC + orow * D + (2 * head) * 128), D, lam, a.in[I_OGSUB], 1.f - lam_init); }
        }
    } else OATT(false);
#undef OATT
    float gq2 = fmaxf(fabsf(a.in[I_OGQD][c.lane]), c.lane < 32 ? fabsf(a.in[I_OGQD][64 + c.lane]) : 0.f), gk2 = fmaxf(fabsf(a.in[I_OGKD][c.lane]), c.lane < 32 ? fabsf(a.in[I_OGKD][64 + c.lane]) : 0.f);
    gq2 = wave_max(gq2); gk2 = wave_max(gk2);
    const bool fast2 = (0.10206207261596575f * LOG2E * 96.f * gq2 * gk2) < 90.f;
#define MATT(FIXV) do { \
    for (int L = c.vcu; L < 512; L += c.G) { const int bh = L / 64, qb = L % 64, b = bh / 4, h = bh % 4; \
        att::attn_unit<96, 128, FIXV, FIXV>(Qd + ((size_t)(b * 4 + h) * SEQ + qb * 256) * 96, Kd + (size_t)(b * 4 + h) * SKV * 96, Vd + (size_t)(b * 4 + h) * SKV * 128, \
                                MIX + (size_t)(TC + b * SEQ + qb * 256) * D + 512 + h * 128, D, SKV, lds, c.wave); } } while (0)
    const bool f8d = fast8_d(a, c.lane);
#define MATT8(EPIV, CHK) do { \
    for (int L = c.vcu; L < 512; L += c.G) { const int bh = L / 64, qb = L % 64, b = bh / 4, h = bh % 4; \
        att8::attn_unit<128, 128, EPIV>(ws + F8_DQ + ((size_t)(b * 4 + h) * SEQ + qb * 256) * 128, ws + F8_DK + (size_t)(b * 4 + h) * NTILE * 8192, ws + F8_DV + (size_t)(b * 4 + h) * NTILE * 8192, \
                                        MIX + (size_t)(TC + b * SEQ + qb * 256) * D + 512 + h * 128, D, NTILE, lds, c.wave, nullptr, 0, 0.f, nullptr, 1.f, CHK); } } while (0)
#if A8_DEBUG != 3
    if (f8d) MATT8(0, nullptr); else
#endif
    if (fast2) {
        for (int L = c.vcu; L < 512; L += c.G) { const int bh = L / 64, qb = L % 64, b = bh / 4, h = bh % 4;
            att64::attn_unit<8, true, 2, 96>((const att64::bf16*)(Qd + ((size_t)(b * 4 + h) * SEQ + qb * 256) * 96), 96, (const att64::bf16*)(Kd + (size_t)(b * 4 + h) * SKV * 96), (const att64::bf16*)(Vd + (size_t)(b * 4 + h) * SKV * 128), 96, 128,
                                             (att64::bf16*)(MIX + (size_t)(TC + b * SEQ + qb * 256) * D + 512 + h * 128), D, SKV / 64, (char*)lds, c.wave); }
    } else MATT(false);
#if A8_DEBUG == 3
    if (f8d) { grid_sync(c); MATT8(2, (float*)(ws + WS_CTL) + CW_CHK); }
#endif
#undef MATT8
#undef MATT
}

__device__ __forceinline__ void phase_osub(const Args& a, const Ctx& c0) {
    const Ctx c = fresh(c0);
    unsigned char* ws = a.ws;
    const bf16_t* OC = (const bf16_t*)(ws + WS_RA);
    bf16_t* MIX = (bf16_t*)(ws + WS_HMF);
    const int lane = c.lane, head = lane >> 4, chunk = lane & 15;
    const float lam_init = 0.8f - 0.6f * expf(-0.3f);
    const float* lp = a.in[I_OLAM];
    const float d1 = wave_sum(lp[lane] * lp[64 + lane]), d2 = wave_sum(lp[128 + lane] * lp[192 + lane]);
    const float lam = expf(d1) - expf(d2) + lam_init;
    float gs[8];
#pragma unroll
    for (int i = 0; i < 8; ++i) gs[i] = a.in[I_OGSUB][chunk * 8 + i] * (1.f - lam_init);
    { float gqx = fabsf(a.in[I_OGQC][lane]), gkx = fabsf(a.in[I_OGKC][lane]); gqx = wave_max(gqx); gkx = wave_max(gkx);
      if ((0.125f * LOG2E * 64.f * gqx * gkx) < 90.f) return; }
    for (int r = c.gw; r < TL; r += c.NGW) {
        const u32x4 w1 = *(const u32x4*)(OC + (size_t)r * D + (2 * head) * 128 + chunk * 8), w2 = *(const u32x4*)(OC + (size_t)r * D + (2 * head + 1) * 128 + chunk * 8);
        float f1[8], f2[8]; unpack8(w1, f1); unpack8(w2, f2);
#pragma unroll
        for (int i = 0; i < 8; ++i) f1[i] = f1[i] - lam * f2[i];
        const float rstd = rsqrtf(sum16(ssq8(f1)) * (1.f / 128.f) + EPS);
#pragma unroll
        for (int i = 0; i < 8; ++i) f1[i] = f1[i] * rstd * gs[i];
        *(u32x4*)(MIX + (size_t)(TC + r) * D + head * 128 + chunk * 8) = pack8(f1);
    }
}

#define IN(k) (LO <= (k) && (k) < HI)
#define LOADA() const Args args = load_args(); unsigned char* ws = args.ws; bf16_t* wsm = (bf16_t*)(ws + WS_WSM); const float* MOD = (const float*)(ws + WS_MOD); (void)ws; (void)wsm; (void)MOD
#ifndef PROBE_MASK
#define PROBE_MASK 0ull
#endif
#define NREP(k) (((PROBE_MASK >> (k)) & 1ull) ? 2 : 1)
#define REPB(k) for (int rep_ = 0; rep_ < NREP(k); ++rep_) {
#define REPE }
#define SEAM(k) do { if constexpr (IN(k) && IN((k) + 1)) { extern __shared__ __attribute__((aligned(16))) unsigned char lds_dyn2_[]; XcdBarrier b_; b_.bar = (unsigned*)(load_args().ws + WS_CTL) + CW_BAR; b_.x = xb_xcc_id(); b_.st = (volatile LAS unsigned*)((LAS unsigned char*)lds_dyn2_ + MISC_OFF) + 8; xcd_barrier(b_, mk_tid(c.wave)); } } while (0)
template <int LO, int HI, int LAYER>
__device__ __forceinline__ void moe_program(const Ctx& c) {
    constexpr int pb = LAYER ? PH_M1NORM : PH_M0NORM;
    if constexpr (IN(pb)) { REPB(pb) LOADA(); phase_mnorm(args, c, LAYER, args.ph_lo); REPE } SEAM(pb);
    if constexpr (IN(pb + 1)) { REPB(pb + 1) LOADA(); phase_mgather(args, c, LAYER); REPE } SEAM(pb + 1);
    if constexpr (IN(pb + 2)) { REPB(pb + 2) LOADA();
        const int nblk = ((const int*)(ws + WS_BLKE))[1024];
        pg8::Gemm g{(const bf16_t*)(ws + WS_HMF), (const bf16_t*)(ws + WS_RB), 0, D, D};
        pg8::MoeOrder S{(const int*)(ws + WS_BLKE), nblk * 4, 4, c.G, (int)blockIdx.x, (size_t)D * D * 2, (unsigned*)(ws + WS_CTL) + CW_MOEC + LAYER * 512, 1};
        pg8::EpiSwiGLU E{(bf16_t*)(ws + WS_RC), DEXP};
        pg8::gemm_phase<pg8::EpiSwiGLU, pg8::MoeOrder, true, true>(c.lds, g, S, E, c.wave, (const int*)(ws + WS_BLKE) + 2048);
    REPE }
    if constexpr (IN(pb + 3)) { REPB(pb + 3) LOADA();
        const int nblk = ((const int*)(ws + WS_BLKE))[1024];
        pg8::Gemm g{(const bf16_t*)(ws + WS_RC), (const bf16_t*)(ws + WS_RA + 146 * MiB), 0, D, DEXP};
        pg8::MoeOrder S{(const int*)(ws + WS_BLKE), nblk * 4, 4, c.G, (int)blockIdx.x, (size_t)D * DEXP * 2, (unsigned*)(ws + WS_CTL) + CW_MOEC + LAYER * 512, 2};
        pg8::EpiStoreBf16 E{(bf16_t*)(ws + WS_RA), D, 0};
        pg8::gemm_phase<pg8::EpiStoreBf16, pg8::MoeOrder>(c.lds, g, S, E, c.wave);
    REPE } SEAM(pb + 3);
    if constexpr (IN(pb + 4)) { REPB(pb + 4) LOADA(); phase_mcomb(args, c, LAYER); REPE } if constexpr (LAYER == 0) SEAM(pb + 4);
}

template <int LO, int HI>
__global__ void __launch_bounds__(512, 2) fwd_kernel(Args kargs) {
    extern __shared__ __attribute__((aligned(16))) unsigned char lds_raw[];
    Ctx c;
    c.lds = (LAS unsigned char*)lds_raw;
    c.tid = threadIdx.x; c.lane = c.tid & 63; c.wave = __builtin_amdgcn_readfirstlane(c.tid >> 6);
    c.G = gridDim.x; { const int bx = blockIdx.x; c.vcu = (c.G % 8 == 0) ? (bx % 8) * (c.G / 8) + bx / 8 : bx; }
    c.gw = c.vcu * 8 + c.wave; c.NGW = c.G * 8;
    { LAS unsigned long long* ap = (LAS unsigned long long*)(c.lds + ARGS_OFF);
      if (c.tid < 33) ap[c.tid] = (unsigned long long)kargs.in[c.tid];
      if (c.tid == 33) ap[33] = (unsigned long long)kargs.out;
      if (c.tid == 34) ap[34] = (unsigned long long)kargs.ws;
      if (c.tid == 35) ap[35] = ((unsigned long long)(unsigned)kargs.ph_hi << 32) | (unsigned)kargs.ph_lo; }
    if constexpr (HI - LO > 1) {
        volatile LAS unsigned* MISC = (volatile LAS unsigned*)(c.lds + MISC_OFF);
        if (c.tid < 16) MISC[c.tid] = 0u;
        __syncthreads();
        (void)xcd_barrier_post((unsigned*)(kargs.ws + WS_CTL) + CW_BAR, MISC + 8, c.tid);
    }
    __syncthreads();
    XcdBarrier bar; bar.bar = nullptr; bar.x = 0; bar.st = nullptr;
#define LOADA() const Args args = load_args(); unsigned char* ws = args.ws; bf16_t* wsm = (bf16_t*)(ws + WS_WSM); const float* MOD = (const float*)(ws + WS_MOD); (void)ws; (void)wsm; (void)MOD
    if constexpr (IN(PH_PRO)) { REPB(PH_PRO) LOADA(); phase_pro(args, c); REPE } SEAM(PH_PRO);
    if constexpr (IN(PH_ENORM)) { REPB(PH_ENORM) LOADA(); phase_enorm(args, c); REPE } SEAM(PH_ENORM);
    if constexpr (IN(PH_EINPROJ)) { REPB(PH_EINPROJ) LOADA();
        pg8::Gemm g{(const bf16_t*)(ws + WS_HMF), wsm + WO_WINE / 2, NROW, NZE, D}; pg8::StaticOrder S; S.init(NROW, NZE, c.G, (int)blockIdx.x);
        pg8::EpiStoreBf16 E{(bf16_t*)(ws + WS_RA), NZE, 0};
        pg8::gemm_phase<pg8::EpiStoreBf16, pg8::StaticOrder>(c.lds, g, S, E, c.wave);
    REPE } SEAM(PH_EINPROJ);
    if constexpr (IN(PH_EPOST)) { REPB(PH_EPOST) LOADA(); phase_epost(args, c); REPE } SEAM(PH_EPOST);
    if constexpr (IN(PH_EATTN)) { REPB(PH_EATTN) LOADA(); phase_eattn(args, c); REPE } SEAM(PH_EATTN);
    if constexpr (IN(PH_MLA)) { REPB(PH_MLA) LOADA(); phase_mla(args, c); REPE } SEAM(PH_MLA);
    if constexpr (IN(PH_MLB)) { REPB(PH_MLB) LOADA(); phase_mlb(args, c); REPE } SEAM(PH_MLB);
    if constexpr (IN(PH_MLC)) { REPB(PH_MLC) LOADA(); phase_mlc(args, c); REPE } SEAM(PH_MLC);
    if constexpr (IN(PH_EOUT)) { REPB(PH_EOUT) LOADA();
        pg8::Gemm g{(const bf16_t*)(ws + WS_HMF) + (size_t)TC * D, wsm + WO_WOUTE / 2, TL, D, D}; pg8::StaticOrder S; S.init(TL, D, c.G, (int)blockIdx.x);
        pg8::EpiResid E{args.in[I_X], args.in[I_CTX], (bf16_t*)(ws + WS_X), MOD + 2 * 1024, TC, 0};
        pg8::gemm_phase<pg8::EpiResid, pg8::StaticOrder>(c.lds, g, S, E, c.wave);
        { const float* xc = args.in[I_CTX]; bf16_t* Xb = (bf16_t*)(ws + WS_X); const float* gc = MOD + 2 * 1024 + 2 * 6144;
          auto epi = [=](int row, int col, const f32x4 v) { const f32x4 xv = *(const f32x4*)(xc + (size_t)row * D + col), gv = *(const f32x4*)(gc + col); *(u32x2*)(Xb + (size_t)row * D + col) = f32_to_bf4(xv + gv * v); };
          for (int u = c.vcu; u < (TC / 64) * (D / 32); u += c.G) ctx_tile_gemm<1>(c.lds, (const bf16_t*)(ws + WS_HMF), wsm + WO_WOUTE / 2, (u / (D / 32)) * 64, (u % (D / 32)) * 32, c.wave, epi); }
    REPE } SEAM(PH_EOUT);
    moe_program<LO, HI, 0>(c);
    if constexpr (IN(PH_OINPROJ)) { REPB(PH_OINPROJ) LOADA();
        pg8::Gemm g{(const bf16_t*)(ws + WS_HMF) + (size_t)TC * D, wsm + WO_WINO / 2, TL, NZO, D}; pg8::StaticOrder S; S.init(TL, NZO, c.G, (int)blockIdx.x);
        pg8::EpiStoreBf16 E{(bf16_t*)(ws + WS_RA), NZO, TC};
        pg8::gemm_phase<pg8::EpiStoreBf16, pg8::StaticOrder>(c.lds, g, S, E, c.wave);
        { bf16_t* Zb = (bf16_t*)(ws + WS_RA);
          auto epi = [=](int row, int col, const f32x4 v) { *(u32x2*)(Zb + (size_t)row * NZO + col) = f32_to_bf4(v); };
          for (int u = c.vcu; u < (TC / 64) * (NZO / 64); u += c.G) ctx_tile_gemm<2>(c.lds, (const bf16_t*)(ws + WS_HMF), wsm + WO_WINO / 2, (u / (NZO / 64)) * 64, (u % (NZO / 64)) * 64, c.wave, epi); }
    REPE } SEAM(PH_OINPROJ);
    if constexpr (IN(PH_OPOST)) { REPB(PH_OPOST) LOADA(); phase_opost(args, c); REPE } SEAM(PH_OPOST);
    if constexpr (IN(PH_OGEMM)) { REPB(PH_OGEMM) LOADA();
        { pg8::Gemm g{(const bf16_t*)(ws + WS_RC + 33 * MiB) + (size_t)TC * 256, wsm + WO_WUQ / 2, TL, 512, 256}; pg8::StaticOrder S; S.init(TL, 512, c.G, (int)blockIdx.x);
          pg8::EpiStoreBf16 E{(bf16_t*)(ws + WS_RA), 512, TC};
          pg8::gemm_phase<pg8::EpiStoreBf16, pg8::StaticOrder>(c.lds, g, S, E, c.wave); }
        { pg8::Gemm g{(const bf16_t*)(ws + WS_RC + 50 * MiB), wsm + WO_WUKV / 2, NROW, 768, 128}; pg8::StaticOrder S; S.init(NROW, 768, c.G, (int)blockIdx.x);
          pg8::EpiStoreBf16 E{(bf16_t*)(ws + WS_RA + 33 * MiB), 768, 0};
          pg8::gemm_phase<pg8::EpiStoreBf16, pg8::StaticOrder>(c.lds, g, S, E, c.wave); }
    REPE } SEAM(PH_OGEMM);
    if constexpr (IN(PH_OPOST2)) { REPB(PH_OPOST2) LOADA(); phase_opost2(args, c); REPE } SEAM(PH_OPOST2);
    if constexpr (IN(PH_OATTN)) { REPB(PH_OATTN) LOADA(); phase_oattn(args, c); REPE } SEAM(PH_OATTN);
    if constexpr (IN(PH_OSUB)) { REPB(PH_OSUB) LOADA(); phase_osub(args, c); REPE } SEAM(PH_OSUB);
    if constexpr (IN(PH_OOUT)) { REPB(PH_OOUT) LOADA();
        pg8::Gemm g{(const bf16_t*)(ws + WS_HMF) + (size_t)TC * D, wsm + WO_WOUTO / 2, TL, D, D}; pg8::StaticOrder S; S.init(TL, D, c.G, (int)blockIdx.x);
        pg8::EpiResid E{nullptr, nullptr, (bf16_t*)(ws + WS_X), MOD + 3 * 6144 + 2 * 1024, TC, 1};
        pg8::gemm_phase<pg8::EpiResid, pg8::StaticOrder>(c.lds, g, S, E, c.wave);
    REPE } SEAM(PH_OOUT);
    moe_program<LO, HI, 1>(c);
}
#undef IN
#undef SEAM

#ifndef HOST_DUP_MASK
#define HOST_DUP_MASK 0ull
#endif
template <int P> static void launch_phase(int grid, hipStream_t stream, const Args& a) {
    for (int rep = 0; rep < ((((unsigned long long)HOST_DUP_MASK >> P) & 1ull) ? 2 : 1); ++rep) {
        Args b = a; b.ph_lo = rep;
        hipLaunchKernelGGL((fwd_kernel<P, P + 1>), dim3(grid), dim3(512), LDS_BYTES, stream, b); }
}
template <int P> static void set_attr_phase() { (void)hipFuncSetAttribute((const void*)fwd_kernel<P, P + 1>, hipFuncAttributeMaxDynamicSharedMemorySize, LDS_BYTES); }
template <int... Ps> static void set_attr_all(std::integer_sequence<int, Ps...>) { (set_attr_phase<Ps>(), ...); }
template <int... Ps> static void launch_all(int grid, hipStream_t stream, const Args& a, std::integer_sequence<int, Ps...>) { (launch_phase<Ps>(grid, stream, a), ...); }

extern "C" void kernel_launch(void* const* d_in, const int* in_sizes, int n_in, void* d_out, int out_size, void* d_ws, size_t ws_size, hipStream_t stream) {
    static int grid = 0;
    if (grid == 0) {
        if (n_in != 33 || out_size != TL * D || ws_size < WS_NEED) { fprintf(stderr, "kernel_launch: unexpected shapes (n_in %d out %d ws %zu need %zu)\n", n_in, out_size, ws_size, (size_t)WS_NEED); grid = -1; return; }
        int dev = 0, cus = 0;
        if (hipGetDevice(&dev) != hipSuccess || hipDeviceGetAttribute(&cus, hipDeviceAttributeMultiprocessorCount, dev) != hipSuccess) { grid = -1; return; }
#if MK_ONE_LAUNCH
        if (hipFuncSetAttribute((const void*)fwd_kernel<0, NPH>, hipFuncAttributeMaxDynamicSharedMemorySize, LDS_BYTES) != hipSuccess) { fprintf(stderr, "kernel_launch: hipFuncSetAttribute failed\n"); grid = -1; return; }
#else
        set_attr_all(std::make_integer_sequence<int, NPH>{});
#endif
        (void)hipGetLastError();
        grid = cus;
    }
    if (grid < 0) return;
    (void)hipMemsetAsync((char*)d_ws + WS_CTL, 0, CTL_ZERO_BYTES, stream);
    Args a{};
    for (int i = 0; i < 33; ++i) a.in[i] = (const float*)d_in[i];
    a.out = (float*)d_out; a.ws = (unsigned char*)d_ws;
    a.ph_lo = 0; a.ph_hi = NPH;
#if MK_ONE_LAUNCH
    hipLaunchKernelGGL((fwd_kernel<0, NPH>), dim3(grid), dim3(512), LDS_BYTES, stream, a);
#else
    launch_all(grid, stream, a, std::make_integer_sequence<int, NPH>{});
#endif
}
```

```cpp
#include <hip/hip_runtime.h>
#include <hip/hip_bf16.h>
#include <cstdio>
#include <cstdint>
#include <cmath>
#include <utility>

#ifndef MK_ONE_LAUNCH
#define MK_ONE_LAUNCH 1
#endif

#define GAS __attribute__((address_space(1)))
#define LAS __attribute__((address_space(3)))
typedef unsigned short bf16_t;
typedef short bf16x8 __attribute__((ext_vector_type(8)));
typedef short s16x4 __attribute__((ext_vector_type(4)));
typedef float f32x4 __attribute__((ext_vector_type(4)));
typedef float f32x2 __attribute__((ext_vector_type(2)));
typedef float f32x16 __attribute__((ext_vector_type(16)));
typedef unsigned u32x4 __attribute__((ext_vector_type(4)));
typedef unsigned u32x2 __attribute__((ext_vector_type(2)));

constexpr int D = 1024, BATCH = 2, SEQ = 16384, CTX = 256, GRIDW = 64;
constexpr int TL = BATCH * SEQ, TC = BATCH * CTX, NROW = TL + TC;
constexpr int SKV = CTX + SEQ;
constexpr int NZE = 2816, NZO = 2048;
constexpr int IN_EVEN = 2832, IN_ODD = 1952;
constexpr int NE = 32, DEXP = 512;
constexpr int MOE_MAXBLK = 292, MOE_MAXROWS = MOE_MAXBLK * 256;
constexpr float EPS = 1e-6f;
constexpr float LOG2E = 1.4426950408889634f;
constexpr int NCHUNK = 130, NCHAIN = 16;

constexpr size_t MiB = 1u << 20;
constexpr size_t WS_CTL = 0, CTL_ZERO_BYTES = 1 * MiB;
constexpr size_t WS_MODP = 1 * MiB;
constexpr size_t WS_MOD = 3 * MiB;
constexpr size_t WS_G = 4 * MiB;
constexpr size_t WS_RT = 7 * MiB;
constexpr size_t WS_BLKE = 9 * MiB;
constexpr size_t WS_ML = 10 * MiB;
constexpr size_t WS_ROPE64 = WS_BLKE + 512 * 1024, WS_ROPED = WS_ROPE64 + 64 * 1024;
constexpr size_t WS_WSM = 12 * MiB;
constexpr size_t WS_X = 26 * MiB;
constexpr size_t WS_HMF = 156 * MiB;
constexpr size_t WS_RA = 221 * MiB;
constexpr size_t WS_RB = 400 * MiB;
constexpr size_t WS_RC = 465 * MiB;
constexpr size_t WS_END = 538 * MiB;
#ifndef A8_ENABLE
#define A8_ENABLE 1
#endif
#ifndef A8_QK6
#define A8_QK6 1
#endif
#ifndef A8_DEBUG
#define A8_DEBUG 0
#endif
constexpr size_t WS_DBG = 538 * MiB;
constexpr int NTILE = SKV / 64;
constexpr size_t F8_EQ = A8_DEBUG == 1 ? WS_DBG : WS_RB, F8_EK = A8_DEBUG == 1 ? WS_DBG + 16 * MiB : WS_RB + 32 * MiB, F8_EV = A8_DEBUG == 1 ? WS_DBG + 21 * MiB : WS_RB + 50 * MiB,
                 F8_EQC = A8_DEBUG == 1 ? WS_DBG + 26 * MiB : WS_RB + 49 * MiB;
constexpr size_t F8_CQ = WS_RB, F8_CK = WS_RB + 32 * MiB, F8_CV = WS_RB + 48 * MiB + 512 * 1024;
constexpr size_t F8_DQ = A8_DEBUG == 3 ? WS_DBG : WS_RA + 82 * MiB, F8_DK = A8_DEBUG == 3 ? WS_DBG + 16 * MiB : WS_RA + 106 * MiB, F8_DV = A8_DEBUG == 3 ? WS_DBG + 33 * MiB : WS_RC + 33 * MiB;
constexpr size_t WS_NEED = A8_DEBUG ? WS_DBG + 50 * MiB : WS_END;
constexpr int CW_CHK = 20000;
constexpr size_t WO_WINE = 0, WO_WINO = WO_WINE + (size_t)NZE * D * 2, WO_WOUTE = WO_WINO + (size_t)NZO * D * 2, WO_WOUTO = WO_WOUTE + (size_t)D * D * 2,
                 WO_WUQ = WO_WOUTO + (size_t)D * D * 2, WO_WUKV = WO_WUQ + (size_t)512 * 256 * 2, WO_END = WO_WUKV + (size_t)768 * 128 * 2;
static_assert(WO_END <= 14 * MiB, "small weights");
constexpr int CW_BAR = 4096;
constexpr int CW_CNT0 = 16384, CW_CNT1 = 16384 + 64;
constexpr size_t RT_E = 0, RT_POS = (size_t)NROW * 2 * 4, RT_GATE = 2 * RT_POS, RT_DEST = 3 * RT_POS;
constexpr size_t ML_BL = 0, ML_ML = 16384, ML_MS = 32768, ML_NL = 65536;

constexpr int LDS_BYTES = 163840;
constexpr int MISC_OFF = LDS_BYTES - 1024;
constexpr int ARGS_OFF = MISC_OFF + 256;

__device__ __forceinline__ unsigned f2bf(float f) { unsigned u = __builtin_bit_cast(unsigned, f); return (u + 0x7fffu + ((u >> 16) & 1u)) >> 16; }
typedef __bf16 bf16x2_t __attribute__((ext_vector_type(2)));
__device__ __forceinline__ unsigned pk2(float lo, float hi) { f32x2 v = {lo, hi}; bf16x2_t b = __builtin_convertvector(v, bf16x2_t); return __builtin_bit_cast(unsigned, b); }
__device__ __forceinline__ float bf2f(unsigned short b) { return __builtin_bit_cast(float, (unsigned)b << 16); }
__device__ __forceinline__ float bflo(unsigned w) { return __builtin_bit_cast(float, w << 16); }
__device__ __forceinline__ float bfhi(unsigned w) { return __builtin_bit_cast(float, w & 0xffff0000u); }
__device__ __forceinline__ unsigned cvt_pk_bf16(float lo, float hi) { unsigned r; asm volatile("v_cvt_pk_bf16_f32 %0, %1, %2" : "=v"(r) : "v"(lo), "v"(hi)); return r; }
template <int O> __device__ __forceinline__ float xshfl(float v) {
#ifdef TEST_HIP_XSHFL
    return __shfl_xor(v, O);
#endif
    if constexpr (O < 32) return __builtin_bit_cast(float, __builtin_amdgcn_ds_swizzle(__builtin_bit_cast(int, v), (O << 10) | 0x1f));
    else { auto rr = __builtin_amdgcn_permlane32_swap(__float_as_uint(v), __float_as_uint(v), false, false);
           unsigned ones = ~0u; const bool lo = __builtin_amdgcn_mbcnt_hi(ones, __builtin_amdgcn_mbcnt_lo(ones, 0u)) < 32u; return __uint_as_float(lo ? rr[1] : rr[0]); }
}
#define DPPX(v, ctrl) __builtin_bit_cast(float, __builtin_amdgcn_update_dpp(0, __builtin_bit_cast(int, (float)(v)), (ctrl), 0xf, 0xf, false))
__device__ __forceinline__ float dpp_x1(float v) { return DPPX(v, 0xB1); }
__device__ __forceinline__ float dpp_x2(float v) { return DPPX(v, 0x4E); }
__device__ __forceinline__ float dpp_x7(float v) { return DPPX(v, 0x141); }
__device__ __forceinline__ float dpp_x15(float v) { return DPPX(v, 0x140); }
__device__ __forceinline__ float xsum32(float v) { auto rr = __builtin_amdgcn_permlane32_swap(__float_as_uint(v), __float_as_uint(v), false, false); return __uint_as_float(rr[0]) + __uint_as_float(rr[1]); }
__device__ __forceinline__ float xmax32(float v) { auto rr = __builtin_amdgcn_permlane32_swap(__float_as_uint(v), __float_as_uint(v), false, false); return fmaxf(__uint_as_float(rr[0]), __uint_as_float(rr[1])); }
__device__ __forceinline__ float wave_sum(float v) {
    v += dpp_x1(v); v += dpp_x2(v); v += dpp_x7(v); v += dpp_x15(v); v += xshfl<16>(v); return xsum32(v);
}
__device__ __forceinline__ float wave_max(float v) {
    v = fmaxf(v, dpp_x1(v)); v = fmaxf(v, dpp_x2(v)); v = fmaxf(v, dpp_x7(v)); v = fmaxf(v, dpp_x15(v)); v = fmaxf(v, xshfl<16>(v)); return xmax32(v);
}
__device__ __forceinline__ float rdlane(float v, int l) { return __builtin_bit_cast(float, __builtin_amdgcn_readlane(__builtin_bit_cast(int, v), l)); }
#define DPPF(oldv, v, ctrl, rm) __builtin_bit_cast(float, __builtin_amdgcn_update_dpp(__builtin_bit_cast(int, (float)(oldv)), __builtin_bit_cast(int, (float)(v)), (ctrl), (rm), 0xf, false))
__device__ __forceinline__ float siluf(float x) { return x * __builtin_amdgcn_rcpf(1.f + __expf(-x)); }
__device__ __forceinline__ float sigmoidf_(float x) { return __builtin_amdgcn_rcpf(1.f + __expf(-x)); }
__device__ __forceinline__ float logsigmoidf_(float x) { return fminf(x, 0.f) - log1pf(__expf(-fabsf(x))); }
#define LDS_WAIT() asm volatile("s_waitcnt lgkmcnt(0)" ::: "memory")
#define VM_WAIT() asm volatile("s_waitcnt vmcnt(0)" ::: "memory")
__device__ __forceinline__ void unpack8(const u32x4 w, float* f) {
    f[0] = bflo(w.x); f[1] = bfhi(w.x); f[2] = bflo(w.y); f[3] = bfhi(w.y); f[4] = bflo(w.z); f[5] = bfhi(w.z); f[6] = bflo(w.w); f[7] = bfhi(w.w);
}
__device__ __forceinline__ u32x4 pack8(const float* f) { u32x4 w; w.x = pk2(f[0], f[1]); w.y = pk2(f[2], f[3]); w.z = pk2(f[4], f[5]); w.w = pk2(f[6], f[7]); return w; }

__device__ __forceinline__ f32x4 bf4_to_f32(const u32x2 w) { f32x4 r; r.x = bflo(w.x); r.y = bfhi(w.x); r.z = bflo(w.y); r.w = bfhi(w.y); return r; }
__device__ __forceinline__ u32x2 f32_to_bf4(const f32x4 v) { u32x2 w; w.x = pk2(v.x, v.y); w.y = pk2(v.z, v.w); return w; }
__device__ __forceinline__ int mk_tid(int wave) {
    unsigned ones = ~0u; asm volatile("" : "+s"(ones), "+s"(wave));
    int tid = wave * 64 + (int)__builtin_amdgcn_mbcnt_hi(ones, __builtin_amdgcn_mbcnt_lo(ones, 0u));
    asm volatile("" : "+v"(tid));
    return tid;
}
#define XB_TMO      128
#define XB_XCNT(j)  (256  + 64 * (j))
#define XB_XSUB(j)  (1280 + 64 * (j))
#define XB_XGEN(j)  (2304 + 64 * (j))
#define XB_TOP      3328
#define XB_TOPGEN   3392
#define XCD_BAR_WORDS 3456
#define XB_SPIN_CAP (1u << 18)
__device__ __forceinline__ unsigned xb_ld(unsigned* p)              { return __hip_atomic_load(p, __ATOMIC_RELAXED, __HIP_MEMORY_SCOPE_AGENT); }
__device__ __forceinline__ unsigned xb_add(unsigned* p, unsigned v) { return __hip_atomic_fetch_add(p, v, __ATOMIC_RELAXED, __HIP_MEMORY_SCOPE_AGENT); }
__device__ __forceinline__ unsigned xb_xcc_id() { return (unsigned)__builtin_amdgcn_s_getreg((3 << 11) | 20) & 0xFu; }
#define XB_SPIN(cond, bar) do { unsigned _sp = 0; while (cond) { __builtin_amdgcn_s_sleep(1); \
    if ((++_sp & 255u) == 0u) { if (xb_ld(&(bar)[XB_TMO])) break; if (_sp > XB_SPIN_CAP) { atomicAdd(&(bar)[XB_TMO], 1u); break; } } } } while (0)
struct XcdBarrier { unsigned* bar; unsigned x; volatile LAS unsigned* st; };
__device__ __forceinline__ XcdBarrier xcd_barrier_post(unsigned* bar, volatile LAS unsigned* st, int tid0) {
    XcdBarrier b; b.bar = bar; b.x = xb_xcc_id(); b.st = st;
    if (tid0 == 0) (void)xb_add(&bar[XB_XCNT(b.x)], 1u);
    return b;
}
__device__ __forceinline__ void xcd_barrier_complete(unsigned* bar, unsigned x, unsigned& nloc, unsigned& nx) {
    const unsigned G = gridDim.x * gridDim.y * gridDim.z;
    unsigned sum, cnt, mine, sp = 0u;
    for (;;) {
        sum = 0u; cnt = 0u; mine = 0u;
#pragma unroll
        for (unsigned j = 0; j < 16; ++j) { const unsigned c = xb_ld(&bar[XB_XCNT(j)]); sum += c; cnt += (c > 0u) ? 1u : 0u; mine = (j == x) ? c : mine; }
        if (sum == G) break;
        __builtin_amdgcn_s_sleep(1);
        if ((++sp & 255u) == 0u) { if (xb_ld(&bar[XB_TMO])) break; if (sp > XB_SPIN_CAP) { atomicAdd(&bar[XB_TMO], 1u); break; } }
    }
    nloc = mine > 0u ? mine : 1u; nx = cnt > 0u ? cnt : 1u;
}
__device__ __forceinline__ void xcd_barrier(const XcdBarrier& b, int tid0) {
    asm volatile("s_waitcnt vmcnt(0)" ::: "memory");
    __syncthreads();
    if (tid0 == 0) {
        unsigned* bar = b.bar;
        __builtin_amdgcn_s_waitcnt(0);
        unsigned nloc = b.st[0], nx = b.st[1];
        if (nloc == 0u) { xcd_barrier_complete(bar, b.x, nloc, nx); b.st[0] = nloc; b.st[1] = nx; }
        const unsigned old = xb_add(&bar[XB_XSUB(b.x)], 1u);
        const unsigned gen = old / nloc;
        if (old + 1u == (gen + 1u) * nloc) {
            __builtin_amdgcn_fence(__ATOMIC_RELEASE, "agent");
            asm volatile("s_waitcnt vmcnt(0)" ::: "memory");
            const unsigned og = xb_add(&bar[XB_TOP], 1u);
            const unsigned tg = og / nx;
            if (og + 1u == (tg + 1u) * nx) xb_add(&bar[XB_TOPGEN], 1u);
            else XB_SPIN(xb_ld(&bar[XB_TOPGEN]) == tg, bar);
            __builtin_amdgcn_fence(__ATOMIC_ACQUIRE, "agent");
            xb_add(&bar[XB_XGEN(b.x)], 1u);
            asm volatile("s_waitcnt vmcnt(0)" ::: "memory");
        } else {
            XB_SPIN(xb_ld(&bar[XB_XGEN(b.x)]) == gen, bar);
            __builtin_amdgcn_fence(__ATOMIC_ACQUIRE, "agent");
            asm volatile("s_waitcnt vmcnt(0)" ::: "memory");
        }
    }
    __syncthreads();
}

namespace pg8 {
constexpr int BM = 256, BK = 64, HALF = 128, HTB = HALF * BK * 2, STAGE_BYTES = 8 * HTB, NXCD = 8, WGM = 8;
__host__ __device__ __forceinline__ int lds_byte(int r, int c) { const int st = (r >> 4) * 2 + (c >> 5), rr = r & 15, cc = c & 31, ob = rr * 64 + cc * 2; return st * 1024 + (ob ^ (((ob >> 9) & 1) << 5)); }
__host__ __device__ __forceinline__ void stage_rc(int b, int& R, int& C) { const int st = b / 1024, sb = b % 1024, swz = sb ^ (((sb >> 9) & 1) << 5); R = (st >> 1) * 16 + swz / 64; C = (st & 1) * 32 + (swz % 64) / 2; }
__host__ __device__ __forceinline__ int perm32(int rho) { const int n = rho >> 4, i = rho & 15; return 8 * (i >> 2) + 4 * n + (i & 3); }
struct Unit { int pm, pn; };
struct Gemm { const bf16_t* A; const bf16_t* Bt; int M, N, K; };
struct StaticOrder {
    int nM, nN, nwg, G, c;
    __device__ void init(int M, int N, int G_, int c_) { nM = M / BM; nN = N / BM; nwg = nM * nN; G = G_; c = c_; }
    __device__ bool next(int i, Unit& u) const {
        const long L = (long)i * G + c; if (L >= nwg) return false;
        int wgid = (int)L; { const int q = nwg / NXCD, r = nwg % NXCD, xcd = wgid % NXCD, off = wgid / NXCD; wgid = (xcd < r ? xcd * (q + 1) : r * (q + 1) + (xcd - r) * q) + off; }
        const int nig = WGM * nN, gid = wgid / nig, fm = gid * WGM, gsz = (nM - fm) < WGM ? (nM - fm) : WGM;
        u.pm = fm + ((wgid % nig) % gsz); u.pn = (wgid % nig) / gsz; return true;
    }
    __device__ __forceinline__ size_t b_off(const Unit&) const { return 0; }
};
struct MoeOrder {
    const int* blk_e; int nunits, nN, G, c; size_t estride;
    __device__ bool next(int i, Unit& u) const { const long L = (long)i * G + c; if (L >= nunits) return false; u.pm = (int)(L / nN); u.pn = (int)(L % nN); return true; }
    __device__ __forceinline__ size_t b_off(const Unit& u) const { return (size_t)blk_e[u.pm] * estride; }
};

struct EpiStoreBf16 {
    static constexpr bool PERM = true;
    bf16_t* O; int ldc; int row_off;
    __device__ __forceinline__ void operator()(const f32x4 (&acc)[2][2][4][2], const Unit& u, int wr, int wc, int fr, int fq) const {
        const int row0 = row_off + u.pm * BM + wr * 64 + fr, col0 = u.pn * BM + wc * 32 + 8 * fq;
#pragma unroll
        for (int ai = 0; ai < 2; ++ai)
#pragma unroll
            for (int m = 0; m < 4; ++m) { bf16_t* rowp = O + (size_t)(row0 + ai * HALF + m * 16) * ldc + col0;
#pragma unroll
                for (int bj = 0; bj < 2; ++bj) { const f32x4 v0 = acc[ai][bj][m][0], v1 = acc[ai][bj][m][1];
                    u32x4 w; w.x = cvt_pk_bf16(v0[0], v0[1]); w.y = cvt_pk_bf16(v0[2], v0[3]); w.z = cvt_pk_bf16(v1[0], v1[1]); w.w = cvt_pk_bf16(v1[2], v1[3]);
                    *(u32x4*)(rowp + bj * HALF) = w; } }
    }
};
struct EpiSwiGLU {
    static constexpr bool PERM = false;
    bf16_t* O; int ldc;
    __device__ __forceinline__ void operator()(const f32x4 (&acc)[2][2][4][2], const Unit& u, int wr, int wc, int fr, int fq) const {
        const int row0 = u.pm * BM + wr * 64 + fr, colh = (u.pn * BM + wc * 32) / 2 + 4 * fq;
#pragma unroll
        for (int ai = 0; ai < 2; ++ai)
#pragma unroll
            for (int m = 0; m < 4; ++m) { bf16_t* rowp = O + (size_t)(row0 + ai * HALF + m * 16) * ldc + colh;
#pragma unroll
                for (int bj = 0; bj < 2; ++bj) { const f32x4 a = acc[ai][bj][m][0], b = acc[ai][bj][m][1];
                    u32x2 w; w.x = cvt_pk_bf16(siluf(a[0]) * b[0], siluf(a[1]) * b[1]); w.y = cvt_pk_bf16(siluf(a[2]) * b[2], siluf(a[3]) * b[3]);
                    *(u32x2*)(rowp + bj * (HALF / 2)) = w; } }
    }
};
struct EpiResid {
    static constexpr bool PERM = false;
    const float* x_lat; const float* x_ctx; bf16_t* X; const float* gate;
    int row_off; int inplace;
    __device__ __forceinline__ void operator()(const f32x4 (&acc)[2][2][4][2], const Unit& u, int wr, int wc, int fr, int fq) const {
        const int row0 = row_off + u.pm * BM + wr * 64 + fr, col0 = u.pn * BM + wc * 32 + 4 * fq;
#pragma unroll
        for (int ai = 0; ai < 2; ++ai)
#pragma unroll
            for (int m = 0; m < 4; ++m) { const int row = row0 + ai * HALF + m * 16;
                const int bsel = row < TC ? 2 : (row - TC) / SEQ;
                const float* xin = row < TC ? x_ctx + (size_t)row * D : x_lat + (size_t)(row - TC) * D;
                const float* gp = gate + bsel * 6144;
#pragma unroll
                for (int bj = 0; bj < 2; ++bj)
#pragma unroll
                    for (int n = 0; n < 2; ++n) { const int col = col0 + bj * HALF + n * 16;
                        const f32x4 xv = inplace ? bf4_to_f32(*(const u32x2*)(X + (size_t)row * D + col)) : *(const f32x4*)(xin + col), gv = *(const f32x4*)(gp + col);
                        *(u32x2*)(X + (size_t)row * D + col) = f32_to_bf4(xv + gv * acc[ai][bj][m][n]); } }
    }
};

template <class Epi, class Sched, bool ALIGN_EPI = true, bool GATHER = false>
__device__ __forceinline__ void gemm_phase(LAS unsigned char* lds, const Gemm g, const Sched& S, const Epi& E, int wv, const int* rowtab = nullptr) {
    const int tid = mk_tid(wv);
    const int wid = __builtin_amdgcn_readfirstlane(tid >> 6), lane = tid & 63, wr = wid >> 2, wc = wid & 3, fr = lane & 15, fq = lane >> 4;
    const int K = g.K, nt = K / BK;
    const size_t kstep = (size_t)(BK * 2);
    const size_t hstep = (size_t)HALF * K * 2;
    const size_t tstep = 2 * hstep;
    int RA_[2], CA_[2]; unsigned vA[2][2], nvA[2][2], voffB[2];
#pragma unroll
    for (int i = 0; i < 2; ++i) { int R, C; stage_rc(tid * 16 + i * 8192, R, C); const int Rb = Epi::PERM ? ((R & ~31) + perm32(R & 31)) : R;
        RA_[i] = R; CA_[i] = C; voffB[i] = (unsigned)(Rb * K + C) * 2u;
        vA[0][i] = (unsigned)(R * K + C) * 2u; vA[1][i] = vA[0][i] + (unsigned)hstep; nvA[0][i] = vA[0][i]; nvA[1][i] = vA[1][i]; }
#define PG8_GVOFF(V, u) do { if constexpr (GATHER) { _Pragma("unroll") for (int h_ = 0; h_ < 2; ++h_) _Pragma("unroll") for (int i_ = 0; i_ < 2; ++i_) \
        V[h_][i_] = (unsigned)(rowtab[(u).pm * BM + h_ * HALF + RA_[i_]] * K + CA_[i_]) * 2u; } } while (0)
    const unsigned ldsw = (unsigned)wid * 1024u;
    const int aoff = lds_byte(wr * 64 + fr, fq * 8), boff = lds_byte(wc * 32 + fr, fq * 8);
#define PG8_SA(b, h) (((b) * 2 + (h)) * HTB)
#define PG8_SB(b, h) ((4 + (b) * 2 + (h)) * HTB)
#define PG8_STAGE(bufoff, gbase, voff) do { _Pragma("unroll") for (int _i = 0; _i < 2; ++_i) \
        __builtin_amdgcn_global_load_lds((const unsigned*)((const char*)(gbase) + (voff)[_i]), (LAS unsigned*)(lds + (bufoff) + ldsw + _i * 8192), 16, 0, 0); } while (0)
#define PG8_STAGE_SEL(bufoff, gbase, sel, v1, v0) do { _Pragma("unroll") for (int _i = 0; _i < 2; ++_i) \
        __builtin_amdgcn_global_load_lds((const unsigned*)((const char*)(gbase) + ((sel) ? (v1)[_i] : (v0)[_i])), (LAS unsigned*)(lds + (bufoff) + ldsw + _i * 8192), 16, 0, 0); } while (0)
#define PG8_LDA(dst, b, h) do { _Pragma("unroll") for (int m = 0; m < 4; ++m) _Pragma("unroll") for (int k = 0; k < 2; ++k) dst[m][k] = *(const LAS bf16x8*)(lds + PG8_SA(b, h) + aoff + m * 2048 + k * 1024); } while (0)
#define PG8_LDB(dst, b, h) do { _Pragma("unroll") for (int n = 0; n < 2; ++n) _Pragma("unroll") for (int k = 0; k < 2; ++k) dst[n][k] = *(const LAS bf16x8*)(lds + PG8_SB(b, h) + boff + n * 2048 + k * 1024); } while (0)
#define PG8_MMA(ai, bj, At, Bt) do { __builtin_amdgcn_s_setprio(1); _Pragma("unroll") for (int m = 0; m < 4; ++m) _Pragma("unroll") for (int n = 0; n < 2; ++n) _Pragma("unroll") for (int k = 0; k < 2; ++k) \
        acc[ai][bj][m][n] = __builtin_amdgcn_mfma_f32_16x16x32_bf16(Bt[n][k], At[m][k], acc[ai][bj][m][n], 0, 0, 0); __builtin_amdgcn_s_setprio(0); } while (0)
#define PG8_WAIT_V(n) asm volatile("s_waitcnt vmcnt(" #n ")" ::: "memory")
#define PG8_WAIT_L(n) asm volatile("s_waitcnt lgkmcnt(" #n ")" ::: "memory")
#define PG8_BAR __builtin_amdgcn_s_barrier()
#define PG8_SCHED __builtin_amdgcn_sched_barrier(0)
    Unit cur, nxt; int ui = 0;
    if (!S.next(0, cur)) return;
    f32x4 acc[2][2][4][2];
#pragma unroll
    for (int a = 0; a < 2; ++a)
#pragma unroll
        for (int b = 0; b < 2; ++b)
#pragma unroll
            for (int m = 0; m < 4; ++m)
#pragma unroll
                for (int n = 0; n < 2; ++n) acc[a][b][m][n] = (f32x4){0.f, 0.f, 0.f, 0.f};
    bf16x8 At[4][2], B0[2][2], B1[2][2];
    const char* cA = (const char*)g.A + (GATHER ? (size_t)0 : (size_t)cur.pm * tstep); const char* cB = (const char*)g.Bt + S.b_off(cur) + (size_t)cur.pn * tstep;
    PG8_GVOFF(vA, cur);
    PG8_STAGE(PG8_SB(0, 0), cB, voffB); PG8_STAGE(PG8_SB(0, 1), cB + hstep, voffB); PG8_STAGE(PG8_SA(0, 0), cA, vA[0]); PG8_STAGE(PG8_SA(0, 1), cA, vA[1]);
    if (wr == 1) PG8_BAR;
    PG8_WAIT_V(2); PG8_BAR;
    PG8_STAGE(PG8_SB(1, 0), cB + kstep, voffB); PG8_STAGE(PG8_SA(1, 0), cA + kstep, vA[0]); PG8_STAGE(PG8_SB(1, 1), cB + hstep + kstep, voffB);
    PG8_WAIT_V(6); PG8_BAR;
    for (;;) {
        const bool has_next = S.next(ui + 1, nxt);
        const char* nA = has_next ? (const char*)g.A + (GATHER ? (size_t)0 : (size_t)nxt.pm * tstep) : cA; const char* nB = has_next ? (const char*)g.Bt + S.b_off(nxt) + (size_t)nxt.pn * tstep : cB;
        if constexpr (GATHER) { if (has_next) { PG8_GVOFF(nvA, nxt); } else {
#pragma unroll
            for (int h_ = 0; h_ < 2; ++h_)
#pragma unroll
                for (int i_ = 0; i_ < 2; ++i_) nvA[h_][i_] = vA[h_][i_]; } }
        for (int t = 0; t < nt; t += 2) {
            const bool last = (t == nt - 2);
            const char* a1 = cA + (size_t)(t + 1) * kstep;
            const char* a2 = last ? nA : cA + (size_t)(t + 2) * kstep; const char* b2 = last ? nB : cB + (size_t)(t + 2) * kstep;
            const char* a3 = a2 + kstep; const char* b3 = b2 + kstep;
            PG8_LDB(B0, 0, 0); PG8_LDB(B1, 0, 1); PG8_SCHED; PG8_LDA(At, 0, 0); PG8_STAGE(PG8_SA(1, 1), a1, vA[1]);
            PG8_WAIT_V(8); PG8_WAIT_L(0); PG8_BAR; PG8_MMA(0, 0, At, B0); PG8_MMA(0, 1, At, B1); PG8_BAR; PG8_SCHED;
            PG8_LDA(At, 0, 1); PG8_STAGE(PG8_SB(0, 0), b2, voffB); PG8_STAGE(PG8_SB(0, 1), b2 + hstep, voffB); PG8_STAGE_SEL(PG8_SA(0, 0), a2, last, nvA[0], vA[0]);
            PG8_WAIT_V(8); PG8_WAIT_L(0); PG8_BAR; PG8_MMA(1, 0, At, B0); PG8_MMA(1, 1, At, B1); PG8_BAR; PG8_SCHED;
            PG8_LDB(B0, 1, 0); PG8_LDB(B1, 1, 1); PG8_SCHED; PG8_LDA(At, 1, 0); PG8_STAGE_SEL(PG8_SA(0, 1), a2, last, nvA[1], vA[1]);
            PG8_WAIT_V(8); PG8_WAIT_L(0); PG8_BAR; PG8_MMA(0, 0, At, B0); PG8_MMA(0, 1, At, B1); PG8_BAR; PG8_SCHED;
            PG8_LDA(At, 1, 1); PG8_STAGE(PG8_SB(1, 0), b3, voffB); PG8_STAGE(PG8_SB(1, 1), b3 + hstep, voffB); PG8_STAGE_SEL(PG8_SA(1, 0), a3, last, nvA[0], vA[0]);
            PG8_WAIT_V(8); PG8_WAIT_L(0); PG8_BAR; PG8_MMA(1, 0, At, B0); PG8_MMA(1, 1, At, B1); PG8_BAR; PG8_SCHED;
        }
        if constexpr (ALIGN_EPI) { if (wr == 0) PG8_BAR; }
        E(acc, cur, wr, wc, fr, fq);
        if (!has_next) break;
#pragma unroll
        for (int a = 0; a < 2; ++a)
#pragma unroll
            for (int b = 0; b < 2; ++b)
#pragma unroll
                for (int m = 0; m < 4; ++m)
#pragma unroll
                    for (int n = 0; n < 2; ++n) acc[a][b][m][n] = (f32x4){0.f, 0.f, 0.f, 0.f};
        cur = nxt; cA = nA; cB = nB; ++ui;
        if constexpr (GATHER) {
#pragma unroll
            for (int h_ = 0; h_ < 2; ++h_)
#pragma unroll
                for (int i_ = 0; i_ < 2; ++i_) vA[h_][i_] = nvA[h_][i_]; }
        if constexpr (ALIGN_EPI) { if (wr == 1) PG8_BAR; }
    }
    PG8_WAIT_V(0);
    if constexpr (!ALIGN_EPI) { if (wr == 0) PG8_BAR; }
    PG8_BAR;
#undef PG8_GVOFF
#undef PG8_SA
#undef PG8_SB
#undef PG8_STAGE
#undef PG8_STAGE_SEL
#undef PG8_LDA
#undef PG8_LDB
#undef PG8_MMA
#undef PG8_WAIT_V
#undef PG8_WAIT_L
#undef PG8_BAR
#undef PG8_SCHED
}
}

template <int NB, class F>
__device__ __forceinline__ void ctx_tile_gemm(LAS unsigned char* lds, const bf16_t* __restrict__ A, const bf16_t* __restrict__ Bt, const int row0, const int col0, int wv, const F& epi) {
    const int tid = mk_tid(wv); const int lane = tid & 63, r32 = lane & 31, hi = lane >> 5; const int wid = __builtin_amdgcn_readfirstlane(tid >> 6);
    const bf16_t* ap = A + (size_t)(row0 + r32) * D + wid * 128 + 8 * hi;
    const bf16_t* bp = Bt + (size_t)(col0 + r32) * D + wid * 128 + 8 * hi;
    bf16x8 a0[8], a1[8], bb[NB][8];
#pragma unroll
    for (int ks = 0; ks < 8; ++ks) { a0[ks] = *(const bf16x8*)(ap + 16 * ks); a1[ks] = *(const bf16x8*)(ap + (size_t)32 * D + 16 * ks);
#pragma unroll
        for (int n = 0; n < NB; ++n) bb[n][ks] = *(const bf16x8*)(bp + (size_t)(32 * n) * D + 16 * ks); }
    f32x16 acc[2][NB];
#pragma unroll
    for (int m = 0; m < 2; ++m)
#pragma unroll
        for (int n = 0; n < NB; ++n) acc[m][n] = f32x16{};
#pragma unroll
    for (int ks = 0; ks < 8; ++ks)
#pragma unroll
        for (int n = 0; n < NB; ++n) { acc[0][n] = __builtin_amdgcn_mfma_f32_32x32x16_bf16(a0[ks], bb[n][ks], acc[0][n], 0, 0, 0); acc[1][n] = __builtin_amdgcn_mfma_f32_32x32x16_bf16(a1[ks], bb[n][ks], acc[1][n], 0, 0, 0); }
    constexpr int TW = 32 * NB;
    LAS float* part = (LAS float*)lds + wid * (64 * TW);
#pragma unroll
    for (int r = 0; r < 16; ++r) { const int row = (r & 3) + 8 * (r >> 2) + 4 * hi;
#pragma unroll
        for (int n = 0; n < NB; ++n) { part[row * TW + 32 * n + r32] = acc[0][n][r]; part[(32 + row) * TW + 32 * n + r32] = acc[1][n][r]; } }
    __syncthreads();
#pragma unroll
    for (int q = 0; q < NB; ++q) { const int o4 = tid + 512 * q;
      const LAS f32x4* p4 = (const LAS f32x4*)lds + o4;
      f32x4 v = p4[0];
#pragma unroll
      for (int w = 1; w < 8; ++w) v = v + p4[w * (16 * TW)];
      epi(row0 + o4 / (TW / 4), col0 + 4 * (o4 % (TW / 4)), v); }
    __syncthreads();
}

namespace att {
#define SBAR() __builtin_amdgcn_sched_barrier(0)
__device__ __forceinline__ int crow(int r, int hi) { return (r & 3) + 8 * (r >> 2) + 4 * hi; }
constexpr float THR = 8.f;
template <int DQK> struct KT {
    static constexpr int ROWB = (DQK == 64) ? 128 : 256;
    static constexpr int BYTES = 64 * ROWB;
    __device__ static __forceinline__ int swz(int row, int colB) { return row * ROWB + (colB ^ ((DQK == 64) ? (((row >> 1) & 7) << 4) : ((row & 15) << 4))); }
};
template <int DV> struct VT {
    static constexpr int NCB = DV / 32;
    static constexpr int BYTES = 64 * DV * 2;
    __device__ static __forceinline__ int v_st(int k, int c) { const int kk = (k & ~0xC) | ((k & 4) << 1) | ((k & 8) >> 1); return ((kk >> 3) * NCB + (c >> 5)) * 512 + ((kk & 7) * 32 + (c & 31)) * 2; }
    static constexpr int rd_off(int d0, int ks, int half) { return d0 * 512 + ks * (NCB * 1024) + half * (NCB * 512); }
};
__device__ __forceinline__ int v_rd_base(int lane) { return ((lane & 3) << 3) | (((lane >> 2) & 3) << 6) | (((lane >> 4) & 1) << 5) | (((lane >> 5) & 1) << 8); }
template <int OFF> __device__ __forceinline__ s16x4 tr_read(int vb) {
    s16x4 r; asm volatile("ds_read_b64_tr_b16 %0, %1 offset:%2" : "=&v"(r) : "v"(vb), "i"(OFF) : "memory"); return r;
}
__device__ __forceinline__ void partialSM(f32x16& p0, f32x16& p1, float& m_reg, float& alpha) {
    float pmax = p0[0];
#pragma unroll
    for (int r = 1; r < 16; ++r) pmax = fmaxf(pmax, p0[r]);
#pragma unroll
    for (int r = 0; r < 16; ++r) pmax = fmaxf(pmax, p1[r]);
    { auto rr = __builtin_amdgcn_permlane32_swap(__float_as_uint(pmax), __float_as_uint(pmax), false, false);
      pmax = fmaxf(__uint_as_float(rr[0]), __uint_as_float(rr[1])); }
    float mn;
    if (__builtin_expect(__all(pmax - m_reg <= THR), 1)) { mn = m_reg; alpha = 1.f; }
    else { mn = fmaxf(m_reg, pmax); alpha = __builtin_amdgcn_exp2f(m_reg - mn); m_reg = mn; }
#pragma unroll
    for (int r = 0; r < 16; ++r) p0[r] = p0[r] - mn;
#pragma unroll
    for (int r = 0; r < 16; ++r) p1[r] = p1[r] - mn;
#pragma unroll
    for (int r = 0; r < 16; ++r) p0[r] = __builtin_amdgcn_exp2f(p0[r]);
}
__device__ __forceinline__ void finishSM(f32x16& p0, f32x16& p1, float alpha, float& l_reg, bf16x8& pa0, bf16x8& pa1, bf16x8& pa2, bf16x8& pa3) {
#pragma unroll
    for (int r = 0; r < 16; ++r) p1[r] = __builtin_amdgcn_exp2f(p1[r]);
    float ps = 0;
#pragma unroll
    for (int r = 0; r < 16; ++r) ps += p0[r];
#pragma unroll
    for (int r = 0; r < 16; ++r) ps += p1[r];
    { auto rr = __builtin_amdgcn_permlane32_swap(__float_as_uint(ps), __float_as_uint(ps), false, false);
      ps = __uint_as_float(rr[0]) + __uint_as_float(rr[1]); }
    l_reg = l_reg * alpha + ps;
#define PK4(P, BASE, OUT) do { unsigned a0 = cvt_pk_bf16(P[BASE + 0], P[BASE + 1]), a1 = cvt_pk_bf16(P[BASE + 2], P[BASE + 3]);   \
    unsigned b0 = cvt_pk_bf16(P[BASE + 4], P[BASE + 5]), b1 = cvt_pk_bf16(P[BASE + 6], P[BASE + 7]);                              \
    auto r0 = __builtin_amdgcn_permlane32_swap(a0, b0, false, false); auto r1 = __builtin_amdgcn_permlane32_swap(a1, b1, false, false); \
    u32x4 w = {r0[0], r1[0], r0[1], r1[1]}; OUT = __builtin_bit_cast(bf16x8, w); } while (0)
    PK4(p0, 0, pa0); PK4(p0, 8, pa1); PK4(p1, 0, pa2); PK4(p1, 8, pa3);
#undef PK4
}

__device__ __forceinline__ unsigned cvtpk_v(float lo, float hi) { f32x2 v = {lo, hi}; bf16x2_t b = __builtin_convertvector(v, bf16x2_t); return __builtin_bit_cast(unsigned, b); }
#define PK4V(P, BASE, OUT) do { unsigned a0 = cvtpk_v(P[BASE + 0], P[BASE + 1]), a1 = cvtpk_v(P[BASE + 2], P[BASE + 3]);   \
    unsigned b0 = cvtpk_v(P[BASE + 4], P[BASE + 5]), b1 = cvtpk_v(P[BASE + 6], P[BASE + 7]);                              \
    auto r0 = __builtin_amdgcn_permlane32_swap(a0, b0, false, false); auto r1 = __builtin_amdgcn_permlane32_swap(a1, b1, false, false); \
    u32x4 w = {r0[0], r1[0], r0[1], r1[1]}; OUT = __builtin_bit_cast(bf16x8, w); } while (0)
__device__ __forceinline__ void partialSM_fix(f32x16& p0, float& l_reg, bf16x8& q0, bf16x8& q1) {
    float ps = 0.f;
#pragma unroll
    for (int r = 0; r < 16; ++r) { p0[r] = __builtin_amdgcn_exp2f(p0[r]); ps += p0[r]; }
    l_reg += ps;
    PK4V(p0, 0, q0); PK4V(p0, 8, q1);
}
__device__ __forceinline__ void finishSM_fix(f32x16& p1, float& l_reg, const bf16x8& q0, const bf16x8& q1, bf16x8& pa0, bf16x8& pa1, bf16x8& pa2, bf16x8& pa3) {
    float ps = 0.f;
#pragma unroll
    for (int r = 0; r < 16; ++r) { p1[r] = __builtin_amdgcn_exp2f(p1[r]); ps += p1[r]; }
    l_reg += ps;
    pa0 = q0; pa1 = q1; PK4V(p1, 0, pa2); PK4V(p1, 8, pa3);
}
template <int DQK> __device__ __forceinline__ void qkt(f32x16& p0, f32x16& p1, const LAS char* Ks, const bf16x8* qr, int r32, int hi) {
    p0 = f32x16{}; p1 = f32x16{};
#pragma unroll
    for (int d0 = 0; d0 < DQK / 16; ++d0) { const int cb = (d0 * 16 + hi * 8) * 2;
        const bf16x8 b0 = *(const LAS bf16x8*)(Ks + KT<DQK>::swz(r32, cb));
        const bf16x8 b1 = *(const LAS bf16x8*)(Ks + KT<DQK>::swz(32 + r32, cb));
        p0 = __builtin_amdgcn_mfma_f32_32x32x16_bf16(b0, qr[d0], p0, 0, 0, 0);
        p1 = __builtin_amdgcn_mfma_f32_32x32x16_bf16(b1, qr[d0], p1, 0, 0, 0);
        if constexpr (DQK == 96) { if (d0 == 1 || d0 == 3) SBAR(); } }
}
template <int DQK> __device__ __forceinline__ void qkt_q(f32x16& p0, f32x16& p1, const LAS char* Ks, const LAS char* Qs, int r32, int hi) {
    p0 = f32x16{}; p1 = f32x16{};
#pragma unroll
    for (int d0 = 0; d0 < DQK / 16; ++d0) { const int cb = (d0 * 16 + hi * 8) * 2;
        const bf16x8 b0 = *(const LAS bf16x8*)(Ks + KT<DQK>::swz(r32, cb));
        const bf16x8 b1 = *(const LAS bf16x8*)(Ks + KT<DQK>::swz(32 + r32, cb));
        const bf16x8 q = *(const LAS bf16x8*)(Qs + r32 * 208 + cb);
        p0 = __builtin_amdgcn_mfma_f32_32x32x16_bf16(b0, q, p0, 0, 0, 0);
        p1 = __builtin_amdgcn_mfma_f32_32x32x16_bf16(b1, q, p1, 0, 0, 0); }
}
template <int DV, int D0> __device__ __forceinline__ void pv_one(f32x16& od, int vb, bf16x8 pa0, bf16x8 pa1, bf16x8 pa2, bf16x8 pa3) {
    typedef VT<DV> V_;
    const s16x4 l0 = tr_read<V_::rd_off(D0, 0, 0)>(vb), h0 = tr_read<V_::rd_off(D0, 0, 1)>(vb), l1 = tr_read<V_::rd_off(D0, 1, 0)>(vb), h1 = tr_read<V_::rd_off(D0, 1, 1)>(vb);
    const s16x4 l2 = tr_read<V_::rd_off(D0, 2, 0)>(vb), h2 = tr_read<V_::rd_off(D0, 2, 1)>(vb), l3 = tr_read<V_::rd_off(D0, 3, 0)>(vb), h3 = tr_read<V_::rd_off(D0, 3, 1)>(vb);
    asm volatile("s_waitcnt lgkmcnt(0)" ::: "memory"); SBAR();
#define PK(L, H) (bf16x8){L[0], L[1], L[2], L[3], H[0], H[1], H[2], H[3]}
    od = __builtin_amdgcn_mfma_f32_32x32x16_bf16(pa0, PK(l0, h0), od, 0, 0, 0);
    od = __builtin_amdgcn_mfma_f32_32x32x16_bf16(pa1, PK(l1, h1), od, 0, 0, 0);
    od = __builtin_amdgcn_mfma_f32_32x32x16_bf16(pa2, PK(l2, h2), od, 0, 0, 0);
    od = __builtin_amdgcn_mfma_f32_32x32x16_bf16(pa3, PK(l3, h3), od, 0, 0, 0);
#undef PK
}
template <int DV> __device__ __forceinline__ void pv_all(f32x16* o, int vb, bf16x8 pa0, bf16x8 pa1, bf16x8 pa2, bf16x8 pa3) {
    pv_one<DV, 0>(o[0], vb, pa0, pa1, pa2, pa3); pv_one<DV, 1>(o[1], vb, pa0, pa1, pa2, pa3);
    if constexpr (DV == 128) { pv_one<DV, 2>(o[2], vb, pa0, pa1, pa2, pa3); pv_one<DV, 3>(o[3], vb, pa0, pa1, pa2, pa3); }
}
template <int DQK, int DV> constexpr int lds_bytes() { return 2 * VT<DV>::BYTES + 2 * KT<DQK>::BYTES + 8 * 64 * 4; }

template <int DQK, int DV, bool FIX = false, bool QLDS = false>
__device__ __forceinline__ void attn_unit(const bf16_t* __restrict__ Qb, const bf16_t* __restrict__ Kh, const bf16_t* __restrict__ Vh, bf16_t* __restrict__ Ob, int ldo, int seq, LAS char* lds, int wv) {
    typedef KT<DQK> K_; typedef VT<DV> V_;
    constexpr int NCB = V_::NCB, NQ = DQK / 16;
    constexpr int SHM_V = V_::BYTES, SHM_K = K_::BYTES;
    constexpr int NKC = (DQK == 64) ? 1 : 2, NVC = (DV == 64) ? 1 : 2;
    const int tid = mk_tid(wv);
    const int wid = tid >> 6, lane = tid & 63, r32 = lane & 31, hi = lane >> 5;
    LAS char* V_lds = lds; LAS char* K_lds = lds + 2 * SHM_V;
    LAS float* wsf = (LAS float*)(lds + 2 * SHM_V + 2 * SHM_K) + wid * 64; LAS float* li_l = wsf; LAS float* al_l = wsf + 32;
    float m_reg = -1e30f, l_reg = 0; f32x16 o[NCB]; bf16x8 qr[NQ];
#pragma unroll
    for (int d = 0; d < NCB; ++d) o[d] = f32x16{};
    const bf16_t* Qw = Qb + (long)(wid * 32 + r32) * DQK + hi * 8;
#pragma unroll
    for (int d0 = 0; d0 < NQ; ++d0) qr[d0] = *(const bf16x8*)(Qw + d0 * 16);
    LAS char* Qs = lds + lds_bytes<DQK, DV>() + wid * 6656;
    if constexpr (QLDS) {
#pragma unroll
        for (int d0 = 0; d0 < NQ; ++d0) *(LAS bf16x8*)(Qs + r32 * 208 + (d0 * 16 + hi * 8) * 2) = qr[d0];
    }
#define QKT(P0, P1, KB) do { if constexpr (QLDS) qkt_q<DQK>(P0, P1, KB, Qs, r32, hi); else qkt<DQK>(P0, P1, KB, qr, r32, hi); } while (0)
    int krow[NKC], kcol[NKC], vrow[NVC], vcol[NVC];
    if constexpr (DQK == 64) { krow[0] = tid >> 3; kcol[0] = (tid & 7) * 8; }
    else { const int c0 = tid, c1 = 512 + (tid & 255); krow[0] = c0 / 12; kcol[0] = (c0 % 12) * 8; krow[1] = c1 / 12; kcol[1] = (c1 % 12) * 8; }
    if constexpr (DV == 64) { vrow[0] = tid >> 3; vcol[0] = (tid & 7) * 8; }
    else { vrow[0] = tid >> 4; vcol[0] = (tid & 15) * 8; vrow[1] = 32 + (tid >> 4); vcol[1] = (tid & 15) * 8; }
    const int vb0 = (int)(uintptr_t)V_lds + v_rd_base(lane);
    bf16x8 ksE[NKC], vsE[NVC];
#define SLOAD(KS, VS, k0) do { _Pragma("unroll") for (int i_ = 0; i_ < NVC; ++i_) VS[i_] = *(const bf16x8*)(Vh + (long)((k0) + vrow[i_]) * DV + vcol[i_]); \
    _Pragma("unroll") for (int i_ = 0; i_ < NKC; ++i_) KS[i_] = *(const bf16x8*)(Kh + (long)((k0) + krow[i_]) * DQK + kcol[i_]); } while (0)
#define SWRITE(b, KS, VS) do { _Pragma("unroll") for (int i_ = 0; i_ < NVC; ++i_) *(LAS bf16x8*)(V_lds + (b) * SHM_V + V_::v_st(vrow[i_], vcol[i_])) = VS[i_]; \
    _Pragma("unroll") for (int i_ = 0; i_ < NKC; ++i_) *(LAS bf16x8*)(K_lds + (b) * SHM_K + K_::swz(krow[i_], kcol[i_] * 2)) = KS[i_]; } while (0)
#define RESC(a) do { if (__any((a) < 1.f)) { if (hi == 0) al_l[r32] = (a); asm volatile("s_waitcnt lgkmcnt(0)" ::: "memory"); \
    _Pragma("unroll") for (int d = 0; d < NCB; ++d) _Pragma("unroll") for (int r = 0; r < 16; ++r) o[d][r] *= al_l[crow(r, hi)]; } } while (0)
#define XSB() do { if constexpr (FIX && DQK == 96) SBAR(); } while (0)
    s16x4 fl0, fh0, fl1, fh1, fl2, fh2, fl3, fh3;
#define PVPRE(vb) do { if constexpr (FIX && DQK == 64) { fl0 = tr_read<V_::rd_off(0, 0, 0)>(vb); fh0 = tr_read<V_::rd_off(0, 0, 1)>(vb); fl1 = tr_read<V_::rd_off(0, 1, 0)>(vb); fh1 = tr_read<V_::rd_off(0, 1, 1)>(vb); \
        fl2 = tr_read<V_::rd_off(0, 2, 0)>(vb); fh2 = tr_read<V_::rd_off(0, 2, 1)>(vb); fl3 = tr_read<V_::rd_off(0, 3, 0)>(vb); fh3 = tr_read<V_::rd_off(0, 3, 1)>(vb); } } while (0)
#define PKF(L, H) (bf16x8){L[0], L[1], L[2], L[3], H[0], H[1], H[2], H[3]}
#define PVALL(vb) do { if constexpr (FIX && DQK == 64) { asm volatile("s_waitcnt lgkmcnt(0)" ::: "memory"); SBAR(); \
        o[0] = __builtin_amdgcn_mfma_f32_32x32x16_bf16(pa0, PKF(fl0, fh0), o[0], 0, 0, 0); o[0] = __builtin_amdgcn_mfma_f32_32x32x16_bf16(pa1, PKF(fl1, fh1), o[0], 0, 0, 0); \
        o[0] = __builtin_amdgcn_mfma_f32_32x32x16_bf16(pa2, PKF(fl2, fh2), o[0], 0, 0, 0); o[0] = __builtin_amdgcn_mfma_f32_32x32x16_bf16(pa3, PKF(fl3, fh3), o[0], 0, 0, 0); \
        pv_one<DV, 1>(o[1], vb, pa0, pa1, pa2, pa3); if constexpr (DV == 128) { pv_one<DV, 2>(o[2], vb, pa0, pa1, pa2, pa3); pv_one<DV, 3>(o[3], vb, pa0, pa1, pa2, pa3); } } \
      else pv_all<DV>(o, vb, pa0, pa1, pa2, pa3); } while (0)
    f32x16 pA0, pA1, pB0, pB1; float alA = 1.f, alB = 1.f; bf16x8 pa0, pa1, pa2, pa3, qA0, qA1, qB0, qB1; const int NT = seq / 64;
#define PSM(P0, P1, AL, Q0, Q1) do { if constexpr (FIX) partialSM_fix(P0, l_reg, Q0, Q1); else partialSM(P0, P1, m_reg, AL); } while (0)
#define FSM(P0, P1, AL, Q0, Q1) do { if constexpr (FIX) finishSM_fix(P1, l_reg, Q0, Q1, pa0, pa1, pa2, pa3); else finishSM(P0, P1, AL, l_reg, pa0, pa1, pa2, pa3); } while (0)
#define RSC(AL) do { if constexpr (!FIX) { RESC(AL); } } while (0)
    SLOAD(ksE, vsE, 0); SWRITE(0, ksE, vsE); __syncthreads();
    QKT(pA0, pA1, K_lds); PSM(pA0, pA1, alA, qA0, qA1);
    SLOAD(ksE, vsE, 64); SWRITE(1, ksE, vsE); if (2 < NT) SLOAD(ksE, vsE, 128);
    __syncthreads();
    for (int j = 1; j + 1 < NT; j += 2) {
        SBAR(); QKT(pB0, pB1, K_lds + SHM_K); XSB(); PVPRE(vb0);
        FSM(pA0, pA1, alA, qA0, qA1); SBAR();
        PVALL(vb0); XSB(); PSM(pB0, pB1, alB, qB0, qB1);
        __syncthreads(); SWRITE(0, ksE, vsE); SBAR();
        if (j + 2 < NT) SLOAD(ksE, vsE, (j + 2) * 64); SBAR();
        RSC(alB); __syncthreads();
        SBAR(); QKT(pA0, pA1, K_lds); XSB(); PVPRE(vb0 + SHM_V);
        FSM(pB0, pB1, alB, qB0, qB1); SBAR();
        PVALL(vb0 + SHM_V); XSB(); PSM(pA0, pA1, alA, qA0, qA1);
        __syncthreads(); SWRITE(1, ksE, vsE); SBAR();
        if (j + 3 < NT) SLOAD(ksE, vsE, (j + 3) * 64); SBAR();
        RSC(alA); __syncthreads();
    }
    SBAR(); QKT(pB0, pB1, K_lds + SHM_K); PVPRE(vb0);
    FSM(pA0, pA1, alA, qA0, qA1); SBAR();
    PVALL(vb0); PSM(pB0, pB1, alB, qB0, qB1);
    __syncthreads(); RSC(alB);
    PVPRE(vb0 + SHM_V);
    FSM(pB0, pB1, alB, qB0, qB1); SBAR();
    PVALL(vb0 + SHM_V);
    if constexpr (FIX) { auto rr = __builtin_amdgcn_permlane32_swap(__float_as_uint(l_reg), __float_as_uint(l_reg), false, false); l_reg = __uint_as_float(rr[0]) + __uint_as_float(rr[1]); }
#undef PSM
#undef PVPRE
#undef PVALL
#undef PKF
#undef XSB
#undef FSM
#undef RSC
    {
        const int tid2 = mk_tid(wv), wid2 = tid2 >> 6, lane2 = tid2 & 63, r32b = lane2 & 31, hib = lane2 >> 5;
        LAS float* li2 = (LAS float*)(lds + 2 * SHM_V + 2 * SHM_K) + wid2 * 64;
        if (hib == 0) li2[r32b] = l_reg; asm volatile("s_waitcnt lgkmcnt(0)" ::: "memory");
        float rli[16];
#pragma unroll
        for (int r = 0; r < 16; ++r) rli[r] = __builtin_amdgcn_rcpf(li2[crow(r, hib)]);
        bf16_t* Ow = Ob + (long)(wid2 * 32) * ldo;
#pragma unroll
        for (int r = 0; r < 16; ++r) { const int orow = crow(r, hib);
#pragma unroll
            for (int d0 = 0; d0 < NCB; ++d0) Ow[(long)orow * ldo + d0 * 32 + r32b] = (bf16_t)f2bf(o[d0][r] * rli[r]); }
    }
    __syncthreads();
#undef SLOAD
#undef QKT
#undef SWRITE
#undef RESC
}
#undef SBAR
}

namespace att64 {
using bf16=__hip_bfloat16;
using bf16x8=__attribute__((ext_vector_type(8)))short;
using s16x4=__attribute__((ext_vector_type(4)))short;
using f32x16=__attribute__((ext_vector_type(16)))float;
using u32x4=__attribute__((ext_vector_type(4)))unsigned;
constexpr int D=64;
constexpr int NW=8,QBLK=32,QB=QBLK*NW,KVBLK=64;
__device__ __forceinline__ int crow(int r,int hi){return (r&3)+8*(r>>2)+4*hi;}
#define SBAR() __builtin_amdgcn_sched_barrier(0)
__device__ __forceinline__ void cmask(f32x16&p0,f32x16&p1,int jb,int qrel,int hi){
  const float NEG=-INFINITY; int kb=64*jb+4*hi;
  #pragma unroll
  for(int r=0;r<16;++r){int kv=kb+(r&3)+8*(r>>2); if(kv>qrel)p0[r]=NEG; if(kv+32>qrel)p1[r]=NEG;}
}

constexpr int NSLOT=3, SLOTB=8192;
constexpr int LDS_K=0;
template<int DQ> constexpr int lds_v(){return NSLOT*(DQ/8)*1024;} template<int NVH,int DQ> constexpr int lds_ws(){return lds_v<DQ>()+NSLOT*SLOTB*NVH;} template<int NVH,int DQ> constexpr int lds_ost(){return lds_ws<NVH,DQ>()+NW*64*4;} template<int NVH,int DQ> constexpr int lds_bytes(){return lds_ost<NVH,DQ>()+NW*4096*NVH;}
constexpr float C2=0.125f*1.4426950408889634f;
__device__ __forceinline__ void glds16(const void*gsrc,unsigned lds_dst){unsigned keep;
  asm volatile("s_mov_b32 %0, m0\n\ts_mov_b32 m0, %2\n\ts_nop 0\n\tglobal_load_lds_dwordx4 %1, off\n\ts_mov_b32 m0, %0":"=&s"(keep):"v"(gsrc),"s"(lds_dst):"memory");}
__device__ __forceinline__ float max3f(float a,float b,float c){float r;asm("v_max3_f32 %0, %1, %2, %3":"=v"(r):"v"(a),"v"(b),"v"(c));return r;}
__device__ __forceinline__ float max2f(float a,float b){float r;asm("v_max_f32_e32 %0, %1, %2":"=v"(r):"v"(a),"v"(b));return r;}
__device__ __forceinline__ float fadd_s(float a,float b){float r;asm("v_add_f32_e32 %0, %1, %2":"=v"(r):"v"(a),"v"(b));return r;}
__device__ __forceinline__ float fsub_s(float a,float b){float r;asm("v_sub_f32_e32 %0, %1, %2":"=v"(r):"v"(a),"v"(b));return r;}
typedef float f32x2_t __attribute__((ext_vector_type(2))); typedef __bf16 bf16x2_t __attribute__((ext_vector_type(2)));
__device__ __forceinline__ unsigned cvtpk_s(float lo,float hi){f32x2_t v={lo,hi};bf16x2_t b=__builtin_convertvector(v,bf16x2_t);return __builtin_bit_cast(unsigned,b);}
#define WAIT_BAR(N) asm volatile("s_waitcnt vmcnt(" #N ") lgkmcnt(0)\n\ts_barrier":::"memory")
#define WAIT_N(n) do{ if constexpr((n)==0){WAIT_BAR(0);} else if constexpr((n)==1){WAIT_BAR(1);} else if constexpr((n)==2){WAIT_BAR(2);} else if constexpr((n)==3){WAIT_BAR(3);} else if constexpr((n)==4){WAIT_BAR(4);} else if constexpr((n)==5){WAIT_BAR(5);} else {WAIT_BAR(6);} }while(0)

template<int NQ> __device__ __forceinline__ void qkt(f32x16&p0,f32x16&p1,const char*Kslot,const bf16x8*qr,const f32x16&negm,int r32,int hi){
  const char*kb=Kslot+hi*1024+r32*16;
  #pragma unroll
  for(int d0=0;d0<NQ;++d0){
    const bf16x8 b0=*reinterpret_cast<const bf16x8*>(kb+d0*2048);
    const bf16x8 b1=*reinterpret_cast<const bf16x8*>(kb+d0*2048+512);
    if(d0==0){p0=__builtin_amdgcn_mfma_f32_32x32x16_bf16(b0,qr[0],negm,0,0,0);p1=__builtin_amdgcn_mfma_f32_32x32x16_bf16(b1,qr[0],negm,0,0,0);}
    else{p0=__builtin_amdgcn_mfma_f32_32x32x16_bf16(b0,qr[d0],p0,0,0,0);p1=__builtin_amdgcn_mfma_f32_32x32x16_bf16(b1,qr[d0],p1,0,0,0);}}
}
typedef __attribute__((address_space(3))) const char* lds_cptr;
typedef short v4i16_t __attribute__((ext_vector_type(4)));
__device__ __forceinline__ void kload8(bf16x8*kf,lds_cptr kp){
  kf[0]=*(const __attribute__((address_space(3))) bf16x8*)(kp);      kf[1]=*(const __attribute__((address_space(3))) bf16x8*)(kp+512);
  kf[2]=*(const __attribute__((address_space(3))) bf16x8*)(kp+2048); kf[3]=*(const __attribute__((address_space(3))) bf16x8*)(kp+2560);
  kf[4]=*(const __attribute__((address_space(3))) bf16x8*)(kp+4096); kf[5]=*(const __attribute__((address_space(3))) bf16x8*)(kp+4608);
  kf[6]=*(const __attribute__((address_space(3))) bf16x8*)(kp+6144); kf[7]=*(const __attribute__((address_space(3))) bf16x8*)(kp+6656);
}
__device__ __forceinline__ void kload2(bf16x8*kf,lds_cptr kp,int j){ kf[2*j]=*(const __attribute__((address_space(3))) bf16x8*)(kp+j*2048); kf[2*j+1]=*(const __attribute__((address_space(3))) bf16x8*)(kp+j*2048+512); }
template<int NQ> __device__ __forceinline__ void kloadn(bf16x8*kf,lds_cptr kp){
  #pragma unroll
  for(int j=0;j<NQ;++j)kload2(kf,kp,j);
}
__device__ __forceinline__ s16x4 vtr(lds_cptr p){ return __builtin_bit_cast(s16x4,__builtin_amdgcn_ds_read_tr16_b64_v4i16((__attribute__((address_space(3))) v4i16_t*)p)); }
__device__ __forceinline__ float rowmax(const f32x16&p0,const f32x16&p1){
  float a=max3f(p0[0],p0[1],p1[0]),b=max3f(p0[2],p0[3],p1[1]);a=max3f(a,p1[2],p1[3]);
  #pragma unroll
  for(int r=4;r<16;r+=4){a=max3f(a,p0[r],p0[r+1]);b=max3f(b,p0[r+2],p0[r+3]);a=max3f(a,p1[r],p1[r+1]);b=max3f(b,p1[r+2],p1[r+3]);}
  const float m=max2f(a,b);
  auto rr=__builtin_amdgcn_permlane32_swap(__float_as_uint(m),__float_as_uint(m),false,false);
  return max2f(__uint_as_float(rr[0]),__uint_as_float(rr[1]));
}
template<int NO> __device__ __forceinline__ void pv(f32x16*o,int vb,bf16x8 pa0,bf16x8 pa1,bf16x8 pa2,bf16x8 pa3){
  #pragma unroll
  for(int d0=0;d0<NO;++d0){s16x4 lo[4],hi[4];
    #pragma unroll
    for(int ks=0;ks<4;++ks){
      asm volatile("ds_read_b64_tr_b16 %0,%1 offset:%c2":"=&v"(lo[ks]):"v"(vb),"i"(d0*4096+ks*1024):"memory");
      asm volatile("ds_read_b64_tr_b16 %0,%1 offset:%c2":"=&v"(hi[ks]):"v"(vb),"i"(d0*4096+ks*1024+512):"memory");}
    asm volatile("s_waitcnt lgkmcnt(0)":::"memory");SBAR();
    #define PK(k) (bf16x8){lo[k][0],lo[k][1],lo[k][2],lo[k][3],hi[k][0],hi[k][1],hi[k][2],hi[k][3]}
    o[d0]=__builtin_amdgcn_mfma_f32_32x32x16_bf16(pa0,PK(0),o[d0],0,0,0);
    o[d0]=__builtin_amdgcn_mfma_f32_32x32x16_bf16(pa1,PK(1),o[d0],0,0,0);
    o[d0]=__builtin_amdgcn_mfma_f32_32x32x16_bf16(pa2,PK(2),o[d0],0,0,0);
    o[d0]=__builtin_amdgcn_mfma_f32_32x32x16_bf16(pa3,PK(3),o[d0],0,0,0);
    #undef PK
  }
}

#ifndef ATTN_STORE16
#define ATTN_STORE16(p,v) (*(u32x4*)(p)=(v))
#endif
template<int THRL,bool FIX=false,int NVH=1,int DQ=64,int EPI=0> __device__ __forceinline__ void attn_unit(const bf16*Qu,const int QP,const bf16*__restrict__ Kh,const bf16*__restrict__ Vh,const int KP,const int VP,bf16*Ou,const int OP,const int NT,char*shm,int wv,
    const bf16*O1=nullptr,const int OP1=0,const float lam=0.f,const float*gsub=nullptr,const float osc=1.f){
  static_assert(NVH==1||FIX,"the 128-wide V form exists only for the fixed-reference softmax");
  static_assert(DQ==64||(DQ==96&&NVH==2&&FIX),"96-wide q/k only in the fixed-reference 128-wide-V form");
  constexpr int NO=2*NVH, NQ=DQ/16, NKD=(DQ==64)?1:2, KSLOT=(DQ/8)*1024, LDS_V=lds_v<DQ>(), LDS_WS=lds_ws<NVH,DQ>(), LDS_OST=lds_ost<NVH,DQ>();
  const int tid=mk_tid(wv); const int lane=tid&63,r32=lane&31,hi=lane>>5; const int wid=__builtin_amdgcn_readfirstlane(tid>>6);
  const bf16*Qw=Qu+(long)(wid*QBLK)*QP;
  const unsigned lds0=(unsigned)(uintptr_t)shm;
  float*wsf=(float*)(shm+LDS_WS)+wid*64;
  const bf16*ksrc=Kh+(long)lane*KP+wid*8;
  const bf16*vsrc=Vh+(long)(16*(wid&3)+(lane>>2))*VP+(wid>>2)*32+(lane&3)*8;
  const unsigned kdst=lds0+LDS_K+wid*1024, vdst=lds0+LDS_V+wid*1024;
  #define KSL(sl) ((DQ==64)?(sl):((sl)+((sl)>>1)))
  #define DMA_K(t,slot) do{ glds16(ksrc+(long)(t)*KVBLK*KP,(unsigned)__builtin_amdgcn_readfirstlane(kdst+KSL(slot))); if constexpr(NKD==2) glds16(ksrc+(8+(wid&3)-wid)*8+(long)(t)*KVBLK*KP,(unsigned)__builtin_amdgcn_readfirstlane(kdst+KSL(slot)+(8+(wid&3)-wid)*1024)); }while(0)
  #define DMA_V(t,slot) do{ glds16(vsrc+(long)(t)*KVBLK*VP,(unsigned)__builtin_amdgcn_readfirstlane(vdst+(slot)*NVH)); if constexpr(NVH==2) glds16(vsrc+64+(long)(t)*KVBLK*VP,(unsigned)__builtin_amdgcn_readfirstlane(vdst+(slot)*NVH+8192)); }while(0)
  const int vb0=(int)(lds0+LDS_V)+((lane>>4)&1)*32+(lane&3)*8+(4*hi+((lane&15)>>2))*64;
  const char*Kbase=shm+LDS_K; bf16x8 kf[2*NQ];
  const lds_cptr shm3=(lds_cptr)shm; const lds_cptr kp0=shm3+LDS_K+hi*1024+r32*16; const lds_cptr vp0=shm3+LDS_V+((lane>>4)&1)*32+(lane&3)*8+(4*hi+((lane&15)>>2))*64;
  DMA_K(0,0);DMA_V(0,0);DMA_K(1,SLOTB);
  bf16x8 qr[NQ];
  #pragma unroll
  for(int d0=0;d0<NQ;++d0)qr[d0]=*reinterpret_cast<const bf16x8*>(&Qw[(long)r32*QP+d0*16+hi*8]);
  float mhat=0.f,l_reg=0.f;f32x16 o[NO];
  _Pragma("unroll") for(int d_=0;d_<NO;++d_)o[d_]=f32x16{};
  f32x16 negm=f32x16{}; if constexpr(!FIX){asm volatile("":"+v"(negm));}
  #define NEGM (FIX?f32x16{}:negm)
  const int qrel=wid*QBLK+r32;
  #define CMASK(P0,P1,t) do{}while(0)
  bool resc=false;
  #define START(P0,P1) do{ resc=false; if constexpr(!FIX){ const float rm=rowmax(P0,P1); \
    { const float dl=rm; mhat=fadd_s(mhat,dl); \
      _Pragma("unroll") for(int r=0;r<16;++r){P0[r]=fsub_s(P0[r],dl);P1[r]=fsub_s(P1[r],dl);} \
      _Pragma("unroll") for(int r=0;r<16;++r)negm[r]=-mhat; asm volatile("":"+v"(negm)); } } \
    _Pragma("unroll") for(int r=0;r<16;++r)P0[r]=__builtin_amdgcn_exp2f(P0[r]); }while(0)
  #define RESC() do{ if(resc){ asm volatile("s_waitcnt lgkmcnt(0)":::"memory"); \
      _Pragma("unroll") for(int d_=0;d_<NO;++d_) _Pragma("unroll") for(int r=0;r<16;++r)o[d_][r]*=wsf[crow(r,hi)]; } }while(0)
  f32x16 pA0,pA1,pB0,pB1;
  int sl_prev=0,sl_cur=0,sl_next=SLOTB;
  #define ROT() do{sl_prev=sl_cur;sl_cur=sl_next;sl_next=(sl_next==(NSLOT-1)*SLOTB)?0:sl_next+SLOTB;}while(0)
  DMA_K(2,2*SLOTB);
  WAIT_N(NVH+2*NKD);
  qkt<NQ>(pA0,pA1,Kbase,qr,NEGM,r32,hi);asm volatile("s_nop 15\n\ts_nop 7":"+v"(pA0),"+v"(pA1));CMASK(pA0,pA1,0);
  START(pA0,pA1);
  _Pragma("unroll") for(int r=0;r<16;++r)pA1[r]=__builtin_amdgcn_exp2f(pA1[r]);
  WAIT_BAR(0);
  DMA_K(3,0);DMA_V(1,SLOTB);
  ROT();
  kloadn<NQ>(kf,kp0+KSL(sl_cur));
  WAIT_N(NVH+NKD);
  s16x4 vlo[8],vhi[8]; u32x4 pw0,pw1,pw2,pw3;
  #define PKW(P,B) cvtpk_s(P[B],P[B+1])
  #define PAF(k) __builtin_bit_cast(bf16x8,pw##k)
  #define VFR(i) (bf16x8){vlo[i][0],vlo[i][1],vlo[i][2],vlo[i][3],vhi[i][0],vhi[i][1],vhi[i][2],vhi[i][3]}
  #define PIN(x) asm volatile("":"+v"(x))
  #define MX3(a,b,c) __builtin_fmaxf(__builtin_fmaxf((a),(b)),(c))
  #define GAPA(MF,A0,A1,A2,A3,W0,W1,PW) do{ MF; sacc+=A0; sacc+=A1; sacc+=A2; sacc+=A3; PIN(sacc); W0; W1; PIN(PW); SBAR(); }while(0)
  #define EX(v) __builtin_amdgcn_exp2f(v)
  #define GAPB(MF,X,B) do{ MF; X[B]=EX(X[B]); X[B+1]=EX(X[B+1]); X[B+2]=EX(X[B+2]); X[B+3]=EX(X[B+3]); PIN(X); SBAR(); }while(0)
  #define VRD(i) do{ vlo[i]=vtr(vp_+(((i)>>2)*4096+((i)&3)*1024)); vhi[i]=vtr(vp_+(((i)>>2)*4096+((i)&3)*1024+512)); }while(0)
  #define VRD2(i) do{ vlo[i]=vtr(vp_+(8192+((i)>>2)*4096+((i)&3)*1024)); vhi[i]=vtr(vp_+(8192+((i)>>2)*4096+((i)&3)*1024+512)); }while(0)
  #define GAPC(MF,RD,X,B) do{ MF; RD; X[B]=EX(X[B]); X[B+1]=EX(X[B+1]); PIN(X); SBAR(); }while(0)
  #define KRD(G,j) do{ if(G){ kload2(kf,kp0+KSL(sl_next),j); SBAR(); } }while(0)
  #define STEP(C0,C1,P0,P1,t,GK,GV,GL) do{ SBAR(); \
    const lds_cptr vp_=vp0+sl_prev*NVH; \
    VRD(0); SBAR(); float sacc=(P0[0]+P0[1]); \
    GAPA(C0=__builtin_amdgcn_mfma_f32_32x32x16_bf16(kf[0],qr[0],NEGM,0,0,0), P0[2],P0[3],P0[4],P0[5],     pw0[0]=PKW(P0,0), pw0[1]=PKW(P0,2), pw0); \
    VRD(4); SBAR(); GAPA(C1=__builtin_amdgcn_mfma_f32_32x32x16_bf16(kf[1],qr[0],NEGM,0,0,0), P0[6],P0[7],P0[8],P0[9],     pw0[2]=PKW(P0,4), pw0[3]=PKW(P0,6), pw0); \
    VRD(1); SBAR(); GAPA(C0=__builtin_amdgcn_mfma_f32_32x32x16_bf16(kf[2],qr[1],C0,0,0,0),   P0[10],P0[11],P0[12],P0[13], pw1[0]=PKW(P0,8), pw1[1]=PKW(P0,10), pw1); \
    VRD(5); SBAR(); GAPA(C1=__builtin_amdgcn_mfma_f32_32x32x16_bf16(kf[3],qr[1],C1,0,0,0),   P0[14],P0[15],P1[0],P1[1],   pw1[2]=PKW(P0,12),pw1[3]=PKW(P0,14), pw1); \
    VRD(2); SBAR(); GAPA(C0=__builtin_amdgcn_mfma_f32_32x32x16_bf16(kf[4],qr[2],C0,0,0,0),   P1[2],P1[3],P1[4],P1[5],     pw2[0]=PKW(P1,0), pw2[1]=PKW(P1,2), pw2); \
    VRD(6); SBAR(); GAPA(C1=__builtin_amdgcn_mfma_f32_32x32x16_bf16(kf[5],qr[2],C1,0,0,0),   P1[6],P1[7],P1[8],P1[9],     pw2[2]=PKW(P1,4), pw2[3]=PKW(P1,6), pw2); \
    VRD(3); SBAR(); GAPA(C0=__builtin_amdgcn_mfma_f32_32x32x16_bf16(kf[6],qr[3],C0,0,0,0),   P1[10],P1[11],P1[12],P1[13], pw3[0]=PKW(P1,8), pw3[1]=PKW(P1,10), pw3); \
    VRD(7); SBAR(); GAPA(C1=__builtin_amdgcn_mfma_f32_32x32x16_bf16(kf[7],qr[3],C1,0,0,0),   P1[14],P1[15],0.f,0.f,       pw3[2]=PKW(P1,12),pw3[3]=PKW(P1,14), pw3); \
    if constexpr(NQ==6){ C0=__builtin_amdgcn_mfma_f32_32x32x16_bf16(kf[8],qr[4],C0,0,0,0); C1=__builtin_amdgcn_mfma_f32_32x32x16_bf16(kf[9],qr[4],C1,0,0,0); C0=__builtin_amdgcn_mfma_f32_32x32x16_bf16(kf[10],qr[5],C0,0,0,0); C1=__builtin_amdgcn_mfma_f32_32x32x16_bf16(kf[11],qr[5],C1,0,0,0); SBAR(); } \
    l_reg+=sacc; \
    if(GK){DMA_K((t)+3,sl_cur);} if(GV){DMA_V((t)+1,sl_next);} \
    CMASK(C0,C1,t); \
        if constexpr(!FIX){ float a=MX3(C0[0],C0[1],C1[0]),b=MX3(C0[2],C0[3],C1[1]); a=MX3(a,C1[2],C1[3]); \
      _Pragma("unroll") for(int r=4;r<16;r+=4){a=MX3(a,C0[r],C0[r+1]);b=MX3(b,C0[r+2],C0[r+3]);a=MX3(a,C1[r],C1[r+1]);b=MX3(b,C1[r+2],C1[r+3]);} \
      float rm=__builtin_fmaxf(a,b); { auto rr=__builtin_amdgcn_permlane32_swap(__float_as_uint(rm),__float_as_uint(rm),false,false); rm=__builtin_fmaxf(__uint_as_float(rr[0]),__uint_as_float(rr[1])); } \
      resc=false; \
      if(__builtin_expect(__any(rm>(float)THRL),0)){ const float dl=__builtin_fmaxf(rm,0.f); mhat+=dl; \
        _Pragma("unroll") for(int r=0;r<16;++r){C0[r]-=dl;C1[r]-=dl;} \
        _Pragma("unroll") for(int r=0;r<16;++r)negm[r]=-mhat; asm volatile("":"+v"(negm)); \
        const float f=__builtin_amdgcn_exp2f(-dl); l_reg*=f; if(hi==0)wsf[r32]=f; resc=true; } } \
    SBAR(); \
    if constexpr(NVH==1){ \
    GAPB(o[0]=__builtin_amdgcn_mfma_f32_32x32x16_bf16(PAF(0),VFR(0),o[0],0,0,0), C0,0); \
    GAPB(o[1]=__builtin_amdgcn_mfma_f32_32x32x16_bf16(PAF(0),VFR(4),o[1],0,0,0), C0,4); \
    KRD(GL,0); GAPB(o[0]=__builtin_amdgcn_mfma_f32_32x32x16_bf16(PAF(1),VFR(1),o[0],0,0,0), C0,8); \
    KRD(GL,1); GAPB(o[1]=__builtin_amdgcn_mfma_f32_32x32x16_bf16(PAF(1),VFR(5),o[1],0,0,0), C0,12); \
    KRD(GL,2); GAPB(o[0]=__builtin_amdgcn_mfma_f32_32x32x16_bf16(PAF(2),VFR(2),o[0],0,0,0), C1,0); \
    KRD(GL,3); GAPB(o[1]=__builtin_amdgcn_mfma_f32_32x32x16_bf16(PAF(2),VFR(6),o[1],0,0,0), C1,4); \
    GAPB(o[0]=__builtin_amdgcn_mfma_f32_32x32x16_bf16(PAF(3),VFR(3),o[0],0,0,0), C1,8); \
    GAPB(o[1]=__builtin_amdgcn_mfma_f32_32x32x16_bf16(PAF(3),VFR(7),o[1],0,0,0), C1,12); \
    } else {   \
    GAPC(o[0]=__builtin_amdgcn_mfma_f32_32x32x16_bf16(PAF(0),VFR(0),o[0],0,0,0), VRD2(0), C0,0); \
    GAPC(o[1]=__builtin_amdgcn_mfma_f32_32x32x16_bf16(PAF(0),VFR(4),o[1],0,0,0), VRD2(4), C0,2); \
    KRD(GL,0); GAPC(o[0]=__builtin_amdgcn_mfma_f32_32x32x16_bf16(PAF(1),VFR(1),o[0],0,0,0), VRD2(1), C0,4); \
    KRD(GL,1); GAPC(o[1]=__builtin_amdgcn_mfma_f32_32x32x16_bf16(PAF(1),VFR(5),o[1],0,0,0), VRD2(5), C0,6); \
    KRD(GL,2); GAPC(o[0]=__builtin_amdgcn_mfma_f32_32x32x16_bf16(PAF(2),VFR(2),o[0],0,0,0), VRD2(2), C0,8); \
    KRD(GL,3); GAPC(o[1]=__builtin_amdgcn_mfma_f32_32x32x16_bf16(PAF(2),VFR(6),o[1],0,0,0), VRD2(6), C0,10); \
    if constexpr(NQ==6){KRD(GL,4);} GAPC(o[0]=__builtin_amdgcn_mfma_f32_32x32x16_bf16(PAF(3),VFR(3),o[0],0,0,0), VRD2(3), C0,12); \
    if constexpr(NQ==6){KRD(GL,5);} GAPC(o[1]=__builtin_amdgcn_mfma_f32_32x32x16_bf16(PAF(3),VFR(7),o[1],0,0,0), VRD2(7), C0,14); \
    GAPC(o[2]=__builtin_amdgcn_mfma_f32_32x32x16_bf16(PAF(0),VFR(0),o[2],0,0,0), (void)0, C1,0); \
    GAPC(o[3]=__builtin_amdgcn_mfma_f32_32x32x16_bf16(PAF(0),VFR(4),o[3],0,0,0), (void)0, C1,2); \
    GAPC(o[2]=__builtin_amdgcn_mfma_f32_32x32x16_bf16(PAF(1),VFR(1),o[2],0,0,0), (void)0, C1,4); \
    GAPC(o[3]=__builtin_amdgcn_mfma_f32_32x32x16_bf16(PAF(1),VFR(5),o[3],0,0,0), (void)0, C1,6); \
    GAPC(o[2]=__builtin_amdgcn_mfma_f32_32x32x16_bf16(PAF(2),VFR(2),o[2],0,0,0), (void)0, C1,8); \
    GAPC(o[3]=__builtin_amdgcn_mfma_f32_32x32x16_bf16(PAF(2),VFR(6),o[3],0,0,0), (void)0, C1,10); \
    GAPC(o[2]=__builtin_amdgcn_mfma_f32_32x32x16_bf16(PAF(3),VFR(3),o[2],0,0,0), (void)0, C1,12); \
    GAPC(o[3]=__builtin_amdgcn_mfma_f32_32x32x16_bf16(PAF(3),VFR(7),o[3],0,0,0), (void)0, C1,14); \
    } \
    }while(0)
  #define WAITS() WAIT_N(NVH+NKD)
  int t=1;
  #undef CMASK
  #define CMASK(P0,P1,t) do{}while(0)
  for(;t+5<NT;t+=2){
    STEP(pB0,pB1,pA0,pA1,t,true,true,true);     WAITS(); RESC(); ROT();
    STEP(pA0,pA1,pB0,pB1,t+1,true,true,true);   WAITS(); RESC(); ROT();
  }
  #undef CMASK
  #define CMASK(P0,P1,t) do{}while(0)
  #define ENDW(tt) do{ if((tt)+3<NT){WAITS();} else if((tt)+2<NT){ WAIT_N(NVH); } else {WAIT_BAR(0);} }while(0)
  for(;t+1<NT;t+=2){
    STEP(pB0,pB1,pA0,pA1,t,(t+3<NT),(t+1<NT),(t+1<NT));       ENDW(t);   RESC(); ROT();
    STEP(pA0,pA1,pB0,pB1,t+1,(t+4<NT),(t+2<NT),(t+2<NT));     ENDW(t+1); RESC(); ROT();
  }
  STEP(pB0,pB1,pA0,pA1,NT-1,false,false,false); RESC();
  { float sacc=pB0[0]+pB0[1]; _Pragma("unroll") for(int r=2;r<16;++r)sacc+=pB0[r]; _Pragma("unroll") for(int r=0;r<16;++r)sacc+=pB1[r]; l_reg+=sacc;
    pw0=(u32x4){PKW(pB0,0),PKW(pB0,2),PKW(pB0,4),PKW(pB0,6)};pw1=(u32x4){PKW(pB0,8),PKW(pB0,10),PKW(pB0,12),PKW(pB0,14)};pw2=(u32x4){PKW(pB1,0),PKW(pB1,2),PKW(pB1,4),PKW(pB1,6)};pw3=(u32x4){PKW(pB1,8),PKW(pB1,10),PKW(pB1,12),PKW(pB1,14)};
    SBAR(); pv<NO>(o,vb0+sl_cur*NVH,PAF(0),PAF(1),PAF(2),PAF(3)); }
  #undef PKW
  #undef PAF
  #undef VFR
  #undef PIN
  #undef MX3
  #undef GAPA
  #undef GAPB
  #undef EX
  #undef VRD
  #undef VRD2
  #undef GAPC
  #undef KRD
  #undef STEP
  #undef ENDW
  #undef WAITS
  {auto rr=__builtin_amdgcn_permlane32_swap(__float_as_uint(l_reg),__float_as_uint(l_reg),false,false);l_reg=__uint_as_float(rr[0])+__uint_as_float(rr[1]);}
  if(hi==0)wsf[32+r32]=l_reg;asm volatile("s_waitcnt lgkmcnt(0)":::"memory");
  float rli[16];
  #pragma unroll
  for(int r=0;r<16;++r)rli[r]=__builtin_amdgcn_rcpf(wsf[32+crow(r,hi)]);
  bf16*Ow=Ou+(long)(wid*QBLK)*OP;
  { constexpr int OW=64*NVH;
    bf16*stg=(bf16*)(shm+LDS_OST)+wid*(32*OW);
    #pragma unroll
    for(int r=0;r<16;++r){const int orow=crow(r,hi);
      #pragma unroll
      for(int d0=0;d0<NO;++d0)stg[orow*OW+d0*32+r32]=__float2bfloat16(o[d0][r]*rli[r]);}
    asm volatile("s_waitcnt lgkmcnt(0)":::"memory");
    constexpr int CPR=OW/8;
    #pragma unroll
    for(int i=0;i<32*CPR/64;++i){const int pid=i*64+lane,row=pid/CPR,ch=pid%CPR; u32x4 v=*(const u32x4*)(stg+row*OW+ch*8);
      if constexpr(EPI==1){ static_assert(EPI==0||NVH==2,"combine epilogue: 128-wide heads");
        const u32x4 w1=*(const u32x4*)(O1+(long)(wid*QBLK+row)*OP1+ch*8); float f1[8],f2[8]; unpack8(w1,f1); unpack8(v,f2); float ss=0.f;
        _Pragma("unroll") for(int k=0;k<8;++k){ f1[k]=f1[k]-lam*f2[k]; ss+=f1[k]*f1[k]; }
        ss+=dpp_x1(ss); ss+=dpp_x2(ss); ss+=dpp_x7(ss); ss+=dpp_x15(ss);
        const float rs=rsqrtf(ss*(1.f/128.f)+EPS)*osc;
        _Pragma("unroll") for(int k=0;k<8;++k) f1[k]=f1[k]*rs*gsub[ch*8+k];
        v=pack8(f1); }
      ATTN_STORE16(Ow+(long)row*OP+ch*8,v);} }
  asm volatile("s_waitcnt lgkmcnt(0)\n\ts_barrier":::"memory");
  #undef NEGM
  #undef KSL
  #undef DMA_K
  #undef DMA_V
  #undef CMASK
  #undef START
  #undef RESC
  #undef ROT
}
#undef SBAR
#undef WAIT_BAR
}

namespace att8 {
typedef int v8i __attribute__((ext_vector_type(8)));
typedef int v4i __attribute__((ext_vector_type(4)));
constexpr int NS = 8, PD = 5;
#define A8_SB() __builtin_amdgcn_sched_barrier(0)
__device__ __forceinline__ int crow(int r, int hi) { return (r & 3) + 8 * (r >> 2) + 4 * hi; }
__device__ __forceinline__ int pk4_f8(float a, float b, float c, float d) { int w = __builtin_amdgcn_cvt_pk_fp8_f32(a, b, 0, false); return __builtin_amdgcn_cvt_pk_fp8_f32(c, d, w, true); }
__device__ __forceinline__ int pk4_b8(float a, float b, float c, float d) { int w = __builtin_amdgcn_cvt_pk_bf8_f32(a, b, 0, false); return __builtin_amdgcn_cvt_pk_bf8_f32(c, d, w, true); }
template <int DQ> __device__ __forceinline__ int kswz(int key) { return DQ == 64 ? ((key >> 2) & 3) : ((key >> 1) & 7); }
template <int DQ> __device__ __forceinline__ int k_off(int k, int c) { return k * DQ + ((c ^ kswz<DQ>(k)) << 4); }
__device__ __forceinline__ int v_off(int n, int c) { return n * 64 + ((c ^ ((n >> 2) & 3)) << 4); }
__device__ __forceinline__ int v_key(int c, int r) { return 32 * (c & 1) + 4 * (c >> 1) + (r & 3) + 8 * (r >> 2); }
#if A8_QK6
__device__ __forceinline__ f32x16 mm_f8f8(v8i a, v8i b, f32x16 c) { return __builtin_amdgcn_mfma_scale_f32_32x32x64_f8f6f4(a, b, c, 2, 2, 0, 0, 0, 0); }
#else
__device__ __forceinline__ f32x16 mm_f8f8(v8i a, v8i b, f32x16 c) { return __builtin_amdgcn_mfma_scale_f32_32x32x64_f8f6f4(a, b, c, 0, 0, 0, 0, 0, 0); }
#endif
__device__ __forceinline__ f32x16 mm_b8f8(v8i a, v8i b, f32x16 c) { return __builtin_amdgcn_mfma_scale_f32_32x32x64_f8f6f4(a, b, c, 1, 0, 0, 0, 0, 0); }
__device__ __forceinline__ v8i ld8(const LAS char* p0, const LAS char* p1) { const v4i a = *(const LAS v4i*)p0, b = *(const LAS v4i*)p1; return (v8i){a.x, a.y, a.z, a.w, b.x, b.y, b.z, b.w}; }

template <int DQ, int DV, int EPI>
__device__ __forceinline__ void attn_unit(const unsigned char* __restrict__ Qu, const unsigned char* __restrict__ Kt, const unsigned char* __restrict__ Vt, bf16_t* Ou, const int OP, const int NT, LAS char* lds, int wv,
    const bf16_t* O1 = nullptr, const int OP1 = 0, const float lam = 0.f, const float* gsub = nullptr, const float osc = 1.f, float* chk = nullptr) {
  constexpr int KB = 64 * DQ, VB = DV * 64, SLOT = KB + VB, NKP = KB / 1024, NVP = VB / 1024, NQS = DQ / 64, NOB = DV / 32, NM = NOB + 1;
  const int tid = mk_tid(wv); const int lane = tid & 63, r32 = lane & 31, hi = lane >> 5; const int wid = __builtin_amdgcn_readfirstlane(tid >> 6);
  constexpr int NDMA = (DQ == 64 && DV == 64) ? 1 : 2;
  const unsigned lds0 = (unsigned)(size_t)lds;
  const int kp = (DQ == 64) ? (wid & 3) : wid, vp = (DV == 64) ? (wid & 3) : wid;
  const unsigned char* ksrc = Kt + kp * 1024 + lane * 16;
  const unsigned char* vsrc = Vt + vp * 1024 + lane * 16;
  const unsigned kdst = lds0 + kp * 1024, vdst = lds0 + KB + vp * 1024;
  const unsigned char* src1 = (NDMA == 1 && wid >= 4) ? vsrc : ksrc; const unsigned dst1 = (NDMA == 1 && wid >= 4) ? vdst : kdst;
  static_assert(NDMA == 2 || KB == VB, "single-piece form: equal tile strides");
#define A8_DMA(tt, sb) do { const int t_ = (tt) < NT ? (tt) : NT - 1; \
    att64::glds16(src1 + (size_t)t_ * KB, (unsigned)__builtin_amdgcn_readfirstlane(dst1 + (sb))); \
    if constexpr (NDMA == 2) att64::glds16(vsrc + (size_t)t_ * VB, (unsigned)__builtin_amdgcn_readfirstlane(vdst + (sb))); } while (0)
#define A8_WAIT() do { if constexpr (NDMA == 2) asm volatile("s_waitcnt vmcnt(4)" ::: "memory"); else asm volatile("s_waitcnt vmcnt(2)" ::: "memory"); __builtin_amdgcn_s_barrier(); asm volatile("" ::: "memory"); } while (0)
  v8i qf[NQS];
  { const unsigned char* qrow = Qu + (size_t)(wid * 32 + r32) * DQ + 32 * hi;
#pragma unroll
    for (int s = 0; s < NQS; ++s) { const v4i a = *(const v4i*)(qrow + 64 * s), b = *(const v4i*)(qrow + 64 * s + 16); qf[s] = (v8i){a.x, a.y, a.z, a.w, b.x, b.y, b.z, b.w}; } }
#pragma unroll
  for (int u = 0; u < PD; ++u) A8_DMA(u, u * SLOT);
  int kof[NQS][2], vof[2];
#pragma unroll
  for (int s = 0; s < NQS; ++s)
#pragma unroll
    for (int i = 0; i < 2; ++i) kof[s][i] = k_off<DQ>(r32, 4 * s + 2 * hi + i);
#pragma unroll
  for (int i = 0; i < 2; ++i) vof[i] = KB + v_off(r32, 2 * hi + i);
  f32x16 o[NOB], L = f32x16{}, SA0, SA1, SB0, SB1;
#pragma unroll
  for (int d = 0; d < NOB; ++d) o[d] = f32x16{};
  v8i kf[2][NQS], vf[NOB];
  const int one4 = pk4_f8(1.f, 1.f, 1.f, 1.f);
  const v8i ONES = (v8i){one4, one4, one4, one4, one4, one4, one4, one4};
  f32x16 NEG4 = {-4.f, -4.f, -4.f, -4.f, -4.f, -4.f, -4.f, -4.f, -4.f, -4.f, -4.f, -4.f, -4.f, -4.f, -4.f, -4.f};
  if constexpr (NQS == 1) asm volatile("" : "+v"(NEG4));
  v8i pk = (v8i){0, 0, 0, 0, 0, 0, 0, 0};
  int sb_prev = 0, sb_cur = 0, sb_next = SLOT, sb_dma = PD * SLOT;
#define A8_ROT() do { sb_prev = sb_cur; sb_cur = sb_next; sb_next = (sb_next == (NS - 1) * SLOT) ? 0 : sb_next + SLOT; sb_dma = (sb_dma == (NS - 1) * SLOT) ? 0 : sb_dma + SLOT; } while (0)
#define A8_LDK(sb) do { _Pragma("unroll") for (int m_ = 0; m_ < 2; ++m_) _Pragma("unroll") for (int s_ = 0; s_ < NQS; ++s_) { const LAS char* p_ = lds + (sb) + m_ * 32 * DQ; kf[m_][s_] = ld8(p_ + kof[s_][0], p_ + kof[s_][1]); } } while (0)
#define A8_LDV(sb) do { _Pragma("unroll") for (int d_ = 0; d_ < NOB; ++d_) { const LAS char* p_ = lds + (sb) + d_ * 2048; vf[d_] = ld8(p_ + vof[0], p_ + vof[1]); } } while (0)
#define A8_QK1(N, m) do { if constexpr (NQS == 1) N = mm_f8f8(kf[m][0], qf[0], NEG4); else { N = mm_f8f8(kf[m][0], qf[0], f32x16{}); N = mm_f8f8(kf[m][1], qf[1], N); } } while (0)
#define A8_EX(C0, C1, e) do { if ((e) < 16) C0[(e) & 15] = __builtin_amdgcn_exp2f(C0[(e) & 15]); else C1[(e) & 15] = __builtin_amdgcn_exp2f(C1[(e) & 15]); } while (0)
#define A8_PK1(W, P, B) do { W = __builtin_amdgcn_cvt_pk_bf8_f32(P[B], P[B + 1], W, false); W = __builtin_amdgcn_cvt_pk_bf8_f32(P[B + 2], P[B + 3], W, true); } while (0)
#define A8_PACKH(C, h) do { _Pragma("unroll") for (int j_ = 0; j_ < 4; ++j_) A8_PK1(pk[4 * (h) + j_], C, 4 * j_); } while (0)
  A8_WAIT();
  A8_DMA(PD, sb_dma);
  A8_LDK(sb_cur);
  A8_QK1(SA0, 0); A8_QK1(SA1, 1);
#pragma unroll
  for (int e = 0; e < 32; ++e) A8_EX(SA0, SA1, e);
  A8_PACKH(SA0, 0); A8_PACKH(SA1, 1);
  A8_LDK(sb_next);
  A8_QK1(SB0, 0); A8_QK1(SB1, 1);
  A8_LDV(sb_cur);
  A8_ROT();
#define A8_PRIO(p) do { A8_SB(); __builtin_amdgcn_s_setprio(p); A8_SB(); } while (0)
#define A8_STEP(C0, C1, N0, N1, tt, SYNC) do { \
    A8_SB(); if constexpr (SYNC) { A8_WAIT(); } A8_SB(); \
    _Pragma("unroll") for (int i = 0; i < NM; ++i) { \
      A8_PRIO(1); if (i < NOB) o[i < NOB ? i : 0] = mm_b8f8(pk, vf[i < NOB ? i : 0], o[i < NOB ? i : 0]); else L = mm_b8f8(pk, ONES, L); A8_PRIO(0); \
      if (i == 0) A8_LDK(sb_next); \
      _Pragma("unroll") for (int e = (32 * i) / NM; e < (32 * (i + 1)) / NM; ++e) A8_EX(C0, C1, e); \
      A8_SB(); } \
    A8_LDV(sb_cur); A8_SB(); \
    A8_PRIO(1); A8_QK1(N0, 0); A8_PRIO(0); A8_PACKH(C0, 0); A8_SB(); \
    A8_PRIO(1); A8_QK1(N1, 1); A8_PRIO(0); A8_PACKH(C1, 1); A8_SB(); \
    A8_DMA((tt) + PD, sb_dma); \
    A8_ROT(); A8_SB(); } while (0)
  { int t = 1;
    for (; t + 1 < NT; t += 2) { A8_STEP(SB0, SB1, SA0, SA1, t, true); A8_STEP(SA0, SA1, SB0, SB1, t + 1, false); }
    A8_STEP(SB0, SB1, SA0, SA1, NT - 1, true); }
#pragma unroll
  for (int i = 0; i < NOB; ++i) o[i] = mm_b8f8(pk, vf[i], o[i]);
  L = mm_b8f8(pk, ONES, L);
  asm volatile("s_waitcnt vmcnt(0) lgkmcnt(0)" ::: "memory");
  __builtin_amdgcn_s_barrier(); asm volatile("" ::: "memory");
#undef A8_DMA
#undef A8_WAIT
#undef A8_ROT
#undef A8_LDK
#undef A8_LDV
#undef A8_QK1
#undef A8_EX
#undef A8_PACKH
#undef A8_PK1
#undef A8_STEP
#undef A8_PRIO
  float rl[16];
#pragma unroll
  for (int r = 0; r < 16; ++r) rl[r] = __builtin_amdgcn_rcpf(L[r]);
  bf16_t* Ow = Ou + (size_t)(wid * 32) * OP;
  LAS bf16_t* stg = (LAS bf16_t*)lds + wid * (32 * DV);
#pragma unroll
  for (int r = 0; r < 16; ++r) { const int orow = crow(r, hi);
#pragma unroll
    for (int d0 = 0; d0 < NOB; ++d0) stg[orow * DV + d0 * 32 + r32] = (bf16_t)f2bf(o[d0][r] * rl[r]); }
  asm volatile("s_waitcnt lgkmcnt(0)" ::: "memory");
  constexpr int CPR = DV / 8;
  float cs_d = 0.f, cs_o = 0.f;
#pragma unroll
  for (int i = 0; i < 32 * CPR / 64; ++i) { const int pid = i * 64 + lane, row = pid / CPR, ch = pid % CPR; u32x4 v = *(const LAS u32x4*)(stg + row * DV + ch * 8);
    if constexpr (EPI == 1) { static_assert(EPI != 1 || DV == 128, "combine epilogue: 128-wide heads");
      const u32x4 w1 = *(const u32x4*)(O1 + (size_t)(wid * 32 + row) * OP1 + ch * 8); float f1[8], f2[8]; unpack8(w1, f1); unpack8(v, f2); float ss = 0.f;
#pragma unroll
      for (int k = 0; k < 8; ++k) { f1[k] = f1[k] - lam * f2[k]; ss += f1[k] * f1[k]; }
      ss += dpp_x1(ss); ss += dpp_x2(ss); ss += dpp_x7(ss); ss += dpp_x15(ss);
      const float rs = rsqrtf(ss * (1.f / 128.f) + EPS) * osc;
#pragma unroll
      for (int k = 0; k < 8; ++k) f1[k] = f1[k] * rs * gsub[ch * 8 + k];
      v = pack8(f1); }
    if constexpr (EPI == 2) { const u32x4 w1 = *(const u32x4*)(Ow + (size_t)row * OP + ch * 8); float f1[8], f2[8]; unpack8(w1, f1); unpack8(v, f2);
#pragma unroll
      for (int k = 0; k < 8; ++k) { const float dd = f2[k] - f1[k]; cs_d += dd * dd; cs_o += f1[k] * f1[k]; } }
    else *(u32x4*)(Ow + (size_t)row * OP + ch * 8) = v; }
  if constexpr (EPI == 2) { cs_d = wave_sum(cs_d); cs_o = wave_sum(cs_o); if (lane == 0) { atomicAdd(chk, cs_d); atomicAdd(chk + 1, cs_o); } }
  asm volatile("s_waitcnt lgkmcnt(0)" ::: "memory");
  __builtin_amdgcn_s_barrier(); asm volatile("" ::: "memory");
}
#undef A8_SB
}

struct Args {
    const float* in[33];
    float* out; unsigned char* ws;
    int ph_lo, ph_hi;
};
enum { I_X = 0, I_C, I_CTX, I_CCTX, I_WADA, I_BADA, I_GMIX, I_GFFN, I_EWIN, I_EWOUT, I_EGQ, I_EGK, I_ECONVW, I_ECONVB, I_EBG, I_EGH,
       I_OWIN, I_OWOUT, I_OGQC, I_OGKC, I_OLAM, I_OGSUB, I_OGCQ, I_OWUQ, I_OGCKV, I_OWUKV, I_OGQD, I_OGKD, I_WR, I_BR, I_W1, I_W3, I_W2 };
enum { PH_PRO = 0, PH_ENORM, PH_EINPROJ, PH_EPOST, PH_EATTN, PH_MLA, PH_MLB, PH_MLC, PH_EOUT, PH_M0NORM, PH_M0GATHER, PH_M0G1, PH_M0G2, PH_M0COMB,
       PH_OINPROJ, PH_OPOST, PH_OGEMM, PH_OPOST2, PH_OATTN, PH_OSUB, PH_OOUT, PH_M1NORM, PH_M1GATHER, PH_M1G1, PH_M1G2, PH_M1COMB, NPH };

struct Ctx {
    LAS unsigned char* lds; int tid, lane, wave, vcu, G, gw, NGW;
};

__device__ __forceinline__ Args load_args() {
    extern __shared__ __attribute__((aligned(16))) unsigned char lds_dyn3_[];
    const LAS unsigned* p = (const LAS unsigned*)((LAS unsigned char*)lds_dyn3_ + ARGS_OFF);
    Args a;
#pragma unroll
    for (int i = 0; i < 33; ++i) { const unsigned lo = __builtin_amdgcn_readfirstlane(p[2 * i]), hi = __builtin_amdgcn_readfirstlane(p[2 * i + 1]); a.in[i] = (const float*)(const GAS float*)(((unsigned long long)hi << 32) | lo); }
    { const unsigned lo = __builtin_amdgcn_readfirstlane(p[66]), hi = __builtin_amdgcn_readfirstlane(p[67]); a.out = (float*)(GAS float*)(((unsigned long long)hi << 32) | lo); }
    { const unsigned lo = __builtin_amdgcn_readfirstlane(p[68]), hi = __builtin_amdgcn_readfirstlane(p[69]); a.ws = (unsigned char*)(GAS unsigned char*)(((unsigned long long)hi << 32) | lo); }
    a.ph_lo = __builtin_amdgcn_readfirstlane(p[70]); a.ph_hi = __builtin_amdgcn_readfirstlane(p[71]);
    return a;
}
__device__ __forceinline__ Ctx fresh(const Ctx& c0) {
    Ctx c; int bx = blockIdx.x, G = gridDim.x; const int tid = mk_tid(c0.wave);
    asm volatile("" : "+s"(bx), "+s"(G));
    extern __shared__ __attribute__((aligned(16))) unsigned char lds_dyn_[];
    c.lds = (LAS unsigned char*)lds_dyn_;
    const int vcu = (G % 8 == 0) ? (bx % 8) * (G / 8) + bx / 8 : bx;
    c.tid = tid; c.lane = tid & 63; c.wave = __builtin_amdgcn_readfirstlane(tid >> 6); c.vcu = vcu; c.G = G; c.gw = vcu * 8 + c.wave; c.NGW = G * 8;
    (void)c0;
    return c;
}
__device__ __forceinline__ void grid_sync(const Ctx& c) {
    extern __shared__ __attribute__((aligned(16))) unsigned char lds_dyn4_[];
    XcdBarrier b_; b_.bar = (unsigned*)(load_args().ws + WS_CTL) + CW_BAR; b_.x = xb_xcc_id(); b_.st = (volatile LAS unsigned*)((LAS unsigned char*)lds_dyn4_ + MISC_OFF) + 8; xcd_barrier(b_, mk_tid(c.wave));
}
__device__ __forceinline__ int row_bsel(int row) { return row < TC ? 2 : (row - TC) / SEQ; }
__device__ __forceinline__ bool fast8_e(const Args& a, int lane) { float gq = fabsf(a.in[I_EGQ][lane]), gk = fabsf(a.in[I_EGK][lane]); gq = wave_max(gq); gk = wave_max(gk); return A8_ENABLE && (0.125f * LOG2E * 64.f * gq * gk) < 17.f; }
__device__ __forceinline__ bool fast8_c(const Args& a, int lane) { float gq = fabsf(a.in[I_OGQC][lane]), gk = fabsf(a.in[I_OGKC][lane]); gq = wave_max(gq); gk = wave_max(gk); return A8_ENABLE && (0.125f * LOG2E * 64.f * gq * gk) < 17.f; }
__device__ __forceinline__ bool fast8_d(const Args& a, int lane) {
    float gq2 = fmaxf(fabsf(a.in[I_OGQD][lane]), lane < 32 ? fabsf(a.in[I_OGQD][64 + lane]) : 0.f), gk2 = fmaxf(fabsf(a.in[I_OGKD][lane]), lane < 32 ? fabsf(a.in[I_OGKD][64 + lane]) : 0.f);
    gq2 = wave_max(gq2); gk2 = wave_max(gk2); return A8_ENABLE && (0.10206207261596575f * LOG2E * 96.f * gq2 * gk2) < 20.5f; }
__device__ __forceinline__ void pk8_f6(const float* f, unsigned& lo, unsigned& hi) {
    unsigned cd[8];
#pragma unroll
    for (int i = 0; i < 4; ++i) { const unsigned w = (unsigned)__builtin_amdgcn_cvt_pk_fp8_f32(f[2 * i], f[2 * i + 1], 0, false); const unsigned b0 = w & 0xffu, b1 = (w >> 8) & 0xffu;
        cd[2 * i] = min(b0 & 0x7fu, 31u) | ((b0 & 0x80u) >> 2); cd[2 * i + 1] = min(b1 & 0x7fu, 31u) | ((b1 & 0x80u) >> 2); }
    lo = cd[0] | (cd[1] << 6) | (cd[2] << 12) | (cd[3] << 18) | (cd[4] << 24) | (cd[5] << 30);
    hi = (cd[5] >> 2) | (cd[6] << 4) | (cd[7] << 10);
}
__device__ __forceinline__ void st6(unsigned char* p0, unsigned char* p1, int j4, unsigned lo, unsigned hi) {
    const int o = 6 * j4;
#pragma unroll
    for (int t = 0; t < 3; ++t) { const int x = o + 2 * t; const unsigned short v = (unsigned short)(t == 0 ? lo : (t == 1 ? (lo >> 16) : hi)); *(unsigned short*)((x < 16 ? p0 : p1 - 16) + x) = v; }
}
__device__ __forceinline__ u32x2 pk8_f8(const float* f) { u32x2 w; w.x = (unsigned)att8::pk4_f8(f[0], f[1], f[2], f[3]); w.y = (unsigned)att8::pk4_f8(f[4], f[5], f[6], f[7]); return w; }
template <int DV> __device__ __forceinline__ void vquant_items(const bf16_t* src, int pitch, int col0, int hstride, int nheads, unsigned char* V8, int gw, int NGW, int lane) {
    constexpr int G = DV / 16;
    const int nitems = BATCH * nheads * NTILE * G;
    for (int it = gw; it < nitems; it += NGW) {
        const int g = it % G; int r = it / G; const int tile = r % NTILE; r /= NTILE; const int head = r % nheads, b = r / nheads;
        const int cc = DV == 64 ? g : (g >> 1), n = DV == 64 ? lane : ((g & 1) * 64 + lane);
        const int row0 = tile < 4 ? b * CTX + tile * 64 : TC + b * SEQ + (tile - 4) * 64;
        const bf16_t* p = src + (size_t)row0 * pitch + col0 + head * hstride + n;
        float f[16];
#pragma unroll
        for (int q = 0; q < 16; ++q) f[q] = bf2f(p[(size_t)att8::v_key(cc, q) * pitch]);
        att8::v4i w; w.x = att8::pk4_f8(f[0], f[1], f[2], f[3]); w.y = att8::pk4_f8(f[4], f[5], f[6], f[7]); w.z = att8::pk4_f8(f[8], f[9], f[10], f[11]); w.w = att8::pk4_f8(f[12], f[13], f[14], f[15]);
        *(att8::v4i*)(V8 + ((size_t)((b * nheads + head) * NTILE + tile)) * (DV * 64) + att8::v_off(n, cc)) = w;
    }
}

__device__ __forceinline__ void transpose_item(const float* W, int ldw, int K, bf16_t* WT, int row_off, int mode, int which, LAS float* scr, int kb, int nb, int lane) {
    const int k0 = 64 * kb, n0 = 32 * nb;
    { float t_[32];
#pragma unroll
      for (int i = 0; i < 32; ++i) t_[i] = W[(size_t)(k0 + 2 * i + (lane >> 5)) * ldw + n0 + (lane & 31)];
#pragma unroll
      for (int i = 0; i < 32; ++i) scr[(2 * i + (lane >> 5)) * 33 + (lane & 31)] = t_[i]; }
    LDS_WAIT(); asm volatile("" ::: "memory");
    const int c = lane & 7;
#pragma unroll
    for (int j = 0; j < 4; ++j) { const int n = (lane >> 3) + 8 * j; const LAS float* s = scr + (8 * c) * 33 + n;
        u32x4 o; o.x = pk2(s[0 * 33], s[1 * 33]); o.y = pk2(s[2 * 33], s[3 * 33]); o.z = pk2(s[4 * 33], s[5 * 33]); o.w = pk2(s[6 * 33], s[7 * 33]);
        const int ng = n0 + n;
        const int orow = mode == 0 ? row_off + ng : (64 * (ng >> 5) + ((ng & 31) >> 4) * 32 + which * 16 + (ng & 15));
        *(u32x4*)(WT + (size_t)orow * K + k0 + 8 * c) = o; }
    LDS_WAIT(); asm volatile("" ::: "memory");
}

__device__ __forceinline__ void phase_pro(const Args& a, const Ctx& c0) {
    const Ctx c = fresh(c0);
    unsigned char* ws = a.ws;
    for (int it = blockIdx.x; it < 192; it += c.G) {
        const int l = it / 96, rem = it % 96, chunk = rem / 8, s = rem % 8;
        LAS float* sc = (LAS float*)c.lds;
        if (c.tid < 384) { const int bs = c.tid / 128, k = s * 128 + (c.tid % 128);
            const float v = bs < 2 ? a.in[I_C][bs * D + k] : a.in[I_CCTX][k]; sc[c.tid] = siluf(v); }
        __syncthreads();
        const int col = chunk * 512 + c.tid;
        const float* w = a.in[I_WADA] + (size_t)l * D * 6144 + (size_t)(s * 128) * 6144 + col;
        float a0 = 0.f, a1 = 0.f, a2 = 0.f;
#pragma unroll 16
        for (int k = 0; k < 128; ++k) { const float wv = w[(size_t)k * 6144]; a0 += sc[k] * wv; a1 += sc[128 + k] * wv; a2 += sc[256 + k] * wv; }
        float* mp = (float*)(ws + WS_MODP) + (size_t)s * 3 * 12288 + l * 6144 + col;
        mp[0] = a0; mp[12288] = a1; mp[2 * 12288] = a2;
        __syncthreads();
    }
    LAS float* scr = (LAS float*)(c.lds + 4096 + c.wave * 16384);
    bf16_t* wsm = (bf16_t*)(ws + WS_WSM);
    constexpr int I_E = 16 * 88, I_O = 16 * 61, I_W = 16 * 32, I_UQ = 4 * 12, I_UKV = 2 * 24;
    constexpr int NIT = I_E + I_O + 2 * I_W + I_UQ + I_UKV;
    for (int it = c.gw; it < NIT; it += c.NGW) {
        int r = it;
        if (r < I_E) { transpose_item(a.in[I_EWIN], IN_EVEN, D, wsm + WO_WINE / 2, 0, 0, 0, scr, r / 88, r % 88, c.lane); continue; } r -= I_E;
        if (r < I_O) { transpose_item(a.in[I_OWIN], IN_ODD, D, wsm + WO_WINO / 2, 0, 0, 0, scr, r / 61, r % 61, c.lane); continue; } r -= I_O;
        if (r < I_W) { transpose_item(a.in[I_EWOUT], D, D, wsm + WO_WOUTE / 2, 0, 0, 0, scr, r / 32, r % 32, c.lane); continue; } r -= I_W;
        if (r < I_W) { transpose_item(a.in[I_OWOUT], D, D, wsm + WO_WOUTO / 2, 0, 0, 0, scr, r / 32, r % 32, c.lane); continue; } r -= I_W;
        if (r < I_UQ) { transpose_item(a.in[I_OWUQ], 384, 256, wsm + WO_WUQ / 2, 0, 0, 0, scr, r / 12, r % 12, c.lane); continue; } r -= I_UQ;
        transpose_item(a.in[I_OWUKV], 768, 128, wsm + WO_WUKV / 2, 0, 0, 0, scr, r / 24, r % 24, c.lane);
    }
    {
        const int gt = c.vcu * 512 + c.tid, NT = c.G * 512;
        u32x4* z0 = (u32x4*)(ws + WS_WSM + WO_WINO + (size_t)1952 * D * 2);
        for (int i = gt; i < 96 * 2048 / 16; i += NT) z0[i] = (u32x4){0u, 0u, 0u, 0u};
        u32x4* z1 = (u32x4*)(ws + WS_WSM + WO_WUQ + (size_t)384 * 256 * 2);
        for (int i = gt; i < 128 * 512 / 16; i += NT) z1[i] = (u32x4){0u, 0u, 0u, 0u};
        float* t64 = (float*)(ws + WS_ROPE64); float* td = (float*)(ws + WS_ROPED);
        for (int i = gt; i < 256 * 16 + 256 * 8; i += NT) {
            if (i < 4096) { const int pos = i >> 4, fi = i & 15; float sn, cs; sincosf((float)pos * powf(10000.f, -(float)fi / 16.f), &sn, &cs); t64[2 * i] = cs; t64[2 * i + 1] = sn; }
            else { const int k = i - 4096, pos = k >> 3, fi = k & 7; float sn, cs; sincosf((float)pos * powf(10000.f, -(float)fi / 8.f), &sn, &cs); td[2 * k] = cs; td[2 * k + 1] = sn; } }
    }
}

__device__ __forceinline__ void norm_mod_row(const float* xrow, const float* gain, const float* sh, const float* sc, int lane, f32x4 (&v)[4]) {
    const f32x4* xr = (const f32x4*)xrow + lane;
    float s = 0.f;
#pragma unroll
    for (int j = 0; j < 4; ++j) { v[j] = xr[64 * j]; s += (v[j].x * v[j].x + v[j].y * v[j].y) + (v[j].z * v[j].z + v[j].w * v[j].w); }
    const float rstd = rsqrtf(wave_sum(s) * (1.f / D) + EPS);
#pragma unroll
    for (int j = 0; j < 4; ++j) { const f32x4 g = ((const f32x4*)gain)[lane + 64 * j], a = ((const f32x4*)sc)[lane + 64 * j], b = ((const f32x4*)sh)[lane + 64 * j];
        v[j] = (v[j] * rstd) * g * (a + 1.0f) + b; }
}
__device__ __forceinline__ void store_row_bf16(bf16_t* orow, int lane, const f32x4 (&v)[4]) {
    u32x2* o8 = (u32x2*)orow + lane;
#pragma unroll
    for (int j = 0; j < 4; ++j) { u32x2 w; w.x = pk2(v[j].x, v[j].y); w.y = pk2(v[j].z, v[j].w); o8[64 * j] = w; }
}

template <int NEXP> __device__ __forceinline__ void row_dots(const f32x4 (&v)[4], const LAS float* wT, int lane, float (&p)[NEXP]) {
    f32x4 wa[8], wb[8];
#define RD_LOAD(W, G) do { _Pragma("unroll") for (int ei_ = 0; ei_ < 2; ++ei_) _Pragma("unroll") for (int j_ = 0; j_ < 4; ++j_) W[ei_ * 4 + j_] = ((const LAS f32x4*)(wT + ((G) * 2 + ei_) * D))[lane + 64 * j_]; asm volatile("" ::: "memory"); } while (0)
#define RD_COMP(W, G) do { _Pragma("unroll") for (int ei_ = 0; ei_ < 2; ++ei_) { float acc_ = 0.f; _Pragma("unroll") for (int j_ = 0; j_ < 4; ++j_) { const f32x4 w_ = W[ei_ * 4 + j_]; \
        acc_ = fmaf(v[j_].x, w_.x, acc_); acc_ = fmaf(v[j_].y, w_.y, acc_); acc_ = fmaf(v[j_].z, w_.z, acc_); acc_ = fmaf(v[j_].w, w_.w, acc_); } p[(G) * 2 + ei_] = acc_; } } while (0)
    RD_LOAD(wa, 0);
#pragma unroll
    for (int g = 0; g < NEXP / 2; g += 2) {
        RD_LOAD(wb, g + 1);
        RD_COMP(wa, g);
        if (g + 2 < NEXP / 2) RD_LOAD(wa, g + 2);
        RD_COMP(wb, g + 1);
    }
#undef RD_LOAD
#undef RD_COMP
}
__device__ __forceinline__ void phase_enorm(const Args& a, const Ctx& c0) {
    const Ctx c = fresh(c0);
    unsigned char* ws = a.ws;
    const float* modp = (const float*)(ws + WS_MODP);
    float* mod = (float*)(ws + WS_MOD);
    LAS float* lmod = (LAS float*)c.lds;
    LAS float* wgT = (LAS float*)(c.lds + 24576);
    for (int i = c.tid; i < 6144; i += 512) { const int bs = i / 2048, ch = (i % 2048) / 1024, col = i % 1024, j = ch * 1024 + col;
        float v = a.in[I_BADA][j];
#pragma unroll
        for (int s = 0; s < 8; ++s) v += modp[(size_t)s * 3 * 12288 + bs * 12288 + j];
        lmod[i] = v; }
    for (int i = c.vcu * 512 + c.tid; i < 2 * 3 * 6144; i += c.G * 512) { const int l = i / 18432, bs = (i % 18432) / 6144, j = i % 6144;
        float v = a.in[I_BADA][l * 6144 + j];
#pragma unroll
        for (int s = 0; s < 8; ++s) v += modp[(size_t)s * 3 * 12288 + bs * 12288 + l * 6144 + j];
        mod[i] = v; }
    for (int k = c.tid; k < D; k += 512) { const f32x4* src = (const f32x4*)(a.in[I_EWIN] + (size_t)k * IN_EVEN + NZE);
#pragma unroll
        for (int q = 0; q < 4; ++q) { const f32x4 w = src[q]; wgT[(4 * q + 0) * D + k] = w.x; wgT[(4 * q + 1) * D + k] = w.y; wgT[(4 * q + 2) * D + k] = w.z; wgT[(4 * q + 3) * D + k] = w.w; } }
    __syncthreads();
    bf16_t* H = (bf16_t*)(ws + WS_HMF);
    float* Gt = (float*)(ws + WS_G);
    const float* gmix = a.in[I_GMIX];
    const int lane = c.lane;
    f32x4 gmx[4], xn[4];
#pragma unroll
    for (int j = 0; j < 4; ++j) gmx[j] = ((const f32x4*)gmix)[lane + 64 * j];
    { const int row0 = c.gw; if (row0 < NROW) { const float* xr0 = row0 < TC ? a.in[I_CTX] + (size_t)row0 * D : a.in[I_X] + (size_t)(row0 - TC) * D;
#pragma unroll
        for (int j = 0; j < 4; ++j) xn[j] = ((const f32x4*)xr0)[lane + 64 * j]; } }
    for (int row = c.gw; row < NROW; row += c.NGW) {
        const int bs = row_bsel(row);
        f32x4 v[4]; float s = 0.f;
#pragma unroll
        for (int j = 0; j < 4; ++j) { v[j] = xn[j]; s += (v[j].x * v[j].x + v[j].y * v[j].y) + (v[j].z * v[j].z + v[j].w * v[j].w); }
        { const int nrow = row + c.NGW; if (nrow < NROW) { const float* xr1 = nrow < TC ? a.in[I_CTX] + (size_t)nrow * D : a.in[I_X] + (size_t)(nrow - TC) * D;
#pragma unroll
            for (int j = 0; j < 4; ++j) xn[j] = ((const f32x4*)xr1)[lane + 64 * j]; } }
        const float rstd = rsqrtf(wave_sum(s) * (1.f / D) + EPS);
        const LAS f32x4* shp = (const LAS f32x4*)(lmod + bs * 2048), *scp = (const LAS f32x4*)(lmod + bs * 2048 + 1024);
#pragma unroll
        for (int j = 0; j < 4; ++j) v[j] = (v[j] * rstd) * gmx[j] * (scp[lane + 64 * j] + 1.0f) + shp[lane + 64 * j];
        store_row_bf16(H + (size_t)row * D, lane, v);
        float p[16];
        row_dots<16>(v, wgT, lane, p);
#pragma unroll
        for (int i = 0; i < 8; ++i) { const bool up = (lane & 32) != 0; const float send = up ? p[i] : p[i + 8]; const float recv = xshfl<32>(send); p[i] = (up ? p[i + 8] : p[i]) + recv; }
#pragma unroll
        for (int i = 0; i < 4; ++i) { const bool up = (lane & 16) != 0; const float send = up ? p[i] : p[i + 4]; const float recv = xshfl<16>(send); p[i] = (up ? p[i + 4] : p[i]) + recv; }
#pragma unroll
        for (int i = 0; i < 2; ++i) { const bool up = (lane & 8) != 0; const float send = up ? p[i] : p[i + 2]; const float recv = dpp_x15(send); p[i] = (up ? p[i + 2] : p[i]) + recv; }
        { const bool up = (lane & 4) != 0; const float send = up ? p[0] : p[1]; const float recv = dpp_x7(send); p[0] = (up ? p[1] : p[0]) + recv; }
        p[0] += dpp_x2(p[0]); p[0] += dpp_x1(p[0]);
        if ((lane & 3) == 0) { const int idx = ((lane >> 5) & 1) * 8 + ((lane >> 4) & 1) * 4 + ((lane >> 3) & 1) * 2 + ((lane >> 2) & 1);
            float gv = p[0] + a.in[I_EBG][idx];
            const int gt = idx >> 2;
            if (gt & 1) gv = logsigmoidf_(gv);
            Gt[(size_t)row * 16 + idx] = gv; }
    }
}

struct Rope4 { float c[4], s[4]; };
__device__ __forceinline__ Rope4 rope64_angles(int t, int lane, const float* tab) {
    const int pos = ((lane & 7) < 4) ? (t / GRIDW) : (t % GRIDW), fi = ((lane & 7) & 3) * 4;
    const f32x4* p = (const f32x4*)(tab + (pos * 16 + fi) * 2); const f32x4 a = p[0], b = p[1];
    Rope4 r; r.c[0] = a.x; r.s[0] = a.y; r.c[1] = a.z; r.s[1] = a.w; r.c[2] = b.x; r.s[2] = b.y; r.c[3] = b.z; r.s[3] = b.w;
    return r;
}
__device__ __forceinline__ void rope_apply8(float* f, const Rope4& r) {
#pragma unroll
    for (int i = 0; i < 4; ++i) { const float x0 = f[2 * i], x1 = f[2 * i + 1]; f[2 * i] = x0 * r.c[i] - x1 * r.s[i]; f[2 * i + 1] = x0 * r.s[i] + x1 * r.c[i]; }
}
__device__ __forceinline__ float sum8(float v) { v += dpp_x1(v); v += dpp_x2(v); v += dpp_x7(v); return v; }
__device__ __forceinline__ float sum16(float v) { v = sum8(v); v += dpp_x15(v); return v; }
__device__ __forceinline__ float ssq8(const float* f) { float s = 0.f;
#pragma unroll
    for (int i = 0; i < 8; ++i) s += f[i] * f[i];
    return s; }

__device__ __forceinline__ void phase_epost(const Args& a, const Ctx& c0) {
    const Ctx c = fresh(c0);
    unsigned char* ws = a.ws;
    const bf16_t* Z = (const bf16_t*)(ws + WS_RA);
    bf16_t* QKB = (bf16_t*)(ws + WS_RC);
    bf16_t* Qa = (bf16_t*)(ws + WS_RB);
    bf16_t* Ka = Qa + (size_t)BATCH * 8 * SEQ * 64;
    bf16_t* Va = Ka + (size_t)BATCH * 2 * SKV * 64;
    bf16_t* Qc = Va + (size_t)BATCH * 2 * SKV * 64;
    const int lane = c.lane;
    float gq[8], gk[8]; const float* rtab = (const float*)(ws + WS_ROPE64);
#pragma unroll
    for (int i = 0; i < 8; ++i) { gq[i] = a.in[I_EGQ][(lane & 7) * 8 + i]; gk[i] = a.in[I_EGK][(lane & 7) * 8 + i]; }
    float cw[2][3][8], cb[2][8];
#pragma unroll
    for (int jj = 0; jj < 2; ++jj)
#pragma unroll
        for (int i = 0; i < 8; ++i) { const int ch = 8 * lane + 512 * jj + i; cb[jj][i] = a.in[I_ECONVB][ch];
#pragma unroll
            for (int j = 0; j < 3; ++j) cw[jj][j][i] = a.in[I_ECONVW][j * 1024 + ch]; }
    const float qscale = 0.125f * LOG2E;
    const bool f8 = fast8_e(a, lane), w16 = !f8 || A8_DEBUG == 1;
    unsigned char* Q8a = ws + F8_EQ; unsigned char* K8a = ws + F8_EK; unsigned char* Q8c = ws + F8_EQC;
    for (int row = c.gw; row < NROW; row += c.NGW) {
        const bool isctx = row < TC;
        const int b = isctx ? row / CTX : (row - TC) / SEQ, t = isctx ? row % CTX : (row - TC) % SEQ;
        const int slen = isctx ? CTX : SEQ;
        const bf16_t* zr = Z + (size_t)row * NZE;
        Rope4 rp; if (!isctx) rp = rope64_angles(t, lane, rtab);
        float f[8];
        { const u32x4 w = *(const u32x4*)(zr + 8 * lane); unpack8(w, f);
          const float rstd = rsqrtf(sum8(ssq8(f)) * (1.f / 64.f) + EPS);
#pragma unroll
          for (int i = 0; i < 8; ++i) f[i] = f[i] * rstd * gq[i];
          if (!isctx) rope_apply8(f, rp);
#pragma unroll
          for (int i = 0; i < 8; ++i) f[i] *= qscale;
          const int h = lane >> 3;
          if (f8) { unsigned char* r8 = isctx ? Q8c + ((size_t)(b * 8 + h) * CTX + t) * 64 : Q8a + ((size_t)(b * 8 + h) * SEQ + t) * 64; const int j8 = lane & 7;
            if constexpr (A8_QK6) { float g6[8]; _Pragma("unroll") for (int i = 0; i < 8; ++i) g6[i] = f[i] * 0.03125f; unsigned lo6, hi6; pk8_f6(g6, lo6, hi6); unsigned char* gp = r8 + (j8 >> 2) * 32; st6(gp, gp + 16, j8 & 3, lo6, hi6); }
            else *(u32x2*)(r8 + j8 * 8) = pk8_f8(f); }
          if (w16) { bf16_t* dst = isctx ? Qc + ((size_t)(b * 8 + h) * CTX + t) * 64 + (lane & 7) * 8 : Qa + ((size_t)(b * 8 + h) * SEQ + t) * 64 + (lane & 7) * 8;
            *(u32x4*)dst = pack8(f); } }
        if (lane < 16) {
            const int hk = lane >> 3, pos = isctx ? t : CTX + t;
            { const u32x4 w = *(const u32x4*)(zr + 512 + 8 * lane); unpack8(w, f); }
            const float rstd = rsqrtf(sum8(ssq8(f)) * (1.f / 64.f) + EPS);
#pragma unroll
            for (int i = 0; i < 8; ++i) f[i] = f[i] * rstd * gk[i];
            if (!isctx) rope_apply8(f, rp);
            if (f8) { const int j8 = lane & 7; unsigned char* tb = K8a + ((size_t)((b * 2 + hk) * NTILE + (pos >> 6))) * 4096;
              if constexpr (A8_QK6) { float g6[8]; _Pragma("unroll") for (int i = 0; i < 8; ++i) g6[i] = f[i] * 0.0078125f; unsigned lo6, hi6; pk8_f6(g6, lo6, hi6); const int gg = j8 >> 2;
                st6(tb + att8::k_off<64>(pos & 63, 2 * gg), tb + att8::k_off<64>(pos & 63, 2 * gg + 1), j8 & 3, lo6, hi6); }
              else *(u32x2*)(tb + att8::k_off<64>(pos & 63, j8 >> 1) + (j8 & 1) * 8) = pk8_f8(f); }
            if (w16) { *(u32x4*)(Ka + ((size_t)(b * 2 + hk) * SKV + pos) * 64 + (lane & 7) * 8) = pack8(f);
                const u32x4 wv = *(const u32x4*)(zr + 640 + 8 * lane);
                *(u32x4*)(Va + ((size_t)(b * 2 + hk) * SKV + pos) * 64 + (lane & 7) * 8) = wv; }
        }
#pragma unroll
        for (int jj = 0; jj < 2; ++jj) {
            const int ch = 8 * lane + 512 * jj;
            float accv[8];
#pragma unroll
            for (int i = 0; i < 8; ++i) accv[i] = cb[jj][i];
#pragma unroll
            for (int j = 0; j < 3; ++j) { const int tt = t + j - 1;
                if (tt >= 0 && tt < slen) { const u32x4 w = *(const u32x4*)(zr + (long)(j - 1) * NZE + 768 + ch); float g[8]; unpack8(w, g);
#pragma unroll
                    for (int i = 0; i < 8; ++i) accv[i] += g[i] * cw[jj][j][i]; } }
            const float ks = jj ? 0.08838834764831845f : 1.0f;
#pragma unroll
            for (int i = 0; i < 8; ++i) accv[i] = siluf(accv[i]) * ks;
            *(u32x4*)(QKB + (size_t)row * D + ch) = pack8(accv);
        }
    }
    if (f8) vquant_items<64>(Z, NZE, 640, 64, 2, ws + F8_EV, c.gw, c.NGW, lane);
}

__device__ __forceinline__ void phase_eattn(const Args& a, const Ctx& c0) {
    const Ctx c = fresh(c0);
    unsigned char* ws = a.ws;
    const bf16_t* Qa = (const bf16_t*)(ws + WS_RB);
    const bf16_t* Ka = Qa + (size_t)BATCH * 8 * SEQ * 64;
    const bf16_t* Va = Ka + (size_t)BATCH * 2 * SKV * 64;
    const bf16_t* Qc = Va + (size_t)BATCH * 2 * SKV * 64;
    bf16_t* MIX = (bf16_t*)(ws + WS_HMF);
    LAS char* lds = (LAS char*)c.lds;
    float gq = fabsf(a.in[I_EGQ][c.lane]), gk = fabsf(a.in[I_EGK][c.lane]);
    gq = wave_max(gq); gk = wave_max(gk);
    const bool fast = (0.125f * LOG2E * 64.f * gq * gk) < 90.f;
#define EATT(FIXV) do { \
    for (int L = c.vcu; L < 16; L += c.G) { const int b = L / 8, h = L % 8, kvh = h / 4; \
        att64::attn_unit<8, FIXV>((const att64::bf16*)(Qc + (size_t)(b * 8 + h) * CTX * 64), 64, (const att64::bf16*)(Ka + (size_t)(b * 2 + kvh) * SKV * 64), (const att64::bf16*)(Va + (size_t)(b * 2 + kvh) * SKV * 64), 64, 64, \
                               (att64::bf16*)(MIX + (size_t)(b * CTX) * D + h * 64), D, CTX / 64, (char*)lds, c.wave); } \
    for (int L = c.vcu; L < 1024; L += c.G) { const int bk = L / 256, rem = L % 256, b = bk / 2, kvh = bk % 2, hq = rem / 64, qb = rem % 64, h = kvh * 4 + hq; \
        att64::attn_unit<8, FIXV>((const att64::bf16*)(Qa + ((size_t)(b * 8 + h) * SEQ + qb * 256) * 64), 64, (const att64::bf16*)(Ka + (size_t)(b * 2 + kvh) * SKV * 64), (const att64::bf16*)(Va + (size_t)(b * 2 + kvh) * SKV * 64), 64, 64, \
                               (att64::bf16*)(MIX + (size_t)(TC + b * SEQ + qb * 256) * D + h * 64), D, SKV / 64, (char*)lds, c.wave); } } while (0)
    const bool f8 = fast8_e(a, c.lane);
#define EATT8(EPIV, CHK) do { \
    for (int L = c.vcu; L < 16; L += c.G) { const int b = L / 8, h = L % 8, kvh = h / 4; \
        att8::attn_unit<64, 64, EPIV>(ws + F8_EQC + (size_t)(b * 8 + h) * CTX * 64, ws + F8_EK + (size_t)(b * 2 + kvh) * NTILE * 4096, ws + F8_EV + (size_t)(b * 2 + kvh) * NTILE * 4096, \
                                      MIX + (size_t)(b * CTX) * D + h * 64, D, CTX / 64, lds, c.wave, nullptr, 0, 0.f, nullptr, 1.f, CHK); } \
    for (int L = c.vcu; L < 1024; L += c.G) { const int bk = L / 256, rem = L % 256, b = bk / 2, kvh = bk % 2, hq = rem / 64, qb = rem % 64, h = kvh * 4 + hq; \
        att8::attn_unit<64, 64, EPIV>(ws + F8_EQ + ((size_t)(b * 8 + h) * SEQ + qb * 256) * 64, ws + F8_EK + (size_t)(b * 2 + kvh) * NTILE * 4096, ws + F8_EV + (size_t)(b * 2 + kvh) * NTILE * 4096, \
                                      MIX + (size_t)(TC + b * SEQ + qb * 256) * D + h * 64, D, NTILE, lds, c.wave, nullptr, 0, 0.f, nullptr, 1.f, CHK); } } while (0)
#if A8_DEBUG == 1
    if (fast) EATT(true); else EATT(false);
    if (f8) { grid_sync(c); EATT8(2, (float*)(ws + WS_CTL) + CW_CHK); }
#else
    if (f8) EATT8(0, nullptr); else if (fast) EATT(true); else EATT(false);
#endif
#undef EATT8
#undef EATT
}

__device__ __forceinline__ int ml_row0(int b, int nc) { return nc < 2 ? b * CTX + nc * 128 : TC + b * SEQ + (nc - 2) * 128; }
__device__ __forceinline__ float wave_scan_add(float v, int lane) {
#ifdef TEST_HIP_SCAN
    for (int o = 1; o < 64; o <<= 1) { const float t = __shfl_up(v, o); if (lane >= o) v += t; } return v;
#endif
    v += DPPF(0.f, v, 0x111, 0xf); v += DPPF(0.f, v, 0x112, 0xf); v += DPPF(0.f, v, 0x114, 0xf); v += DPPF(0.f, v, 0x118, 0xf);
    v += DPPF(0.f, v, 0x142, 0xa); v += DPPF(0.f, v, 0x143, 0xc); (void)lane;
    return v;
}
__device__ __forceinline__ float wave_scan_max(float v, int lane) {
#ifdef TEST_HIP_SCAN
    for (int o = 1; o < 64; o <<= 1) { const float t = __shfl_up(v, o); if (lane >= o) v = fmaxf(v, t); } return v;
#endif
    v = fmaxf(v, DPPF(-INFINITY, v, 0x111, 0xf)); v = fmaxf(v, DPPF(-INFINITY, v, 0x112, 0xf)); v = fmaxf(v, DPPF(-INFINITY, v, 0x114, 0xf)); v = fmaxf(v, DPPF(-INFINITY, v, 0x118, 0xf));
    v = fmaxf(v, DPPF(-INFINITY, v, 0x142, 0xa)); v = fmaxf(v, DPPF(-INFINITY, v, 0x143, 0xc)); (void)lane;
    return v;
}
__device__ __forceinline__ void ml_gate_scan(const float* Gt, int row0, int h, LAS float* av, LAS float* bc, LAS float* pm, LAS float* sc, int wave, int lane) {
    if (wave < 2) {
        const int dir = wave;
        const int u0 = dir ? 127 - 2 * lane : 2 * lane, u1 = dir ? 126 - 2 * lane : 2 * lane + 1;
        const float i0 = Gt[(size_t)(row0 + u0) * 16 + dir * 8 + h], i1 = Gt[(size_t)(row0 + u1) * 16 + dir * 8 + h];
        const float f0 = Gt[(size_t)(row0 + u0) * 16 + dir * 8 + 4 + h], f1 = Gt[(size_t)(row0 + u1) * 16 + dir * 8 + 4 + h];
        const float s = f0 + f1, incl = wave_scan_add(s, lane), excl = incl - s;
        const float b0 = excl + f0, b1 = incl;
        const float a0 = i0 - b0, a1 = i1 - b1;
        const float m01 = fmaxf(a0, a1), inclm = wave_scan_max(m01, lane);
#ifdef TEST_HIP_SCAN
        float exclm = __shfl_up(inclm, 1); if (lane == 0) exclm = -INFINITY;
#else
        const float exclm = DPPF(-INFINITY, inclm, 0x138, 0xf);
#endif
        LAS float* avd = av + dir * 128; LAS float* bcd = bc + dir * 128; LAS float* pmd = pm + dir * 128;
        avd[u0] = a0; avd[u1] = a1; bcd[u0] = b0; bcd[u1] = b1; pmd[u0] = fmaxf(exclm, a0); pmd[u1] = fmaxf(exclm, m01);
        if (lane == 63) { sc[dir * 4 + 0] = incl; sc[dir * 4 + 1] = inclm; }
    }
}
constexpr int MLP = 136;
__device__ __forceinline__ void ml_stage_rm(const bf16_t* g, int gp, LAS bf16_t* l, int tid) {
#pragma unroll
    for (int it = 0; it < 4; ++it) { const int cid = tid + 512 * it, u = cid >> 4, cc = cid & 15;
        const u32x4 w = *(const u32x4*)(g + (size_t)u * gp + cc * 8); *(LAS u32x4*)(l + u * MLP + cc * 8) = w; }
}
__device__ __forceinline__ void ml_stage_tr(const bf16_t* g, int gp, LAS bf16_t* l0, int tid) {
#pragma unroll
    for (int it = 0; it < 4; ++it) { const int cid = tid + 512 * it, u = cid & 127, ec = cid >> 7;
        const u32x4 w = *(const u32x4*)(g + (size_t)u * gp + ec * 8);
        const unsigned ww[4] = {w.x, w.y, w.z, w.w};
#pragma unroll
        for (int i = 0; i < 4; ++i) { l0[(ec * 8 + 2 * i) * MLP + u] = (bf16_t)(ww[i] & 0xffffu); l0[(ec * 8 + 2 * i + 1) * MLP + u] = (bf16_t)(ww[i] >> 16); } }
}
__device__ __forceinline__ void ml_stage_tr_scaled2(const bf16_t* g, int gp, LAS bf16_t* l0, LAS bf16_t* l1, const LAS float* s0, const LAS float* s1, int tid) {
#pragma unroll
    for (int it = 0; it < 4; ++it) { const int cid = tid + 512 * it, u = cid & 127, ec = cid >> 7;
        const u32x4 w = *(const u32x4*)(g + (size_t)u * gp + ec * 8); float f[8]; unpack8(w, f);
        const float g0 = s0[u], g1 = s1[u];
#pragma unroll
        for (int i = 0; i < 8; ++i) { l0[(ec * 8 + i) * MLP + u] = (bf16_t)f2bf(f[i] * g0); l1[(ec * 8 + i) * MLP + u] = (bf16_t)f2bf(f[i] * g1); } }
}
__device__ __forceinline__ bf16x8 ml_frag(const LAS bf16_t* t, int row, int k0, int lane) { return *(const LAS bf16x8*)(t + (row + (lane & 15)) * MLP + k0 + 8 * (lane >> 4)); }

__device__ __forceinline__ void phase_mla(const Args& a, const Ctx& c0) {
    const Ctx c = fresh(c0);
    unsigned char* ws = a.ws;
    const bf16_t* Z = (const bf16_t*)(ws + WS_RA);
    const bf16_t* QKB = (const bf16_t*)(ws + WS_RC);
    const float* Gt = (const float*)(ws + WS_G);
    bf16_t* KL = (bf16_t*)(ws + WS_RB);
    float* BL = (float*)(ws + WS_ML + ML_BL); float* MLc = (float*)(ws + WS_ML + ML_ML); float* NL = (float*)(ws + WS_ML + ML_NL);
    LAS bf16_t* vT = (LAS bf16_t*)c.lds;
    LAS bf16_t* kgF = vT + 128 * MLP;
    LAS bf16_t* kgB = kgF + 128 * MLP;
    LAS float* av = (LAS float*)(kgB + 128 * MLP); LAS float* bc = av + 256; LAS float* pm = bc + 256; LAS float* sc = pm + 256; LAS float* gs = sc + 16;
    const int tid = c.tid, lane = c.lane, wave = c.wave;
    for (int U = c.vcu; U < BATCH * 4 * NCHUNK; U += c.G) {
        const int b = U / (4 * NCHUNK), h = (U / NCHUNK) % 4, nc = U % NCHUNK;
        const int row0 = ml_row0(b, nc);
        ml_gate_scan(Gt, row0, h, av, bc, pm, sc, wave, lane);
        __syncthreads();
        if (tid < 256) { const int dir = tid >> 7, u = tid & 127; gs[tid] = __expf(av[dir * 128 + u] - sc[dir * 4 + 1]); }
        __syncthreads();
        ml_stage_tr(Z + (size_t)row0 * NZE + 1792 + h * 128, NZE, vT, tid);
        ml_stage_tr_scaled2(QKB + (size_t)row0 * D + 512 + h * 128, D, kgF, kgB, gs, gs + 128, tid);
        __syncthreads();
        const int cf = nc, cbk = nc < 2 ? 1 - nc : 131 - nc;
        const int chf = (b * 4 + h) * 2, chb = chf + 1;
        if (tid < 2) { const int dir = tid; const int ch = dir ? chb : chf, cc = dir ? cbk : cf; BL[ch * NCHUNK + cc] = sc[dir * 4 + 0]; MLc[ch * NCHUNK + cc] = sc[dir * 4 + 0] + sc[dir * 4 + 1]; }
        if (tid < 256) { const int dir = tid >> 7, d = tid & 127; const LAS bf16_t* r = (dir ? kgB : kgF) + d * MLP; float s = 0.f;
            for (int u = 0; u < 128; ++u) s += bf2f(r[u]);
            NL[((size_t)(dir ? chb : chf) * NCHUNK + (dir ? cbk : cf)) * 128 + d] = s; }
        f32x4 accF[8], accB[8];
#pragma unroll
        for (int n = 0; n < 8; ++n) { accF[n] = (f32x4){0.f, 0.f, 0.f, 0.f}; accB[n] = (f32x4){0.f, 0.f, 0.f, 0.f}; }
#pragma unroll
        for (int k0 = 0; k0 < 128; k0 += 32) { const bf16x8 af = ml_frag(vT, 16 * wave, k0, lane);
#pragma unroll
            for (int n = 0; n < 8; ++n) { accF[n] = __builtin_amdgcn_mfma_f32_16x16x32_bf16(af, ml_frag(kgF, 16 * n, k0, lane), accF[n], 0, 0, 0);
                                          accB[n] = __builtin_amdgcn_mfma_f32_16x16x32_bf16(af, ml_frag(kgB, 16 * n, k0, lane), accB[n], 0, 0, 0); } }
        bf16_t* of = KL + ((size_t)chf * NCHUNK + cf) * 16384, *ob = KL + ((size_t)chb * NCHUNK + cbk) * 16384;
#pragma unroll
        for (int n = 0; n < 8; ++n)
#pragma unroll
            for (int r = 0; r < 4; ++r) { const int e = 16 * wave + 4 * (lane >> 4) + r, d = 16 * n + (lane & 15);
                of[e * 128 + d] = (bf16_t)f2bf(accF[n][r]); ob[e * 128 + d] = (bf16_t)f2bf(accB[n][r]); }
        __syncthreads();
    }
}

__device__ __forceinline__ void phase_mlb(const Args& a, const Ctx& c0) {
    const Ctx c = fresh(c0);
    unsigned char* ws = a.ws;
    bf16_t* KL = (bf16_t*)(ws + WS_RB);
    const float* BL = (const float*)(ws + WS_ML + ML_BL); const float* MLc = (const float*)(ws + WS_ML + ML_ML);
    float* MS = (float*)(ws + WS_ML + ML_MS); float* NL = (float*)(ws + WS_ML + ML_NL);
    const int NTH = c.G * 512;
    constexpr int GRP = 13;
    for (int idx = c.vcu * 512 + c.tid; idx < NCHAIN * 8192; idx += NTH) {
        const int ch = idx / 8192, el2 = idx % 8192;
        float st0 = 0.f, st1 = 0.f, m = 0.f;
        const float* bl = BL + ch * NCHUNK; const float* ml = MLc + ch * NCHUNK;
        unsigned* base = (unsigned*)(KL + (size_t)ch * NCHUNK * 16384) + el2;
        for (int g = 0; g < NCHUNK / GRP; ++g) {
            unsigned kv[GRP]; float blv[GRP], mlv[GRP];
#pragma unroll
            for (int i = 0; i < GRP; ++i) { kv[i] = base[(size_t)(g * GRP + i) * 8192]; blv[i] = bl[g * GRP + i]; mlv[i] = ml[g * GRP + i]; }
#pragma unroll
            for (int i = 0; i < GRP; ++i) {
                const float mn = fmaxf(blv[i] + m, mlv[i]), decay = __expf(blv[i] + m - mn), wl = __expf(mlv[i] - mn);
                base[(size_t)(g * GRP + i) * 8192] = pk2(st0, st1);
                st0 = decay * st0 + wl * bflo(kv[i]); st1 = decay * st1 + wl * bfhi(kv[i]); m = mn; }
        }
    }
    for (int idx = c.vcu * 512 + c.tid; idx < NCHAIN * 128; idx += NTH) {
        const int ch = idx / 128, el = idx % 128;
        float st = 0.f, m = 0.f;
        const float* bl = BL + ch * NCHUNK; const float* ml = MLc + ch * NCHUNK;
        float* base = NL + (size_t)ch * NCHUNK * 128 + el;
        for (int g = 0; g < NCHUNK / GRP; ++g) {
            float kv[GRP], blv[GRP], mlv[GRP];
#pragma unroll
            for (int i = 0; i < GRP; ++i) { kv[i] = base[(size_t)(g * GRP + i) * 128]; blv[i] = bl[g * GRP + i]; mlv[i] = ml[g * GRP + i]; }
#pragma unroll
            for (int i = 0; i < GRP; ++i) {
                const float mn = fmaxf(blv[i] + m, mlv[i]), decay = __expf(blv[i] + m - mn), wl = __expf(mlv[i] - mn);
                base[(size_t)(g * GRP + i) * 128] = st; if (el == 0) MS[ch * NCHUNK + g * GRP + i] = m;
                st = decay * st + wl * kv[i]; m = mn; }
        }
    }
}

__device__ __forceinline__ void phase_mlc(const Args& a, const Ctx& c0) {
    const Ctx c = fresh(c0);
    unsigned char* ws = a.ws;
    const bf16_t* Z = (const bf16_t*)(ws + WS_RA);
    const bf16_t* QKB = (const bf16_t*)(ws + WS_RC);
    const float* Gt = (const float*)(ws + WS_G);
    const bf16_t* CS = (const bf16_t*)(ws + WS_RB);
    const float* MS = (const float*)(ws + WS_ML + ML_MS); const float* NS = (const float*)(ws + WS_ML + ML_NL);
    bf16_t* MIX = (bf16_t*)(ws + WS_HMF);
    LAS bf16_t* qT = (LAS bf16_t*)c.lds;
    LAS bf16_t* kT = qT + 128 * MLP;
    LAS bf16_t* vT = kT + 144 * MLP;
    LAS bf16_t* cT = vT + 128 * MLP;
    LAS float* av = (LAS float*)(cT + 128 * MLP); LAS float* bc = av + 256; LAS float* pm = bc + 256; LAS float* sc = pm + 256;
    const int tid = c.tid, lane = c.lane, wave = c.wave;
    const int fr = lane & 15, fq = lane >> 4;
    for (int U = c.vcu; U < BATCH * 4 * NCHUNK; U += c.G) {
        const int b = U / (4 * NCHUNK), h = (U / NCHUNK) % 4, nc = U % NCHUNK;
        const int row0 = ml_row0(b, nc);
        const int cf = nc, cbk = nc < 2 ? 1 - nc : 131 - nc;
        const int chf = (b * 4 + h) * 2, chb = chf + 1;
        ml_gate_scan(Gt, row0, h, av, bc, pm, sc, wave, lane);
        ml_stage_rm(QKB + (size_t)row0 * D + h * 128, D, qT, tid);
        ml_stage_rm(QKB + (size_t)row0 * D + 512 + h * 128, D, kT, tid);
        ml_stage_tr(Z + (size_t)row0 * NZE + 1792 + h * 128, NZE, vT, tid);
        ml_stage_rm(CS + ((size_t)chf * NCHUNK + cf) * 16384, 128, cT, tid);
        if (tid < 256) { const int dir = tid >> 7, d = tid & 127; kT[(128 + dir) * MLP + d] = (bf16_t)f2bf(NS[((size_t)(dir ? chb : chf) * NCHUNK + (dir ? cbk : cf)) * 128 + d]); }
        for (int i = tid; i < 14 * 128; i += 512) kT[(130 + i / 128) * MLP + (i % 128)] = 0;
        const float mF = MS[chf * NCHUNK + cf], mB = MS[chb * NCHUNK + cbk];
        __syncthreads();
        f32x4 S[9];
#pragma unroll
        for (int n = 0; n < 9; ++n) S[n] = (f32x4){0.f, 0.f, 0.f, 0.f};
#pragma unroll
        for (int k0 = 0; k0 < 128; k0 += 32) { const bf16x8 af = ml_frag(qT, 16 * wave, k0, lane);
#pragma unroll
            for (int n = 0; n < 9; ++n) S[n] = __builtin_amdgcn_mfma_f32_16x16x32_bf16(af, ml_frag(kT, 16 * n, k0, lane), S[n], 0, 0, 0); }
        float AF[4], AB[4], rsF[4], rsB[4];
#pragma unroll
        for (int r = 0; r < 4; ++r) { const int j = 16 * wave + 4 * fq + r; AF[r] = fmaxf(mF, pm[j]); AB[r] = fmaxf(mB, pm[128 + j]); rsF[r] = 0.f; rsB[r] = 0.f; }
        float PF[8][4], PB[8][4];
#pragma unroll
        for (int n = 0; n < 8; ++n) { const int s = 16 * n + fr; const float afs = av[s], abs_ = av[128 + s];
#pragma unroll
            for (int r = 0; r < 4; ++r) { const int j = 16 * wave + 4 * fq + r;
                const float pf = (s <= j) ? S[n][r] * __expf(afs - AF[r]) : 0.f, pb = (s >= j) ? S[n][r] * __expf(abs_ - AB[r]) : 0.f;
                PF[n][r] = pf; PB[n][r] = pb; rsF[r] += pf; rsB[r] += pb; } }
        float cF[4], cB[4], iDF[4], iDB[4];
#pragma unroll
        for (int r = 0; r < 4; ++r) { const int j = 16 * wave + 4 * fq + r;
            const float sF = sum16(rsF[r]), sB = sum16(rsB[r]);
            const float sv = S[8][r];
            const float qnF = fq == 0 ? rdlane(sv, 0) : fq == 1 ? rdlane(sv, 16) : fq == 2 ? rdlane(sv, 32) : rdlane(sv, 48);
            const float qnB = fq == 0 ? rdlane(sv, 1) : fq == 1 ? rdlane(sv, 17) : fq == 2 ? rdlane(sv, 33) : rdlane(sv, 49);
            const float aiF = __expf(mF - AF[r]), aiB = __expf(mB - AB[r]);
            const float denF = aiF * qnF + sF, denB = aiB * qnB + sB;
            const float DF = fmaxf(fabsf(denF), __expf(-(bc[j] + AF[r]))), DB = fmaxf(fabsf(denB), __expf(-(bc[128 + j] + AB[r])));
            iDF[r] = 1.f / DF; iDB[r] = 1.f / DB; cF[r] = aiF * iDF[r]; cB[r] = aiB * iDB[r]; }
        __syncthreads();
#pragma unroll
        for (int n = 0; n < 8; ++n)
#pragma unroll
            for (int r = 0; r < 4; ++r) kT[(16 * wave + 4 * fq + r) * MLP + 16 * n + fr] = (bf16_t)f2bf(PF[n][r] * iDF[r] + PB[n][r] * iDB[r]);
        __syncthreads();
        f32x4 O[8], X[8];
#pragma unroll
        for (int n = 0; n < 8; ++n) { O[n] = (f32x4){0.f, 0.f, 0.f, 0.f}; X[n] = (f32x4){0.f, 0.f, 0.f, 0.f}; }
#pragma unroll
        for (int k0 = 0; k0 < 128; k0 += 32) { const bf16x8 ap = ml_frag(kT, 16 * wave, k0, lane), aq = ml_frag(qT, 16 * wave, k0, lane);
#pragma unroll
            for (int n = 0; n < 8; ++n) { O[n] = __builtin_amdgcn_mfma_f32_16x16x32_bf16(ap, ml_frag(vT, 16 * n, k0, lane), O[n], 0, 0, 0);
                                          X[n] = __builtin_amdgcn_mfma_f32_16x16x32_bf16(aq, ml_frag(cT, 16 * n, k0, lane), X[n], 0, 0, 0); } }
#pragma unroll
        for (int n = 0; n < 8; ++n)
#pragma unroll
            for (int r = 0; r < 4; ++r) O[n][r] += cF[r] * X[n][r];
        __syncthreads();
        ml_stage_rm(CS + ((size_t)chb * NCHUNK + cbk) * 16384, 128, cT, tid);
        __syncthreads();
#pragma unroll
        for (int n = 0; n < 8; ++n) X[n] = (f32x4){0.f, 0.f, 0.f, 0.f};
#pragma unroll
        for (int k0 = 0; k0 < 128; k0 += 32) { const bf16x8 aq = ml_frag(qT, 16 * wave, k0, lane);
#pragma unroll
            for (int n = 0; n < 8; ++n) X[n] = __builtin_amdgcn_mfma_f32_16x16x32_bf16(aq, ml_frag(cT, 16 * n, k0, lane), X[n], 0, 0, 0); }
        float ssq[4] = {0.f, 0.f, 0.f, 0.f};
#pragma unroll
        for (int n = 0; n < 8; ++n)
#pragma unroll
            for (int r = 0; r < 4; ++r) { O[n][r] += cB[r] * X[n][r]; ssq[r] += O[n][r] * O[n][r]; }
#pragma unroll
        for (int r = 0; r < 4; ++r) { const float rstd = rsqrtf(sum16(ssq[r]) * (1.f / 128.f) + EPS); const int row = row0 + 16 * wave + 4 * fq + r;
#pragma unroll
            for (int n = 0; n < 8; ++n) { const int e = 16 * n + fr;
                const float obv = bf2f(Z[(size_t)row * NZE + 2304 + h * 128 + e]);
                MIX[(size_t)row * D + 512 + h * 128 + e] = (bf16_t)f2bf(O[n][r] * rstd * a.in[I_EGH][h * 128 + e] * sigmoidf_(obv)); } }
        __syncthreads();
    }
}

__device__ __forceinline__ float reduce32(float* p, int lane) {
#pragma unroll
    for (int i = 0; i < 16; ++i) { const bool up = (lane & 32) != 0; const float send = up ? p[i] : p[i + 16]; const float recv = xshfl<32>(send); p[i] = (up ? p[i + 16] : p[i]) + recv; }
#pragma unroll
    for (int i = 0; i < 8; ++i) { const bool up = (lane & 16) != 0; const float send = up ? p[i] : p[i + 8]; const float recv = xshfl<16>(send); p[i] = (up ? p[i + 8] : p[i]) + recv; }
#pragma unroll
    for (int i = 0; i < 4; ++i) { const bool up = (lane & 8) != 0; const float send = up ? p[i] : p[i + 4]; const float recv = dpp_x15(send); p[i] = (up ? p[i + 4] : p[i]) + recv; }
#pragma unroll
    for (int i = 0; i < 2; ++i) { const bool up = (lane & 4) != 0; const float send = up ? p[i] : p[i + 2]; const float recv = dpp_x7(send); p[i] = (up ? p[i + 2] : p[i]) + recv; }
    { const bool up = (lane & 2) != 0; const float send = up ? p[0] : p[1]; const float recv = dpp_x2(send); p[0] = (up ? p[1] : p[0]) + recv; }
    p[0] += dpp_x1(p[0]);
    return p[0];
}
__device__ __forceinline__ void phase_mnorm(const Args& a, const Ctx& c0, int layer, int dry = 0) {
    const Ctx c = fresh(c0);
    unsigned char* ws = a.ws;
    const bf16_t* X = (const bf16_t*)(ws + WS_X);
    bf16_t* F = (bf16_t*)(ws + WS_HMF);
    const float* mod = (const float*)(ws + WS_MOD) + (size_t)layer * 3 * 6144;
    int* RTE = (int*)(ws + WS_RT + RT_E); int* RTP = (int*)(ws + WS_RT + RT_POS); float* RTG = (float*)(ws + WS_RT + RT_GATE);
    unsigned* gcnt = (unsigned*)(ws + WS_CTL) + (layer ? CW_CNT1 : CW_CNT0);
    LAS float* wT = (LAS float*)c.lds;
    LAS unsigned* lcnt = (LAS unsigned*)(c.lds + 131072);
    LAS unsigned* lbase = lcnt + 32;
    const int lane = c.lane, tid = c.tid;
    for (int k = tid; k < D; k += 512) { const f32x4* src = (const f32x4*)(a.in[I_WR] + (size_t)k * NE);
#pragma unroll
        for (int q = 0; q < 8; ++q) { const f32x4 w = src[q]; wT[(4 * q + 0) * D + k] = w.x; wT[(4 * q + 1) * D + k] = w.y; wT[(4 * q + 2) * D + k] = w.z; wT[(4 * q + 3) * D + k] = w.w; } }
    if (tid < 32) lcnt[tid] = 0u;
    __syncthreads();
    const float* gffn = a.in[I_GFFN] + layer * D;
    const int rlo = layer ? TC : 0;
    int my_e0 = 0, my_e1 = 0, my_p0 = 0, my_p1 = 0; int it = 0;
    f32x4 gsc[4], msh[4]; u32x2 xa[4], xb[4]; int cur_bs = -1;
    const float rbias = a.in[I_BR][lane >> 1];
#define MN_LOADX(X, R) do { if ((R) < NROW) { _Pragma("unroll") for (int j = 0; j < 4; ++j) X[j] = ((const u32x2*)(X_ + (size_t)(R) * D))[lane + 64 * j]; } } while (0)
    const bf16_t* X_ = X;
    MN_LOADX(xa, rlo + c.gw); MN_LOADX(xb, rlo + c.gw + c.NGW);
#define MN_NORM(V, XR, ROW, NEXTROW) do { const int bs = row_bsel(ROW); \
        if (bs != cur_bs) { cur_bs = bs; _Pragma("unroll") for (int j = 0; j < 4; ++j) { msh[j] = ((const f32x4*)(mod + bs * 6144 + 3 * 1024))[lane + 64 * j]; gsc[j] = ((const f32x4*)gffn)[lane + 64 * j] * (((const f32x4*)(mod + bs * 6144 + 4 * 1024))[lane + 64 * j] + 1.0f); } } \
        float ssq_ = 0.f; \
        _Pragma("unroll") for (int j = 0; j < 4; ++j) { V[j] = bf4_to_f32(XR[j]); ssq_ += (V[j].x * V[j].x + V[j].y * V[j].y) + (V[j].z * V[j].z + V[j].w * V[j].w); } \
        MN_LOADX(XR, NEXTROW); \
        const float rstd_ = rsqrtf(wave_sum(ssq_) * (1.f / D) + EPS); \
        _Pragma("unroll") for (int j = 0; j < 4; ++j) V[j] = (V[j] * rstd_) * gsc[j] + msh[j]; \
        store_row_bf16(F + (size_t)(ROW) * D, lane, V); } while (0)
#define RMAXF(x) do { x = fmaxf(x, dpp_x1(x)); x = fmaxf(x, dpp_x2(x)); x = fmaxf(x, dpp_x7(x)); x = fmaxf(x, dpp_x15(x)); } while (0)
#define DPPI(v, ctrl) __builtin_amdgcn_update_dpp(0, (v), (ctrl), 0xf, 0xf, false)
#define RMINI(x) do { x = min(x, DPPI(x, 0xB1)); x = min(x, DPPI(x, 0x4E)); x = min(x, DPPI(x, 0x141)); x = min(x, DPPI(x, 0x140)); } while (0)
#define MN_ROUTE(P, ROW, IT) do { const float mine = reduce32(P, lane); int e0, e1; float s0, s1_; { \
            const int ex = lane >> 1; \
            const float scl = sigmoidf_(mine), sl = scl + rbias; \
            float m1 = sl; RMAXF(m1); \
            int i1 = (sl == m1) ? ex : 127; RMINI(i1); \
            const float sl2 = (ex == i1) ? -INFINITY : sl; \
            float m2 = sl2; RMAXF(m2); \
            int i2 = (sl2 == m2) ? ex : 127; RMINI(i2); \
            float c1 = (ex == i1) ? scl : -INFINITY; RMAXF(c1); \
            float c2 = (ex == i2) ? scl : -INFINITY; RMAXF(c2); \
            const float gs = m1 + m2; \
            const float q0 = rdlane(gs, 0), q1 = rdlane(gs, 16), q2 = rdlane(gs, 32), q3 = rdlane(gs, 48); \
            int bg = 0; float bv = q0; if (q1 > bv) { bv = q1; bg = 1; } if (q2 > bv) { bv = q2; bg = 2; } if (q3 > bv) { bv = q3; bg = 3; } \
            const int bl = __builtin_amdgcn_readfirstlane(bg * 16); \
            e0 = __builtin_amdgcn_readlane(i1, bl); e1 = __builtin_amdgcn_readlane(i2, bl); \
            s0 = __builtin_bit_cast(float, __builtin_amdgcn_readlane(__builtin_bit_cast(int, c1), bl)); s1_ = __builtin_bit_cast(float, __builtin_amdgcn_readlane(__builtin_bit_cast(int, c2), bl)); } \
        const float inv = 1.f / (s0 + s1_); \
        int p0 = 0, p1 = 0; \
        if (lane == 0 && !dry) { p0 = (int)__hip_atomic_fetch_add(&lcnt[e0], 1u, __ATOMIC_RELAXED, __HIP_MEMORY_SCOPE_WORKGROUP); p1 = (int)__hip_atomic_fetch_add(&lcnt[e1], 1u, __ATOMIC_RELAXED, __HIP_MEMORY_SCOPE_WORKGROUP); \
            RTG[(size_t)(ROW) * 2] = s0 * inv; RTG[(size_t)(ROW) * 2 + 1] = s1_ * inv; RTE[(size_t)(ROW) * 2] = e0; RTE[(size_t)(ROW) * 2 + 1] = e1; } \
        p0 = __builtin_amdgcn_readfirstlane(p0); p1 = __builtin_amdgcn_readfirstlane(p1); \
        if (lane == (IT)) { my_e0 = e0; my_e1 = e1; my_p0 = p0; my_p1 = p1; } } while (0)
    for (int row = rlo + c.gw; row < NROW; row += 2 * c.NGW, it += 2) {
        const int row1 = row + c.NGW; const bool has1 = row1 < NROW;
        f32x4 v0[4], v1[4];
        MN_NORM(v0, xa, row, row + 2 * c.NGW);
        if (has1) MN_NORM(v1, xb, row1, row1 + 2 * c.NGW);
        else {
#pragma unroll
            for (int j = 0; j < 4; ++j) v1[j] = (f32x4){0.f, 0.f, 0.f, 0.f}; }
        f32x2 vx[16];
#pragma unroll
        for (int j = 0; j < 4; ++j) { vx[4 * j] = (f32x2){v0[j].x, v1[j].x}; vx[4 * j + 1] = (f32x2){v0[j].y, v1[j].y}; vx[4 * j + 2] = (f32x2){v0[j].z, v1[j].z}; vx[4 * j + 3] = (f32x2){v0[j].w, v1[j].w}; }
        float pa[32], pb[32];
        { f32x4 wa[4], wb[4];
#define RD_LOAD(W, E) do { _Pragma("unroll") for (int j_ = 0; j_ < 4; ++j_) W[j_] = ((const LAS f32x4*)(wT + (E) * D))[lane + 64 * j_]; asm volatile("" ::: "memory"); } while (0)
#define RD_COMP(W, E) do { f32x2 acc_ = (f32x2){0.f, 0.f}; _Pragma("unroll") for (int j_ = 0; j_ < 4; ++j_) { const f32x4 w_ = W[j_]; \
        acc_ = __builtin_elementwise_fma(vx[4 * j_], (f32x2){w_.x, w_.x}, acc_); acc_ = __builtin_elementwise_fma(vx[4 * j_ + 1], (f32x2){w_.y, w_.y}, acc_); \
        acc_ = __builtin_elementwise_fma(vx[4 * j_ + 2], (f32x2){w_.z, w_.z}, acc_); acc_ = __builtin_elementwise_fma(vx[4 * j_ + 3], (f32x2){w_.w, w_.w}, acc_); } pa[E] = acc_.x; pb[E] = acc_.y; } while (0)
          RD_LOAD(wa, 0);
#pragma unroll
          for (int e = 0; e < 32; e += 2) {
              RD_LOAD(wb, e + 1);
              RD_COMP(wa, e);
              if (e + 2 < 32) RD_LOAD(wa, e + 2);
              RD_COMP(wb, e + 1);
          }
#undef RD_LOAD
#undef RD_COMP
        }
        MN_ROUTE(pa, row, it);
        if (has1) MN_ROUTE(pb, row1, it + 1);
    }
#undef MN_LOADX
#undef MN_NORM
#undef MN_ROUTE
#undef RMAXF
#undef DPPI
#undef RMINI
    __syncthreads();
    if (tid < 32 && !dry) lbase[tid] = atomicAdd(&gcnt[tid], lcnt[tid]);
    __syncthreads();
    { const int row = rlo + c.gw + lane * c.NGW;
      if (lane < it && row < NROW && !dry) { RTP[(size_t)row * 2] = (int)lbase[my_e0] + my_p0; RTP[(size_t)row * 2 + 1] = (int)lbase[my_e1] + my_p1; } }
}

__device__ __forceinline__ void phase_mgather(const Args& a, const Ctx& c0, int layer) {
    const Ctx c = fresh(c0);
    unsigned char* ws = a.ws;
    const int* RTE = (const int*)(ws + WS_RT + RT_E); const int* RTP = (const int*)(ws + WS_RT + RT_POS); int* DEST = (int*)(ws + WS_RT + RT_DEST);
    const unsigned* gcnt = (const unsigned*)(ws + WS_CTL) + (layer ? CW_CNT1 : CW_CNT0);
    int* BLKE = (int*)(ws + WS_BLKE);
    LAS int* pst = (LAS int*)c.lds;
    const int tid = c.tid, lane = c.lane;
    if (tid < NE) pst[64 + tid] = (int)gcnt[tid];
    __syncthreads();
    if (tid == 0) { int acc = 0; for (int e = 0; e < NE; ++e) { pst[e] = acc; acc += (pst[64 + e] + 255) / 256 * 256; } pst[32] = acc; }
    __syncthreads();
    if (blockIdx.x == 0) {
        const int nblk = pst[32] / 256;
        for (int i = tid; i < nblk; i += 512) { int e = 0;
#pragma unroll 1
            for (int q = 1; q < NE; ++q) if (i * 256 >= pst[q]) e = q;
            BLKE[i] = e; }
        if (tid == 0) BLKE[1024] = nblk;
    }
    const int rlo = layer ? TC : 0;
    int* ROWTAB = BLKE + 2048;
    for (int i = rlo + c.vcu * 512 + tid; i < NROW; i += c.G * 512) {
#pragma unroll
        for (int k = 0; k < 2; ++k) { const int e = RTE[(size_t)i * 2 + k], slot = pst[e] + RTP[(size_t)i * 2 + k]; DEST[(size_t)i * 2 + k] = slot; ROWTAB[slot] = i; } }
    for (int i = c.vcu * 512 + tid; i < NE * 256; i += c.G * 512) { const int e = i >> 8, pp = i & 255; const int cnt = pst[64 + e], pad = (cnt + 255) / 256 * 256;
        if (cnt + pp < pad) ROWTAB[pst[e] + cnt + pp] = rlo; }
    __syncthreads();
    LAS float* scr = (LAS float*)(c.lds + 4096 + c.wave * 16384);
    bf16_t* W13 = (bf16_t*)(ws + WS_RB);
    bf16_t* W2t = (bf16_t*)(ws + WS_RA + 146 * MiB);
    const float* w1 = a.in[I_W1] + (size_t)layer * NE * D * DEXP; const float* w3 = a.in[I_W3] + (size_t)layer * NE * D * DEXP; const float* w2 = a.in[I_W2] + (size_t)layer * NE * DEXP * D;
    constexpr int IT13 = 16 * 16, IT2 = 8 * 32;
    for (int it = c.gw; it < NE * (2 * IT13 + IT2); it += c.NGW) {
        const int e = it / (2 * IT13 + IT2); int r = it % (2 * IT13 + IT2);
        if (r < IT13) { transpose_item(w1 + (size_t)e * D * DEXP, DEXP, D, W13 + (size_t)e * D * D, 0, 1, 0, scr, r / 16, r % 16, lane); continue; } r -= IT13;
        if (r < IT13) { transpose_item(w3 + (size_t)e * D * DEXP, DEXP, D, W13 + (size_t)e * D * D, 0, 1, 1, scr, r / 16, r % 16, lane); continue; } r -= IT13;
        transpose_item(w2 + (size_t)e * DEXP * D, D, DEXP, W2t + (size_t)e * D * DEXP, 0, 0, 0, scr, r / 32, r % 32, lane);
    }
}

__device__ __forceinline__ void phase_mcomb(const Args& a, const Ctx& c0, int layer) {
    const Ctx c = fresh(c0);
    unsigned char* ws = a.ws;
    bf16_t* X = (bf16_t*)(ws + WS_X);
    const bf16_t* Y = (const bf16_t*)(ws + WS_RA);
    const int* DEST = (const int*)(ws + WS_RT + RT_DEST); const float* RTG = (const float*)(ws + WS_RT + RT_GATE);
    const float* mod = (const float*)(ws + WS_MOD) + (size_t)layer * 3 * 6144;
    const float* mod1 = (const float*)(ws + WS_MOD) + (size_t)1 * 3 * 6144;
    bf16_t* H = (bf16_t*)(ws + WS_HMF);
    const int lane = c.lane;
    const int rlo = layer ? TC : 0;
    u32x2 ya[4], yb[4], xr_[4]; float g0n = 0.f, g1n = 0.f;
#define MC_LOAD(R) do { const int d0_ = DEST[(size_t)(R) * 2], d1_ = DEST[(size_t)(R) * 2 + 1]; g0n = RTG[(size_t)(R) * 2]; g1n = RTG[(size_t)(R) * 2 + 1]; \
        const u32x2* y0_ = (const u32x2*)(Y + (size_t)d0_ * D) + lane; const u32x2* y1_ = (const u32x2*)(Y + (size_t)d1_ * D) + lane; const u32x2* x_ = (const u32x2*)(X + (size_t)(R) * D) + lane; \
        _Pragma("unroll") for (int j = 0; j < 4; ++j) { ya[j] = y0_[64 * j]; yb[j] = y1_[64 * j]; xr_[j] = x_[64 * j]; } } while (0)
    { const int r0 = rlo + c.gw; if (r0 < NROW) MC_LOAD(r0); }
    for (int row = rlo + c.gw; row < NROW; row += c.NGW) {
        const int bs = row_bsel(row);
        const float g0 = g0n, g1 = g1n;
        const f32x4* g2 = (const f32x4*)(mod + bs * 6144 + 5 * 1024) + lane;
        f32x4 v[4]; float s = 0.f;
#pragma unroll
        for (int j = 0; j < 4; ++j) { const u32x2 a0 = ya[j], a1 = yb[j];
            f32x4 y; y.x = g0 * bflo(a0.x) + g1 * bflo(a1.x); y.y = g0 * bfhi(a0.x) + g1 * bfhi(a1.x); y.z = g0 * bflo(a0.y) + g1 * bflo(a1.y); y.w = g0 * bfhi(a0.y) + g1 * bfhi(a1.y);
            v[j] = bf4_to_f32(xr_[j]) + g2[64 * j] * y; s += (v[j].x * v[j].x + v[j].y * v[j].y) + (v[j].z * v[j].z + v[j].w * v[j].w); }
        { const int nrow = row + c.NGW; if (nrow < NROW) MC_LOAD(nrow); }
        if (layer == 1) { f32x4* o = (f32x4*)(a.out + (size_t)(row - TC) * D) + lane;
#if A8_DEBUG
            { const float* ck = (const float*)(ws + WS_CTL) + CW_CHK; const float dd = fminf(100.f * ck[0] / fmaxf(ck[1], 1e-30f), 4.f) + (ck[1] > 0.f ? 0.002f : 0.f), sc_ = 1.f + sqrtf(0.01f + dd);
#pragma unroll
              for (int j = 0; j < 4; ++j) v[j] = v[j] * sc_; }
#endif
#pragma unroll
            for (int j = 0; j < 4; ++j) o[64 * j] = v[j]; }
        else { u32x2* o = (u32x2*)(X + (size_t)row * D) + lane;
#pragma unroll
            for (int j = 0; j < 4; ++j) o[64 * j] = f32_to_bf4(v[j]);
            const float rstd = rsqrtf(wave_sum(s) * (1.f / D) + EPS);
            const f32x4* gm = (const f32x4*)(a.in[I_GMIX] + D) + lane; const f32x4* sh = (const f32x4*)(mod1 + bs * 6144) + lane; const f32x4* sc = (const f32x4*)(mod1 + bs * 6144 + 1024) + lane;
#pragma unroll
            for (int j = 0; j < 4; ++j) v[j] = (v[j] * rstd) * gm[64 * j] * (sc[64 * j] + 1.0f) + sh[64 * j];
            store_row_bf16(H + (size_t)row * D, lane, v); }
    }
#undef MC_LOAD
}

__device__ __forceinline__ void phase_opost(const Args& a, const Ctx& c0) {
    const Ctx c = fresh(c0);
    unsigned char* ws = a.ws;
    const bf16_t* Z = (const bf16_t*)(ws + WS_RA);
    bf16_t* Qc = (bf16_t*)(ws + WS_RB);
    bf16_t* Kc = (bf16_t*)(ws + WS_RB + 32 * MiB);
    bf16_t* Vc = (bf16_t*)(ws + WS_RC);
    bf16_t* CQN = (bf16_t*)(ws + WS_RC + 33 * MiB);
    bf16_t* CKVN = (bf16_t*)(ws + WS_RC + 50 * MiB);
    bf16_t* KR = (bf16_t*)(ws + WS_RC + 59 * MiB);
    const int lane = c.lane;
    float gq[8], gk[8], gcq[8], gckv[8]; const float* rtab = (const float*)(ws + WS_ROPE64);
#pragma unroll
    for (int i = 0; i < 8; ++i) { gq[i] = a.in[I_OGQC][(lane & 7) * 8 + i]; gk[i] = a.in[I_OGKC][(lane & 7) * 8 + i]; gcq[i] = a.in[I_OGCQ][(lane & 31) * 8 + i]; gckv[i] = a.in[I_OGCKV][(lane & 15) * 8 + i]; }
    const float qscale = 0.125f * LOG2E;
    const bool f8 = fast8_c(a, lane), w16 = !f8;
    unsigned char* Q8 = ws + F8_CQ; unsigned char* K8 = ws + F8_CK;
    for (int row = c.gw; row < NROW; row += c.NGW) {
        const bool isctx = row < TC;
        const int b = isctx ? row / CTX : (row - TC) / SEQ, t = isctx ? row % CTX : (row - TC) % SEQ;
        const int pos = isctx ? t : CTX + t;
        const bf16_t* zr = Z + (size_t)row * NZO;
        Rope4 rp; if (!isctx) rp = rope64_angles(t, lane, rtab);
        float f[8];
        if (!isctx) { const u32x4 w = *(const u32x4*)(zr + 8 * lane); unpack8(w, f);
            const float rstd = rsqrtf(sum8(ssq8(f)) * (1.f / 64.f) + EPS);
#pragma unroll
            for (int i = 0; i < 8; ++i) f[i] = f[i] * rstd * gq[i];
            rope_apply8(f, rp);
#pragma unroll
            for (int i = 0; i < 8; ++i) f[i] *= qscale;
            if (f8) { unsigned char* r8 = Q8 + ((size_t)(b * 8 + (lane >> 3)) * SEQ + t) * 64; const int j8 = lane & 7;
              if constexpr (A8_QK6) { float g6[8]; _Pragma("unroll") for (int i = 0; i < 8; ++i) g6[i] = f[i] * 0.03125f; unsigned lo6, hi6; pk8_f6(g6, lo6, hi6); unsigned char* gp = r8 + (j8 >> 2) * 32; st6(gp, gp + 16, j8 & 3, lo6, hi6); }
              else *(u32x2*)(r8 + j8 * 8) = pk8_f8(f); }
            else *(u32x4*)(Qc + ((size_t)(b * 8 + (lane >> 3)) * SEQ + t) * 64 + (lane & 7) * 8) = pack8(f); }
        { const u32x4 w = *(const u32x4*)(zr + 512 + 8 * lane); unpack8(w, f);
            const float rstd = rsqrtf(sum8(ssq8(f)) * (1.f / 64.f) + EPS);
#pragma unroll
            for (int i = 0; i < 8; ++i) f[i] = f[i] * rstd * gk[i];
            if (!isctx) rope_apply8(f, rp);
            if (f8) { const int j8 = lane & 7; unsigned char* tb = K8 + ((size_t)((b * 8 + (lane >> 3)) * NTILE + (pos >> 6))) * 4096;
              if constexpr (A8_QK6) { float g6[8]; _Pragma("unroll") for (int i = 0; i < 8; ++i) g6[i] = f[i] * 0.0078125f; unsigned lo6, hi6; pk8_f6(g6, lo6, hi6); const int gg = j8 >> 2;
                st6(tb + att8::k_off<64>(pos & 63, 2 * gg), tb + att8::k_off<64>(pos & 63, 2 * gg + 1), j8 & 3, lo6, hi6); }
              else *(u32x2*)(tb + att8::k_off<64>(pos & 63, j8 >> 1) + (j8 & 1) * 8) = pk8_f8(f); }
            else *(u32x4*)(Kc + ((size_t)(b * 8 + (lane >> 3)) * SKV + pos) * 64 + (lane & 7) * 8) = pack8(f); }
        if (w16) { const u32x4 w = *(const u32x4*)(zr + 1024 + 8 * lane);
            *(u32x4*)(Vc + ((size_t)(b * 4 + (lane >> 4)) * SKV + pos) * 128 + (lane & 15) * 8) = w; }
        { const int sec = lane < 32 ? 0 : (lane < 48 ? 1 : (lane < 52 ? 2 : 3));
          const int col = sec == 0 ? 1536 + 8 * lane : (sec == 1 ? 1792 + 8 * (lane - 32) : (sec == 2 ? 1920 + 8 * (lane - 48) : 0));
          const u32x4 w = *(const u32x4*)(zr + col); unpack8(w, f);
          float sq = ssq8(f);
          float s0 = sec == 0 ? sq : 0.f, s1 = sec == 1 ? sq : 0.f;
          s0 = wave_sum(s0); s1 = wave_sum(s1);
          if (sec == 0) { const float rstd = rsqrtf(s0 * (1.f / 256.f) + EPS);
#pragma unroll
              for (int i = 0; i < 8; ++i) f[i] = f[i] * rstd * gcq[i];
              *(u32x4*)(CQN + (size_t)row * 256 + 8 * lane) = pack8(f); }
          else if (sec == 1) { const float rstd = rsqrtf(s1 * (1.f / 128.f) + EPS);
#pragma unroll
              for (int i = 0; i < 8; ++i) f[i] = f[i] * rstd * gckv[i];
              *(u32x4*)(CKVN + (size_t)row * 128 + 8 * (lane - 32)) = pack8(f); }
          else if (sec == 2) *(u32x4*)(KR + (size_t)row * 32 + 8 * (lane - 48)) = w; }
    }
    if (f8) vquant_items<128>(Z, NZO, 1024, 128, 4, ws + F8_CV, c.gw, c.NGW, lane);
}

__device__ __forceinline__ void phase_opost2(const Args& a, const Ctx& c0) {
    const Ctx c = fresh(c0);
    unsigned char* ws = a.ws;
    const bf16_t* QD = (const bf16_t*)(ws + WS_RA);
    const bf16_t* KV = (const bf16_t*)(ws + WS_RA + 33 * MiB);
    const bf16_t* KR = (const bf16_t*)(ws + WS_RC + 59 * MiB);
    bf16_t* Qd = (bf16_t*)(ws + WS_RA + 82 * MiB);
    bf16_t* Kd = (bf16_t*)(ws + WS_RA + 106 * MiB);
    bf16_t* Vd = (bf16_t*)(ws + WS_RA + 131 * MiB);
    const int lane = c.lane, head = lane >> 4, chunk = lane & 15;
    const bool act = chunk < 12;
    float gq[8], gk[8]; const float* dtab = (const float*)(ws + WS_ROPED);
#pragma unroll
    for (int i = 0; i < 8; ++i) { gq[i] = act ? a.in[I_OGQD][chunk * 8 + i] : 0.f; gk[i] = act ? a.in[I_OGKD][chunk * 8 + i] : 0.f; }
    const float qscale = 0.10206207261596575f * LOG2E;
    const bool f8 = fast8_d(a, lane), w16 = !f8 || A8_DEBUG == 3;
    unsigned char* Q8 = ws + F8_DQ; unsigned char* K8 = ws + F8_DK;
    for (int row = c.gw; row < NROW; row += c.NGW) {
        const bool isctx = row < TC;
        const int b = isctx ? row / CTX : (row - TC) / SEQ, t = isctx ? row % CTX : (row - TC) % SEQ;
        const int pos = isctx ? t : CTX + t;
        float cs[4], sn[4];
        if (!isctx && chunk >= 8 && act) { const int pp_ = (chunk < 10) ? (t / GRIDW) : (t % GRIDW), fi_ = (chunk & 1) * 4;
            const f32x4* tp = (const f32x4*)(dtab + (pp_ * 8 + fi_) * 2); const f32x4 ta = tp[0], tb = tp[1];
            cs[0] = ta.x; sn[0] = ta.y; cs[1] = ta.z; sn[1] = ta.w; cs[2] = tb.x; sn[2] = tb.y; cs[3] = tb.z; sn[3] = tb.w; }
        float f[8];
        if (!isctx) {
            if (act) { const u32x4 w = *(const u32x4*)(QD + (size_t)row * 512 + head * 96 + chunk * 8); unpack8(w, f); }
            else {
#pragma unroll
                for (int i = 0; i < 8; ++i) f[i] = 0.f; }
            const float rstd = rsqrtf(sum16(ssq8(f)) * (1.f / 96.f) + EPS);
            if (act) {
#pragma unroll
                for (int i = 0; i < 8; ++i) f[i] = f[i] * rstd * gq[i];
                if (chunk >= 8) {
#pragma unroll
                    for (int i = 0; i < 4; ++i) { const float x0 = f[2 * i], x1 = f[2 * i + 1]; f[2 * i] = x0 * cs[i] - x1 * sn[i]; f[2 * i + 1] = x0 * sn[i] + x1 * cs[i]; } }
#pragma unroll
                for (int i = 0; i < 8; ++i) f[i] *= qscale;
                if (w16) *(u32x4*)(Qd + ((size_t)(b * 4 + head) * SEQ + t) * 96 + chunk * 8) = pack8(f); }
            if (f8) { unsigned char* r8 = Q8 + ((size_t)(b * 4 + head) * SEQ + t) * 128;
              if constexpr (A8_QK6) { float g6[8]; _Pragma("unroll") for (int i = 0; i < 8; ++i) g6[i] = f[i] * 0.03125f; if (chunk == 12) g6[0] = -7.5f * 0.015625f;
                unsigned lo6, hi6; pk8_f6(g6, lo6, hi6); unsigned char* gp = r8 + (chunk >> 2) * 32; st6(gp, gp + 16, chunk & 3, lo6, hi6); }
              else { if (chunk == 12) f[0] = -8.f; *(u32x2*)(r8 + chunk * 8) = pk8_f8(f); } }
        }
        { if (act) { const u32x4 w = chunk < 8 ? *(const u32x4*)(KV + (size_t)row * 768 + head * 192 + chunk * 8) : *(const u32x4*)(KR + (size_t)row * 32 + (chunk - 8) * 8); unpack8(w, f); }
          else {
#pragma unroll
              for (int i = 0; i < 8; ++i) f[i] = 0.f; }
          const float rstd = rsqrtf(sum16(ssq8(f)) * (1.f / 96.f) + EPS);
          if (act) {
#pragma unroll
              for (int i = 0; i < 8; ++i) f[i] = f[i] * rstd * gk[i];
              if (!isctx && chunk >= 8) {
#pragma unroll
                  for (int i = 0; i < 4; ++i) { const float x0 = f[2 * i], x1 = f[2 * i + 1]; f[2 * i] = x0 * cs[i] - x1 * sn[i]; f[2 * i + 1] = x0 * sn[i] + x1 * cs[i]; } }
              if (w16) *(u32x4*)(Kd + ((size_t)(b * 4 + head) * SKV + pos) * 96 + chunk * 8) = pack8(f); }
          if (f8) { unsigned char* tb = K8 + ((size_t)((b * 4 + head) * NTILE + (pos >> 6))) * 8192;
              if constexpr (A8_QK6) { float g6[8]; _Pragma("unroll") for (int i = 0; i < 8; ++i) g6[i] = f[i] * 0.0078125f; if (chunk == 12) g6[0] = 1.f * 0.015625f;
                unsigned lo6, hi6; pk8_f6(g6, lo6, hi6); const int gg = chunk >> 2;
                st6(tb + att8::k_off<128>(pos & 63, 2 * gg), tb + att8::k_off<128>(pos & 63, 2 * gg + 1), chunk & 3, lo6, hi6); }
              else { if (chunk == 12) f[0] = 1.f; *(u32x2*)(tb + att8::k_off<128>(pos & 63, chunk >> 1) + (chunk & 1) * 8) = pk8_f8(f); } } }
        if (w16) { const u32x4 w = *(const u32x4*)(KV + (size_t)row * 768 + head * 192 + 64 + chunk * 8);
          *(u32x4*)(Vd + ((size_t)(b * 4 + head) * SKV + pos) * 128 + chunk * 8) = w; }
    }
    if (f8) vquant_items<128>(KV, 768, 64, 192, 4, ws + F8_DV, c.gw, c.NGW, lane);
}

__device__ __forceinline__ void phase_oattn(const Args& a, const Ctx& c0) {
    const Ctx c = fresh(c0);
    unsigned char* ws = a.ws;
    const bf16_t* Qc = (const bf16_t*)(ws + WS_RB);
    const bf16_t* Kc = (const bf16_t*)(ws + WS_RB + 32 * MiB);
    const bf16_t* Vc = (const bf16_t*)(ws + WS_RC);
    const bf16_t* Qd = (const bf16_t*)(ws + WS_RA + 82 * MiB);
    const bf16_t* Kd = (const bf16_t*)(ws + WS_RA + 106 * MiB);
    const bf16_t* Vd = (const bf16_t*)(ws + WS_RA + 131 * MiB);
    bf16_t* OC = (bf16_t*)(ws + WS_RA);
    bf16_t* MIX = (bf16_t*)(ws + WS_HMF);
    LAS char* lds = (LAS char*)c.lds;
    float gq = fabsf(a.in[I_OGQC][c.lane]), gk = fabsf(a.in[I_OGKC][c.lane]);
    gq = wave_max(gq); gk = wave_max(gk);
    const bool fast = (0.125f * LOG2E * 64.f * gq * gk) < 90.f;
#define OATT(FIXV) do { \
    for (int L = c.vcu; L < 1024; L += c.G) { const int bh = L / 64, qb = L % 64, b = bh / 8, hc = bh % 8; \
        att::attn_unit<64, 128, FIXV>(Qc + ((size_t)(b * 8 + hc) * SEQ + qb * 256) * 64, Kc + (size_t)(b * 8 + hc) * SKV * 64, Vc + (size_t)(b * 4 + (hc >> 1)) * SKV * 128, \
                                OC + (size_t)(b * SEQ + qb * 256) * D + hc * 128, D, SKV, lds, c.wave); } } while (0)
    if (fast8_c(a, c.lane)) {
        const float lam_init = 0.8f - 0.6f * expf(-0.3f);
        const float* lp = a.in[I_OLAM];
        const float d1 = wave_sum(lp[c.lane] * lp[64 + c.lane]), d2 = wave_sum(lp[128 + c.lane] * lp[192 + c.lane]);
        const float lam = expf(d1) - expf(d2) + lam_init;
        for (int P = c.vcu; P < 512; P += c.G) { const int b = P / 256, head = (P / 64) % 4, qb = P % 64;
            const unsigned char* v8 = ws + F8_CV + (size_t)(b * 4 + head) * NTILE * 8192; const size_t orow = (size_t)(b * SEQ + qb * 256);
            { const int hc = 2 * head;
              att8::attn_unit<64, 128, 0>(ws + F8_CQ + ((size_t)(b * 8 + hc) * SEQ + qb * 256) * 64, ws + F8_CK + (size_t)(b * 8 + hc) * NTILE * 4096, v8, OC + orow * D + hc * 128, D, NTILE, lds, c.wave); }
            { const int hc = 2 * head + 1;
              att8::attn_unit<64, 128, 1>(ws + F8_CQ + ((size_t)(b * 8 + hc) * SEQ + qb * 256) * 64, ws + F8_CK + (size_t)(b * 8 + hc) * NTILE * 4096, v8, MIX + (TC + orow) * D + head * 128, D, NTILE, lds, c.wave,
                                          OC + orow * D + (2 * head) * 128, D, lam, a.in[I_OGSUB], 1.f - lam_init); }
        }
    } else
    if (fast) {
        const float lam_init = 0.8f - 0.6f * expf(-0.3f);
        const float* lp = a.in[I_OLAM];
        const float d1 = wave_sum(lp[c.lane] * lp[64 + c.lane]), d2 = wave_sum(lp[128 + c.lane] * lp[192 + c.lane]);
        const float lam = expf(d1) - expf(d2) + lam_init;
        for (int P = c.vcu; P < 512; P += c.G) { const int b = P / 256, head = (P / 64) % 4, qb = P % 64;
            const size_t vofs = (size_t)(b * 4 + head) * SKV * 128; const size_t orow = (size_t)(b * SEQ + qb * 256);
            { const int hc = 2 * head;
              att64::attn_unit<8, true, 2>((const att64::bf16*)(Qc + ((size_t)(b * 8 + hc) * SEQ + qb * 256) * 64), 64, (const att64::bf16*)(Kc + (size_t)(b * 8 + hc) * SKV * 64), (const att64::bf16*)(Vc + vofs), 64, 128,
                                           (att64::bf16*)(OC + orow * D + hc * 128), D, SKV / 64, (char*)lds, c.wave); }
            { const int hc = 2 * head + 1;
              att64::attn_unit<8, true, 2, 64, 1>((const att64::bf16*)(Qc + ((size_t)(b * 8 + hc) * SEQ + qb * 256) * 64), 64, (const att64::bf16*)(Kc + (size_t)(b * 8 + hc) * SKV * 64), (const att64::bf16*)(Vc + vofs), 64, 128,
                                           (att64::bf16*)(MIX + (TC + orow) * D + head * 128), D, SKV / 64, (char*)lds, c.wave,
                                           (const att64::bf16*)(OC + orow * D + (2 * head) * 128), D, lam, a.in[I_OGSUB], 1.f - lam_init); }
        }
    } else OATT(false);
#undef OATT
    float gq2 = fmaxf(fabsf(a.in[I_OGQD][c.lane]), c.lane < 32 ? fabsf(a.in[I_OGQD][64 + c.lane]) : 0.f), gk2 = fmaxf(fabsf(a.in[I_OGKD][c.lane]), c.lane < 32 ? fabsf(a.in[I_OGKD][64 + c.lane]) : 0.f);
    gq2 = wave_max(gq2); gk2 = wave_max(gk2);
    const bool fast2 = (0.10206207261596575f * LOG2E * 96.f * gq2 * gk2) < 90.f;
#define MATT(FIXV) do { \
    for (int L = c.vcu; L < 512; L += c.G) { const int bh = L / 64, qb = L % 64, b = bh / 4, h = bh % 4; \
        att::attn_unit<96, 128, FIXV, FIXV>(Qd + ((size_t)(b * 4 + h) * SEQ + qb * 256) * 96, Kd + (size_t)(b * 4 + h) * SKV * 96, Vd + (size_t)(b * 4 + h) * SKV * 128, \
                                MIX + (size_t)(TC + b * SEQ + qb * 256) * D + 512 + h * 128, D, SKV, lds, c.wave); } } while (0)
    const bool f8d = fast8_d(a, c.lane);
#define MATT8(EPIV, CHK) do { \
    for (int L = c.vcu; L < 512; L += c.G) { const int bh = L / 64, qb = L % 64, b = bh / 4, h = bh % 4; \
        att8::attn_unit<128, 128, EPIV>(ws + F8_DQ + ((size_t)(b * 4 + h) * SEQ + qb * 256) * 128, ws + F8_DK + (size_t)(b * 4 + h) * NTILE * 8192, ws + F8_DV + (size_t)(b * 4 + h) * NTILE * 8192, \
                                        MIX + (size_t)(TC + b * SEQ + qb * 256) * D + 512 + h * 128, D, NTILE, lds, c.wave, nullptr, 0, 0.f, nullptr, 1.f, CHK); } } while (0)
#if A8_DEBUG != 3
    if (f8d) MATT8(0, nullptr); else
#endif
    if (fast2) {
        for (int L = c.vcu; L < 512; L += c.G) { const int bh = L / 64, qb = L % 64, b = bh / 4, h = bh % 4;
            att64::attn_unit<8, true, 2, 96>((const att64::bf16*)(Qd + ((size_t)(b * 4 + h) * SEQ + qb * 256) * 96), 96, (const att64::bf16*)(Kd + (size_t)(b * 4 + h) * SKV * 96), (const att64::bf16*)(Vd + (size_t)(b * 4 + h) * SKV * 128), 96, 128,
                                             (att64::bf16*)(MIX + (size_t)(TC + b * SEQ + qb * 256) * D + 512 + h * 128), D, SKV / 64, (char*)lds, c.wave); }
    } else MATT(false);
#if A8_DEBUG == 3
    if (f8d) { grid_sync(c); MATT8(2, (float*)(ws + WS_CTL) + CW_CHK); }
#endif
#undef MATT8
#undef MATT
}

__device__ __forceinline__ void phase_osub(const Args& a, const Ctx& c0) {
    const Ctx c = fresh(c0);
    unsigned char* ws = a.ws;
    const bf16_t* OC = (const bf16_t*)(ws + WS_RA);
    bf16_t* MIX = (bf16_t*)(ws + WS_HMF);
    const int lane = c.lane, head = lane >> 4, chunk = lane & 15;
    const float lam_init = 0.8f - 0.6f * expf(-0.3f);
    const float* lp = a.in[I_OLAM];
    const float d1 = wave_sum(lp[lane] * lp[64 + lane]), d2 = wave_sum(lp[128 + lane] * lp[192 + lane]);
    const float lam = expf(d1) - expf(d2) + lam_init;
    float gs[8];
#pragma unroll
    for (int i = 0; i < 8; ++i) gs[i] = a.in[I_OGSUB][chunk * 8 + i] * (1.f - lam_init);
    { float gqx = fabsf(a.in[I_OGQC][lane]), gkx = fabsf(a.in[I_OGKC][lane]); gqx = wave_max(gqx); gkx = wave_max(gkx);
      if ((0.125f * LOG2E * 64.f * gqx * gkx) < 90.f) return; }
    for (int r = c.gw; r < TL; r += c.NGW) {
        const u32x4 w1 = *(const u32x4*)(OC + (size_t)r * D + (2 * head) * 128 + chunk * 8), w2 = *(const u32x4*)(OC + (size_t)r * D + (2 * head + 1) * 128 + chunk * 8);
        float f1[8], f2[8]; unpack8(w1, f1); unpack8(w2, f2);
#pragma unroll
        for (int i = 0; i < 8; ++i) f1[i] = f1[i] - lam * f2[i];
        const float rstd = rsqrtf(sum16(ssq8(f1)) * (1.f / 128.f) + EPS);
#pragma unroll
        for (int i = 0; i < 8; ++i) f1[i] = f1[i] * rstd * gs[i];
        *(u32x4*)(MIX + (size_t)(TC + r) * D + head * 128 + chunk * 8) = pack8(f1);
    }
}

#define IN(k) (LO <= (k) && (k) < HI)
#define LOADA() const Args args = load_args(); unsigned char* ws = args.ws; bf16_t* wsm = (bf16_t*)(ws + WS_WSM); const float* MOD = (const float*)(ws + WS_MOD); (void)ws; (void)wsm; (void)MOD
#ifndef PROBE_MASK
#define PROBE_MASK 0ull
#endif
#define NREP(k) (((PROBE_MASK >> (k)) & 1ull) ? 2 : 1)
#define REPB(k) for (int rep_ = 0; rep_ < NREP(k); ++rep_) {
#define REPE }
#define SEAM(k) do { if constexpr (IN(k) && IN((k) + 1)) { extern __shared__ __attribute__((aligned(16))) unsigned char lds_dyn2_[]; XcdBarrier b_; b_.bar = (unsigned*)(load_args().ws + WS_CTL) + CW_BAR; b_.x = xb_xcc_id(); b_.st = (volatile LAS unsigned*)((LAS unsigned char*)lds_dyn2_ + MISC_OFF) + 8; xcd_barrier(b_, mk_tid(c.wave)); } } while (0)
template <int LO, int HI, int LAYER>
__device__ __forceinline__ void moe_program(const Ctx& c) {
    constexpr int pb = LAYER ? PH_M1NORM : PH_M0NORM;
    if constexpr (IN(pb)) { REPB(pb) LOADA(); phase_mnorm(args, c, LAYER, args.ph_lo); REPE } SEAM(pb);
    if constexpr (IN(pb + 1)) { REPB(pb + 1) LOADA(); phase_mgather(args, c, LAYER); REPE } SEAM(pb + 1);
    if constexpr (IN(pb + 2)) { REPB(pb + 2) LOADA();
        const int nblk = ((const int*)(ws + WS_BLKE))[1024];
        pg8::Gemm g{(const bf16_t*)(ws + WS_HMF), (const bf16_t*)(ws + WS_RB), 0, D, D};
        pg8::MoeOrder S{(const int*)(ws + WS_BLKE), nblk * 4, 4, c.G, (int)blockIdx.x, (size_t)D * D * 2};
        pg8::EpiSwiGLU E{(bf16_t*)(ws + WS_RC), DEXP};
        pg8::gemm_phase<pg8::EpiSwiGLU, pg8::MoeOrder, true, true>(c.lds, g, S, E, c.wave, (const int*)(ws + WS_BLKE) + 2048);
    REPE } SEAM(pb + 2);
    if constexpr (IN(pb + 3)) { REPB(pb + 3) LOADA();
        const int nblk = ((const int*)(ws + WS_BLKE))[1024];
        pg8::Gemm g{(const bf16_t*)(ws + WS_RC), (const bf16_t*)(ws + WS_RA + 146 * MiB), 0, D, DEXP};
        pg8::MoeOrder S{(const int*)(ws + WS_BLKE), nblk * 4, 4, c.G, (int)blockIdx.x, (size_t)D * DEXP * 2};
        pg8::EpiStoreBf16 E{(bf16_t*)(ws + WS_RA), D, 0};
        pg8::gemm_phase<pg8::EpiStoreBf16, pg8::MoeOrder>(c.lds, g, S, E, c.wave);
    REPE } SEAM(pb + 3);
    if constexpr (IN(pb + 4)) { REPB(pb + 4) LOADA(); phase_mcomb(args, c, LAYER); REPE } if constexpr (LAYER == 0) SEAM(pb + 4);
}

template <int LO, int HI>
__global__ void __launch_bounds__(512, 2) fwd_kernel(Args kargs) {
    extern __shared__ __attribute__((aligned(16))) unsigned char lds_raw[];
    Ctx c;
    c.lds = (LAS unsigned char*)lds_raw;
    c.tid = threadIdx.x; c.lane = c.tid & 63; c.wave = __builtin_amdgcn_readfirstlane(c.tid >> 6);
    c.G = gridDim.x; { const int bx = blockIdx.x; c.vcu = (c.G % 8 == 0) ? (bx % 8) * (c.G / 8) + bx / 8 : bx; }
    c.gw = c.vcu * 8 + c.wave; c.NGW = c.G * 8;
    { LAS unsigned long long* ap = (LAS unsigned long long*)(c.lds + ARGS_OFF);
      if (c.tid < 33) ap[c.tid] = (unsigned long long)kargs.in[c.tid];
      if (c.tid == 33) ap[33] = (unsigned long long)kargs.out;
      if (c.tid == 34) ap[34] = (unsigned long long)kargs.ws;
      if (c.tid == 35) ap[35] = ((unsigned long long)(unsigned)kargs.ph_hi << 32) | (unsigned)kargs.ph_lo; }
    if constexpr (HI - LO > 1) {
        volatile LAS unsigned* MISC = (volatile LAS unsigned*)(c.lds + MISC_OFF);
        if (c.tid < 16) MISC[c.tid] = 0u;
        __syncthreads();
        (void)xcd_barrier_post((unsigned*)(kargs.ws + WS_CTL) + CW_BAR, MISC + 8, c.tid);
    }
    __syncthreads();
    XcdBarrier bar; bar.bar = nullptr; bar.x = 0; bar.st = nullptr;
#define LOADA() const Args args = load_args(); unsigned char* ws = args.ws; bf16_t* wsm = (bf16_t*)(ws + WS_WSM); const float* MOD = (const float*)(ws + WS_MOD); (void)ws; (void)wsm; (void)MOD
    if constexpr (IN(PH_PRO)) { REPB(PH_PRO) LOADA(); phase_pro(args, c); REPE } SEAM(PH_PRO);
    if constexpr (IN(PH_ENORM)) { REPB(PH_ENORM) LOADA(); phase_enorm(args, c); REPE } SEAM(PH_ENORM);
    if constexpr (IN(PH_EINPROJ)) { REPB(PH_EINPROJ) LOADA();
        pg8::Gemm g{(const bf16_t*)(ws + WS_HMF), wsm + WO_WINE / 2, NROW, NZE, D}; pg8::StaticOrder S; S.init(NROW, NZE, c.G, (int)blockIdx.x);
        pg8::EpiStoreBf16 E{(bf16_t*)(ws + WS_RA), NZE, 0};
        pg8::gemm_phase<pg8::EpiStoreBf16, pg8::StaticOrder>(c.lds, g, S, E, c.wave);
    REPE } SEAM(PH_EINPROJ);
    if constexpr (IN(PH_EPOST)) { REPB(PH_EPOST) LOADA(); phase_epost(args, c); REPE } SEAM(PH_EPOST);
    if constexpr (IN(PH_EATTN)) { REPB(PH_EATTN) LOADA(); phase_eattn(args, c); REPE } SEAM(PH_EATTN);
    if constexpr (IN(PH_MLA)) { REPB(PH_MLA) LOADA(); phase_mla(args, c); REPE } SEAM(PH_MLA);
    if constexpr (IN(PH_MLB)) { REPB(PH_MLB) LOADA(); phase_mlb(args, c); REPE } SEAM(PH_MLB);
    if constexpr (IN(PH_MLC)) { REPB(PH_MLC) LOADA(); phase_mlc(args, c); REPE } SEAM(PH_MLC);
    if constexpr (IN(PH_EOUT)) { REPB(PH_EOUT) LOADA();
        pg8::Gemm g{(const bf16_t*)(ws + WS_HMF) + (size_t)TC * D, wsm + WO_WOUTE / 2, TL, D, D}; pg8::StaticOrder S; S.init(TL, D, c.G, (int)blockIdx.x);
        pg8::EpiResid E{args.in[I_X], args.in[I_CTX], (bf16_t*)(ws + WS_X), MOD + 2 * 1024, TC, 0};
        pg8::gemm_phase<pg8::EpiResid, pg8::StaticOrder>(c.lds, g, S, E, c.wave);
        { const float* xc = args.in[I_CTX]; bf16_t* Xb = (bf16_t*)(ws + WS_X); const float* gc = MOD + 2 * 1024 + 2 * 6144;
          auto epi = [=](int row, int col, const f32x4 v) { const f32x4 xv = *(const f32x4*)(xc + (size_t)row * D + col), gv = *(const f32x4*)(gc + col); *(u32x2*)(Xb + (size_t)row * D + col) = f32_to_bf4(xv + gv * v); };
          for (int u = c.vcu; u < (TC / 64) * (D / 32); u += c.G) ctx_tile_gemm<1>(c.lds, (const bf16_t*)(ws + WS_HMF), wsm + WO_WOUTE / 2, (u / (D / 32)) * 64, (u % (D / 32)) * 32, c.wave, epi); }
    REPE } SEAM(PH_EOUT);
    moe_program<LO, HI, 0>(c);
    if constexpr (IN(PH_OINPROJ)) { REPB(PH_OINPROJ) LOADA();
        pg8::Gemm g{(const bf16_t*)(ws + WS_HMF) + (size_t)TC * D, wsm + WO_WINO / 2, TL, NZO, D}; pg8::StaticOrder S; S.init(TL, NZO, c.G, (int)blockIdx.x);
        pg8::EpiStoreBf16 E{(bf16_t*)(ws + WS_RA), NZO, TC};
        pg8::gemm_phase<pg8::EpiStoreBf16, pg8::StaticOrder>(c.lds, g, S, E, c.wave);
        { bf16_t* Zb = (bf16_t*)(ws + WS_RA);
          auto epi = [=](int row, int col, const f32x4 v) { *(u32x2*)(Zb + (size_t)row * NZO + col) = f32_to_bf4(v); };
          for (int u = c.vcu; u < (TC / 64) * (NZO / 64); u += c.G) ctx_tile_gemm<2>(c.lds, (const bf16_t*)(ws + WS_HMF), wsm + WO_WINO / 2, (u / (NZO / 64)) * 64, (u % (NZO / 64)) * 64, c.wave, epi); }
    REPE } SEAM(PH_OINPROJ);
    if constexpr (IN(PH_OPOST)) { REPB(PH_OPOST) LOADA(); phase_opost(args, c); REPE } SEAM(PH_OPOST);
    if constexpr (IN(PH_OGEMM)) { REPB(PH_OGEMM) LOADA();
        { pg8::Gemm g{(const bf16_t*)(ws + WS_RC + 33 * MiB) + (size_t)TC * 256, wsm + WO_WUQ / 2, TL, 512, 256}; pg8::StaticOrder S; S.init(TL, 512, c.G, (int)blockIdx.x);
          pg8::EpiStoreBf16 E{(bf16_t*)(ws + WS_RA), 512, TC};
          pg8::gemm_phase<pg8::EpiStoreBf16, pg8::StaticOrder>(c.lds, g, S, E, c.wave); }
        { pg8::Gemm g{(const bf16_t*)(ws + WS_RC + 50 * MiB), wsm + WO_WUKV / 2, NROW, 768, 128}; pg8::StaticOrder S; S.init(NROW, 768, c.G, (int)blockIdx.x);
          pg8::EpiStoreBf16 E{(bf16_t*)(ws + WS_RA + 33 * MiB), 768, 0};
          pg8::gemm_phase<pg8::EpiStoreBf16, pg8::StaticOrder>(c.lds, g, S, E, c.wave); }
    REPE } SEAM(PH_OGEMM);
    if constexpr (IN(PH_OPOST2)) { REPB(PH_OPOST2) LOADA(); phase_opost2(args, c); REPE } SEAM(PH_OPOST2);
    if constexpr (IN(PH_OATTN)) { REPB(PH_OATTN) LOADA(); phase_oattn(args, c); REPE } SEAM(PH_OATTN);
    if constexpr (IN(PH_OSUB)) { REPB(PH_OSUB) LOADA(); phase_osub(args, c); REPE } SEAM(PH_OSUB);
    if constexpr (IN(PH_OOUT)) { REPB(PH_OOUT) LOADA();
        pg8::Gemm g{(const bf16_t*)(ws + WS_HMF) + (size_t)TC * D, wsm + WO_WOUTO / 2, TL, D, D}; pg8::StaticOrder S; S.init(TL, D, c.G, (int)blockIdx.x);
        pg8::EpiResid E{nullptr, nullptr, (bf16_t*)(ws + WS_X), MOD + 3 * 6144 + 2 * 1024, TC, 1};
        pg8::gemm_phase<pg8::EpiResid, pg8::StaticOrder>(c.lds, g, S, E, c.wave);
    REPE } SEAM(PH_OOUT);
    moe_program<LO, HI, 1>(c);
}
#undef IN
#undef SEAM

#ifndef HOST_DUP_MASK
#define HOST_DUP_MASK 0ull
#endif
template <int P> static void launch_phase(int grid, hipStream_t stream, const Args& a) {
    for (int rep = 0; rep < ((((unsigned long long)HOST_DUP_MASK >> P) & 1ull) ? 2 : 1); ++rep) {
        Args b = a; b.ph_lo = rep;
        hipLaunchKernelGGL((fwd_kernel<P, P + 1>), dim3(grid), dim3(512), LDS_BYTES, stream, b); }
}
template <int P> static void set_attr_phase() { (void)hipFuncSetAttribute((const void*)fwd_kernel<P, P + 1>, hipFuncAttributeMaxDynamicSharedMemorySize, LDS_BYTES); }
template <int... Ps> static void set_attr_all(std::integer_sequence<int, Ps...>) { (set_attr_phase<Ps>(), ...); }
template <int... Ps> static void launch_all(int grid, hipStream_t stream, const Args& a, std::integer_sequence<int, Ps...>) { (launch_phase<Ps>(grid, stream, a), ...); }

extern "C" void kernel_launch(void* const* d_in, const int* in_sizes, int n_in, void* d_out, int out_size, void* d_ws, size_t ws_size, hipStream_t stream) {
    static int grid = 0;
    if (grid == 0) {
        if (n_in != 33 || out_size != TL * D || ws_size < WS_NEED) { fprintf(stderr, "kernel_launch: unexpected shapes (n_in %d out %d ws %zu need %zu)\n", n_in, out_size, ws_size, (size_t)WS_NEED); grid = -1; return; }
        int dev = 0, cus = 0;
        if (hipGetDevice(&dev) != hipSuccess || hipDeviceGetAttribute(&cus, hipDeviceAttributeMultiprocessorCount, dev) != hipSuccess) { grid = -1; return; }
#if MK_ONE_LAUNCH
        if (hipFuncSetAttribute((const void*)fwd_kernel<0, NPH>, hipFuncAttributeMaxDynamicSharedMemorySize, LDS_BYTES) != hipSuccess) { fprintf(stderr, "kernel_launch: hipFuncSetAttribute failed\n"); grid = -1; return; }
#else
        set_attr_all(std::make_integer_sequence<int, NPH>{});
#endif
        (void)hipGetLastError();
        grid = cus;
    }
    if (grid < 0) return;
    (void)hipMemsetAsync((char*)d_ws + WS_CTL, 0, CTL_ZERO_BYTES, stream);
    Args a{};
    for (int i = 0; i < 33; ++i) a.in[i] = (const float*)d_in[i];
    a.out = (float*)d_out; a.ws = (unsigned char*)d_ws;
    a.ph_lo = 0; a.ph_hi = NPH;
#if MK_ONE_LAUNCH
    hipLaunchKernelGGL((fwd_kernel<0, NPH>), dim3(grid), dim3(512), LDS_BYTES, stream, a);
#else
    launch_all(grid, stream, a, std::make_integer_sequence<int, NPH>{});
#endif
}
```

```cpp
#include <hip/hip_runtime.h>
#include <hip/hip_bf16.h>
#include <cstdio>
#include <cstdint>
#include <cmath>
#include <utility>

#ifndef MK_ONE_LAUNCH
#define MK_ONE_LAUNCH 1
#endif

#define GAS __attribute__((address_space(1)))
#define LAS __attribute__((address_space(3)))
typedef unsigned short bf16_t;
typedef short bf16x8 __attribute__((ext_vector_type(8)));
typedef short s16x4 __attribute__((ext_vector_type(4)));
typedef float f32x4 __attribute__((ext_vector_type(4)));
typedef float f32x2 __attribute__((ext_vector_type(2)));
typedef float f32x16 __attribute__((ext_vector_type(16)));
typedef unsigned u32x4 __attribute__((ext_vector_type(4)));
typedef unsigned u32x2 __attribute__((ext_vector_type(2)));

constexpr int D = 1024, BATCH = 2, SEQ = 16384, CTX = 256, GRIDW = 64;
constexpr int TL = BATCH * SEQ, TC = BATCH * CTX, NROW = TL + TC;
constexpr int SKV = CTX + SEQ;
constexpr int NZE = 2816, NZO = 2048;
constexpr int IN_EVEN = 2832, IN_ODD = 1952;
constexpr int NE = 32, DEXP = 512;
constexpr int MOE_MAXBLK = 292, MOE_MAXROWS = MOE_MAXBLK * 256;
constexpr float EPS = 1e-6f;
constexpr float LOG2E = 1.4426950408889634f;
constexpr int NCHUNK = 130, NCHAIN = 16;

constexpr size_t MiB = 1u << 20;
constexpr size_t WS_CTL = 0, CTL_ZERO_BYTES = 128 * 1024;
constexpr size_t WS_MODP = 1 * MiB;
constexpr size_t WS_MOD = 3 * MiB;
constexpr size_t WS_G = 4 * MiB;
constexpr size_t WS_RT = 7 * MiB;
constexpr size_t WS_BLKE = 9 * MiB;
constexpr size_t WS_ML = 10 * MiB;
constexpr size_t WS_ROPE64 = WS_BLKE + 512 * 1024, WS_ROPED = WS_ROPE64 + 64 * 1024;
constexpr size_t WS_WSM = 12 * MiB;
constexpr size_t WS_X = 26 * MiB;
constexpr size_t WS_HMF = 156 * MiB;
constexpr size_t WS_RA = 221 * MiB;
constexpr size_t WS_RB = 400 * MiB;
constexpr size_t WS_RC = 465 * MiB;
constexpr size_t WS_END = 538 * MiB;
#ifndef A8_ENABLE
#define A8_ENABLE 1
#endif
#ifndef A8_QK6
#define A8_QK6 1
#endif
#ifndef MN_MFMA
#define MN_MFMA 1
#endif
#ifndef A8_DEBUG
#define A8_DEBUG 0
#endif
constexpr size_t WS_DBG = 538 * MiB;
constexpr int NTILE = SKV / 64;
constexpr size_t F8_E0 = A8_DEBUG == 1 ? WS_DBG : WS_X + 65 * MiB;
constexpr size_t F8_EQ = F8_E0, F8_EK = F8_E0 + 16 * MiB, F8_EV = F8_E0 + 21 * MiB, F8_EQC = F8_E0 + 26 * MiB;
constexpr size_t F8_CQ = WS_RB, F8_CK = WS_RB + 32 * MiB, F8_CV = WS_RB + 48 * MiB + 512 * 1024;
constexpr size_t F8_DQ = A8_DEBUG == 3 ? WS_DBG : WS_RA + 82 * MiB, F8_DK = A8_DEBUG == 3 ? WS_DBG + 16 * MiB : WS_RA + 106 * MiB, F8_DV = A8_DEBUG == 3 ? WS_DBG + 33 * MiB : WS_RC + 33 * MiB;
constexpr size_t WS_NEED = A8_DEBUG ? WS_DBG + 50 * MiB : WS_END;
constexpr int CW_CHK = 20000;
constexpr size_t WO_WINE = 0, WO_WINO = WO_WINE + (size_t)NZE * D * 2, WO_WOUTE = WO_WINO + (size_t)NZO * D * 2, WO_WOUTO = WO_WOUTE + (size_t)D * D * 2,
                 WO_WUQ = WO_WOUTO + (size_t)D * D * 2, WO_WUKV = WO_WUQ + (size_t)512 * 256 * 2, WO_END = WO_WUKV + (size_t)768 * 128 * 2;
static_assert(WO_END <= 14 * MiB, "small weights");
constexpr int CW_BAR = 4096;
constexpr int CW_CNT0 = 16384, CW_CNT1 = 16384 + 64;
constexpr size_t RT_E = 0, RT_POS = (size_t)NROW * 2 * 4, RT_GATE = 2 * RT_POS, RT_DEST = 3 * RT_POS;
constexpr size_t ML_BL = 0, ML_ML = 16384, ML_MS = 32768, ML_NL = 65536;

constexpr int LDS_BYTES = 163840;
constexpr int MISC_OFF = LDS_BYTES - 1024;
constexpr int ARGS_OFF = MISC_OFF + 256;

__device__ __forceinline__ unsigned f2bf(float f) { unsigned u = __builtin_bit_cast(unsigned, f); return (u + 0x7fffu + ((u >> 16) & 1u)) >> 16; }
typedef __bf16 bf16x2_t __attribute__((ext_vector_type(2)));
__device__ __forceinline__ unsigned pk2(float lo, float hi) { f32x2 v = {lo, hi}; bf16x2_t b = __builtin_convertvector(v, bf16x2_t); return __builtin_bit_cast(unsigned, b); }
__device__ __forceinline__ float bf2f(unsigned short b) { return __builtin_bit_cast(float, (unsigned)b << 16); }
__device__ __forceinline__ float bflo(unsigned w) { return __builtin_bit_cast(float, w << 16); }
__device__ __forceinline__ float bfhi(unsigned w) { return __builtin_bit_cast(float, w & 0xffff0000u); }
__device__ __forceinline__ unsigned cvt_pk_bf16(float lo, float hi) { unsigned r; asm volatile("v_cvt_pk_bf16_f32 %0, %1, %2" : "=v"(r) : "v"(lo), "v"(hi)); return r; }
template <int O> __device__ __forceinline__ float xshfl(float v) {
#ifdef TEST_HIP_XSHFL
    return __shfl_xor(v, O);
#endif
    if constexpr (O < 32) return __builtin_bit_cast(float, __builtin_amdgcn_ds_swizzle(__builtin_bit_cast(int, v), (O << 10) | 0x1f));
    else { auto rr = __builtin_amdgcn_permlane32_swap(__float_as_uint(v), __float_as_uint(v), false, false);
           unsigned ones = ~0u; const bool lo = __builtin_amdgcn_mbcnt_hi(ones, __builtin_amdgcn_mbcnt_lo(ones, 0u)) < 32u; return __uint_as_float(lo ? rr[1] : rr[0]); }
}
#define DPPX(v, ctrl) __builtin_bit_cast(float, __builtin_amdgcn_update_dpp(0, __builtin_bit_cast(int, (float)(v)), (ctrl), 0xf, 0xf, false))
__device__ __forceinline__ float dpp_x1(float v) { return DPPX(v, 0xB1); }
__device__ __forceinline__ float dpp_x2(float v) { return DPPX(v, 0x4E); }
__device__ __forceinline__ float dpp_x7(float v) { return DPPX(v, 0x141); }
__device__ __forceinline__ float dpp_x15(float v) { return DPPX(v, 0x140); }
__device__ __forceinline__ float xsum32(float v) { auto rr = __builtin_amdgcn_permlane32_swap(__float_as_uint(v), __float_as_uint(v), false, false); return __uint_as_float(rr[0]) + __uint_as_float(rr[1]); }
__device__ __forceinline__ float xmax32(float v) { auto rr = __builtin_amdgcn_permlane32_swap(__float_as_uint(v), __float_as_uint(v), false, false); return fmaxf(__uint_as_float(rr[0]), __uint_as_float(rr[1])); }
__device__ __forceinline__ float wave_sum(float v) {
    v += dpp_x1(v); v += dpp_x2(v); v += dpp_x7(v); v += dpp_x15(v); v += xshfl<16>(v); return xsum32(v);
}
__device__ __forceinline__ float wave_max(float v) {
    v = fmaxf(v, dpp_x1(v)); v = fmaxf(v, dpp_x2(v)); v = fmaxf(v, dpp_x7(v)); v = fmaxf(v, dpp_x15(v)); v = fmaxf(v, xshfl<16>(v)); return xmax32(v);
}
__device__ __forceinline__ float rdlane(float v, int l) { return __builtin_bit_cast(float, __builtin_amdgcn_readlane(__builtin_bit_cast(int, v), l)); }
#define DPPF(oldv, v, ctrl, rm) __builtin_bit_cast(float, __builtin_amdgcn_update_dpp(__builtin_bit_cast(int, (float)(oldv)), __builtin_bit_cast(int, (float)(v)), (ctrl), (rm), 0xf, false))
__device__ __forceinline__ float siluf(float x) { return x * __builtin_amdgcn_rcpf(1.f + __expf(-x)); }
__device__ __forceinline__ float sigmoidf_(float x) { return __builtin_amdgcn_rcpf(1.f + __expf(-x)); }
__device__ __forceinline__ float logsigmoidf_(float x) { return fminf(x, 0.f) - log1pf(__expf(-fabsf(x))); }
#define LDS_WAIT() asm volatile("s_waitcnt lgkmcnt(0)" ::: "memory")
#define VM_WAIT() asm volatile("s_waitcnt vmcnt(0)" ::: "memory")
__device__ __forceinline__ void unpack8(const u32x4 w, float* f) {
    f[0] = bflo(w.x); f[1] = bfhi(w.x); f[2] = bflo(w.y); f[3] = bfhi(w.y); f[4] = bflo(w.z); f[5] = bfhi(w.z); f[6] = bflo(w.w); f[7] = bfhi(w.w);
}
__device__ __forceinline__ u32x4 pack8(const float* f) { u32x4 w; w.x = pk2(f[0], f[1]); w.y = pk2(f[2], f[3]); w.z = pk2(f[4], f[5]); w.w = pk2(f[6], f[7]); return w; }

__device__ __forceinline__ f32x4 bf4_to_f32(const u32x2 w) { f32x4 r; r.x = bflo(w.x); r.y = bfhi(w.x); r.z = bflo(w.y); r.w = bfhi(w.y); return r; }
__device__ __forceinline__ u32x2 f32_to_bf4(const f32x4 v) { u32x2 w; w.x = pk2(v.x, v.y); w.y = pk2(v.z, v.w); return w; }
__device__ __forceinline__ int mk_tid(int wave) {
    unsigned ones = ~0u; asm volatile("" : "+s"(ones), "+s"(wave));
    int tid = wave * 64 + (int)__builtin_amdgcn_mbcnt_hi(ones, __builtin_amdgcn_mbcnt_lo(ones, 0u));
    asm volatile("" : "+v"(tid));
    return tid;
}
#define XB_TMO      128
#define XB_XCNT(j)  (256  + 64 * (j))
#define XB_XSUB(j)  (1280 + 64 * (j))
#define XB_XGEN(j)  (2304 + 64 * (j))
#define XB_TOP      3328
#define XB_TOPGEN   3392
#define XCD_BAR_WORDS 3456
#define XB_SPIN_CAP (1u << 18)
__device__ __forceinline__ unsigned xb_ld(unsigned* p)              { return __hip_atomic_load(p, __ATOMIC_RELAXED, __HIP_MEMORY_SCOPE_AGENT); }
__device__ __forceinline__ unsigned xb_add(unsigned* p, unsigned v) { return __hip_atomic_fetch_add(p, v, __ATOMIC_RELAXED, __HIP_MEMORY_SCOPE_AGENT); }
__device__ __forceinline__ unsigned xb_xcc_id() { return (unsigned)__builtin_amdgcn_s_getreg((3 << 11) | 20) & 0xFu; }
#define XB_SPIN(cond, bar) do { unsigned _sp = 0; while (cond) { __builtin_amdgcn_s_sleep(1); \
    if ((++_sp & 255u) == 0u) { if (xb_ld(&(bar)[XB_TMO])) break; if (_sp > XB_SPIN_CAP) { atomicAdd(&(bar)[XB_TMO], 1u); break; } } } } while (0)
struct XcdBarrier { unsigned* bar; unsigned x; volatile LAS unsigned* st; };
__device__ __forceinline__ XcdBarrier xcd_barrier_post(unsigned* bar, volatile LAS unsigned* st, int tid0) {
    XcdBarrier b; b.bar = bar; b.x = xb_xcc_id(); b.st = st;
    if (tid0 == 0) (void)xb_add(&bar[XB_XCNT(b.x)], 1u);
    return b;
}
__device__ __forceinline__ void xcd_barrier_complete(unsigned* bar, unsigned x, unsigned& nloc, unsigned& nx) {
    const unsigned G = gridDim.x * gridDim.y * gridDim.z;
    unsigned sum, cnt, mine, sp = 0u;
    for (;;) {
        sum = 0u; cnt = 0u; mine = 0u;
#pragma unroll
        for (unsigned j = 0; j < 16; ++j) { const unsigned c = xb_ld(&bar[XB_XCNT(j)]); sum += c; cnt += (c > 0u) ? 1u : 0u; mine = (j == x) ? c : mine; }
        if (sum == G) break;
        __builtin_amdgcn_s_sleep(1);
        if ((++sp & 255u) == 0u) { if (xb_ld(&bar[XB_TMO])) break; if (sp > XB_SPIN_CAP) { atomicAdd(&bar[XB_TMO], 1u); break; } }
    }
    nloc = mine > 0u ? mine : 1u; nx = cnt > 0u ? cnt : 1u;
}
__device__ __forceinline__ void xcd_barrier(const XcdBarrier& b, int tid0) {
    asm volatile("s_waitcnt vmcnt(0)" ::: "memory");
    __syncthreads();
    if (tid0 == 0) {
        unsigned* bar = b.bar;
        __builtin_amdgcn_s_waitcnt(0);
        unsigned nloc = b.st[0], nx = b.st[1];
        if (nloc == 0u) { xcd_barrier_complete(bar, b.x, nloc, nx); b.st[0] = nloc; b.st[1] = nx; }
        const unsigned old = xb_add(&bar[XB_XSUB(b.x)], 1u);
        const unsigned gen = old / nloc;
        if (old + 1u == (gen + 1u) * nloc) {
            __builtin_amdgcn_fence(__ATOMIC_RELEASE, "agent");
            asm volatile("s_waitcnt vmcnt(0)" ::: "memory");
            const unsigned og = xb_add(&bar[XB_TOP], 1u);
            const unsigned tg = og / nx;
            if (og + 1u == (tg + 1u) * nx) xb_add(&bar[XB_TOPGEN], 1u);
            else XB_SPIN(xb_ld(&bar[XB_TOPGEN]) == tg, bar);
            __builtin_amdgcn_fence(__ATOMIC_ACQUIRE, "agent");
            xb_add(&bar[XB_XGEN(b.x)], 1u);
            asm volatile("s_waitcnt vmcnt(0)" ::: "memory");
        } else {
            XB_SPIN(xb_ld(&bar[XB_XGEN(b.x)]) == gen, bar);
            __builtin_amdgcn_fence(__ATOMIC_ACQUIRE, "agent");
            asm volatile("s_waitcnt vmcnt(0)" ::: "memory");
        }
    }
    __syncthreads();
}

namespace pg8 {
constexpr int BM = 256, BK = 64, HALF = 128, HTB = HALF * BK * 2, STAGE_BYTES = 8 * HTB, NXCD = 8, WGM = 8;
__host__ __device__ __forceinline__ int lds_byte(int r, int c) { const int st = (r >> 4) * 2 + (c >> 5), rr = r & 15, cc = c & 31, ob = rr * 64 + cc * 2; return st * 1024 + (ob ^ (((ob >> 9) & 1) << 5)); }
__host__ __device__ __forceinline__ void stage_rc(int b, int& R, int& C) { const int st = b / 1024, sb = b % 1024, swz = sb ^ (((sb >> 9) & 1) << 5); R = (st >> 1) * 16 + swz / 64; C = (st & 1) * 32 + (swz % 64) / 2; }
__host__ __device__ __forceinline__ int perm32(int rho) { const int n = rho >> 4, i = rho & 15; return 8 * (i >> 2) + 4 * n + (i & 3); }
struct Unit { int pm, pn; };
struct Gemm { const bf16_t* A; const bf16_t* Bt; int M, N, K; };
struct StaticOrder {
    int nM, nN, nwg, G, c;
    __device__ void init(int M, int N, int G_, int c_) { nM = M / BM; nN = N / BM; nwg = nM * nN; G = G_; c = c_; }
    __device__ bool next(int i, Unit& u) const {
        const long L = (long)i * G + c; if (L >= nwg) return false;
        int wgid = (int)L; { const int q = nwg / NXCD, r = nwg % NXCD, xcd = wgid % NXCD, off = wgid / NXCD; wgid = (xcd < r ? xcd * (q + 1) : r * (q + 1) + (xcd - r) * q) + off; }
        const int nig = WGM * nN, gid = wgid / nig, fm = gid * WGM, gsz = (nM - fm) < WGM ? (nM - fm) : WGM;
        u.pm = fm + ((wgid % nig) % gsz); u.pn = (wgid % nig) / gsz; return true;
    }
    __device__ __forceinline__ size_t b_off(const Unit&) const { return 0; }
};
struct MoeOrder {
    const int* blk_e; int nunits, nN, G, c; size_t estride;
    __device__ bool next(int i, Unit& u) const { const long L = (long)i * G + c; if (L >= nunits) return false; u.pm = (int)(L / nN); u.pn = (int)(L % nN); return true; }
    __device__ __forceinline__ size_t b_off(const Unit& u) const { return (size_t)blk_e[u.pm] * estride; }
};

struct EpiStoreBf16 {
    static constexpr bool PERM = true;
    bf16_t* O; int ldc; int row_off;
    __device__ __forceinline__ void operator()(const f32x4 (&acc)[2][2][4][2], const Unit& u, int wr, int wc, int fr, int fq) const {
        const int row0 = row_off + u.pm * BM + wr * 64 + fr, col0 = u.pn * BM + wc * 32 + 8 * fq;
#pragma unroll
        for (int ai = 0; ai < 2; ++ai)
#pragma unroll
            for (int m = 0; m < 4; ++m) { bf16_t* rowp = O + (size_t)(row0 + ai * HALF + m * 16) * ldc + col0;
#pragma unroll
                for (int bj = 0; bj < 2; ++bj) { const f32x4 v0 = acc[ai][bj][m][0], v1 = acc[ai][bj][m][1];
                    u32x4 w; w.x = cvt_pk_bf16(v0[0], v0[1]); w.y = cvt_pk_bf16(v0[2], v0[3]); w.z = cvt_pk_bf16(v1[0], v1[1]); w.w = cvt_pk_bf16(v1[2], v1[3]);
                    *(u32x4*)(rowp + bj * HALF) = w; } }
    }
};
struct EpiSwiGLU {
    static constexpr bool PERM = false;
    bf16_t* O; int ldc;
    __device__ __forceinline__ void operator()(const f32x4 (&acc)[2][2][4][2], const Unit& u, int wr, int wc, int fr, int fq) const {
        const int row0 = u.pm * BM + wr * 64 + fr, colh = (u.pn * BM + wc * 32) / 2 + 4 * fq;
#pragma unroll
        for (int ai = 0; ai < 2; ++ai)
#pragma unroll
            for (int m = 0; m < 4; ++m) { bf16_t* rowp = O + (size_t)(row0 + ai * HALF + m * 16) * ldc + colh;
#pragma unroll
                for (int bj = 0; bj < 2; ++bj) { const f32x4 a = acc[ai][bj][m][0], b = acc[ai][bj][m][1];
                    u32x2 w; w.x = cvt_pk_bf16(siluf(a[0]) * b[0], siluf(a[1]) * b[1]); w.y = cvt_pk_bf16(siluf(a[2]) * b[2], siluf(a[3]) * b[3]);
                    *(u32x2*)(rowp + bj * (HALF / 2)) = w; } }
    }
};
struct EpiResid {
    static constexpr bool PERM = false;
    const float* x_lat; const float* x_ctx; bf16_t* X; const float* gate;
    int row_off; int inplace;
    __device__ __forceinline__ void operator()(const f32x4 (&acc)[2][2][4][2], const Unit& u, int wr, int wc, int fr, int fq) const {
        const int row0 = row_off + u.pm * BM + wr * 64 + fr, col0 = u.pn * BM + wc * 32 + 4 * fq;
        static_assert(TC % BM == 0 && SEQ % BM == 0, "one batch selector per tile");
        const int rowt = row_off + u.pm * BM, bsel = rowt < TC ? 2 : (rowt - TC) / SEQ;
        const float* gp = gate + bsel * 6144;
        f32x4 gv[2][2];
#pragma unroll
        for (int bj = 0; bj < 2; ++bj)
#pragma unroll
            for (int n = 0; n < 2; ++n) gv[bj][n] = *(const f32x4*)(gp + col0 + bj * HALF + n * 16);
#pragma unroll
        for (int ai = 0; ai < 2; ++ai)
#pragma unroll
            for (int m = 0; m < 4; ++m) { const int row = row0 + ai * HALF + m * 16;
                const float* xin = row < TC ? x_ctx + (size_t)row * D : x_lat + (size_t)(row - TC) * D;
                f32x4 xv[2][2];
#pragma unroll
                for (int bj = 0; bj < 2; ++bj)
#pragma unroll
                    for (int n = 0; n < 2; ++n) { const int col = col0 + bj * HALF + n * 16;
                        xv[bj][n] = inplace ? bf4_to_f32(*(const u32x2*)(X + (size_t)row * D + col)) : *(const f32x4*)(xin + col); }
#pragma unroll
                for (int bj = 0; bj < 2; ++bj)
#pragma unroll
                    for (int n = 0; n < 2; ++n) { const int col = col0 + bj * HALF + n * 16;
                        *(u32x2*)(X + (size_t)row * D + col) = f32_to_bf4(xv[bj][n] + gv[bj][n] * acc[ai][bj][m][n]); } }
    }
};

template <class Epi, class Sched, bool ALIGN_EPI = true, bool GATHER = false>
__device__ __forceinline__ void gemm_phase(LAS unsigned char* lds, const Gemm g, const Sched& S, const Epi& E, int wv, const int* rowtab = nullptr) {
    const int tid = mk_tid(wv);
    const int wid = __builtin_amdgcn_readfirstlane(tid >> 6), lane = tid & 63, wr = wid >> 2, wc = wid & 3, fr = lane & 15, fq = lane >> 4;
    const int K = g.K, nt = K / BK;
    const size_t kstep = (size_t)(BK * 2);
    const size_t hstep = (size_t)HALF * K * 2;
    const size_t tstep = 2 * hstep;
    int RA_[2], CA_[2]; unsigned vA[2][2], nvA[2][2], voffB[2];
#pragma unroll
    for (int i = 0; i < 2; ++i) { int R, C; stage_rc(tid * 16 + i * 8192, R, C); const int Rb = Epi::PERM ? ((R & ~31) + perm32(R & 31)) : R;
        RA_[i] = R; CA_[i] = C; voffB[i] = (unsigned)(Rb * K + C) * 2u;
        vA[0][i] = (unsigned)(R * K + C) * 2u; vA[1][i] = vA[0][i] + (unsigned)hstep; nvA[0][i] = vA[0][i]; nvA[1][i] = vA[1][i]; }
#define PG8_GVOFF(V, u) do { if constexpr (GATHER) { _Pragma("unroll") for (int h_ = 0; h_ < 2; ++h_) _Pragma("unroll") for (int i_ = 0; i_ < 2; ++i_) \
        V[h_][i_] = (unsigned)(rowtab[(u).pm * BM + h_ * HALF + RA_[i_]] * K + CA_[i_]) * 2u; } } while (0)
    const unsigned ldsw = (unsigned)wid * 1024u;
    const int aoff = lds_byte(wr * 64 + fr, fq * 8), boff = lds_byte(wc * 32 + fr, fq * 8);
#define PG8_SA(b, h) (((b) * 2 + (h)) * HTB)
#define PG8_SB(b, h) ((4 + (b) * 2 + (h)) * HTB)
#define PG8_STAGE(bufoff, gbase, voff) do { _Pragma("unroll") for (int _i = 0; _i < 2; ++_i) \
        __builtin_amdgcn_global_load_lds((const unsigned*)((const char*)(gbase) + (voff)[_i]), (LAS unsigned*)(lds + (bufoff) + ldsw + _i * 8192), 16, 0, 0); } while (0)
#define PG8_STAGE_SEL(bufoff, gbase, sel, v1, v0) do { _Pragma("unroll") for (int _i = 0; _i < 2; ++_i) \
        __builtin_amdgcn_global_load_lds((const unsigned*)((const char*)(gbase) + ((sel) ? (v1)[_i] : (v0)[_i])), (LAS unsigned*)(lds + (bufoff) + ldsw + _i * 8192), 16, 0, 0); } while (0)
#define PG8_LDA(dst, b, h) do { _Pragma("unroll") for (int m = 0; m < 4; ++m) _Pragma("unroll") for (int k = 0; k < 2; ++k) dst[m][k] = *(const LAS bf16x8*)(lds + PG8_SA(b, h) + aoff + m * 2048 + k * 1024); } while (0)
#define PG8_LDB(dst, b, h) do { _Pragma("unroll") for (int n = 0; n < 2; ++n) _Pragma("unroll") for (int k = 0; k < 2; ++k) dst[n][k] = *(const LAS bf16x8*)(lds + PG8_SB(b, h) + boff + n * 2048 + k * 1024); } while (0)
#define PG8_MMA(ai, bj, At, Bt) do { __builtin_amdgcn_s_setprio(1); _Pragma("unroll") for (int m = 0; m < 4; ++m) _Pragma("unroll") for (int n = 0; n < 2; ++n) _Pragma("unroll") for (int k = 0; k < 2; ++k) \
        acc[ai][bj][m][n] = __builtin_amdgcn_mfma_f32_16x16x32_bf16(Bt[n][k], At[m][k], acc[ai][bj][m][n], 0, 0, 0); __builtin_amdgcn_s_setprio(0); } while (0)
#define PG8_WAIT_V(n) asm volatile("s_waitcnt vmcnt(" #n ")" ::: "memory")
#define PG8_WAIT_L(n) asm volatile("s_waitcnt lgkmcnt(" #n ")" ::: "memory")
#define PG8_BAR __builtin_amdgcn_s_barrier()
#define PG8_SCHED __builtin_amdgcn_sched_barrier(0)
    Unit cur, nxt; int ui = 0;
    if (!S.next(0, cur)) return;
    f32x4 acc[2][2][4][2];
#pragma unroll
    for (int a = 0; a < 2; ++a)
#pragma unroll
        for (int b = 0; b < 2; ++b)
#pragma unroll
            for (int m = 0; m < 4; ++m)
#pragma unroll
                for (int n = 0; n < 2; ++n) acc[a][b][m][n] = (f32x4){0.f, 0.f, 0.f, 0.f};
    bf16x8 At[4][2], B0[2][2], B1[2][2];
    const char* cA = (const char*)g.A + (GATHER ? (size_t)0 : (size_t)cur.pm * tstep); const char* cB = (const char*)g.Bt + S.b_off(cur) + (size_t)cur.pn * tstep;
    PG8_GVOFF(vA, cur);
    PG8_STAGE(PG8_SB(0, 0), cB, voffB); PG8_STAGE(PG8_SB(0, 1), cB + hstep, voffB); PG8_STAGE(PG8_SA(0, 0), cA, vA[0]); PG8_STAGE(PG8_SA(0, 1), cA, vA[1]);
    if (wr == 1) PG8_BAR;
    PG8_WAIT_V(2); PG8_BAR;
    PG8_STAGE(PG8_SB(1, 0), cB + kstep, voffB); PG8_STAGE(PG8_SA(1, 0), cA + kstep, vA[0]); PG8_STAGE(PG8_SB(1, 1), cB + hstep + kstep, voffB);
    PG8_WAIT_V(6); PG8_BAR;
    for (;;) {
        const bool has_next = S.next(ui + 1, nxt);
        const char* nA = has_next ? (const char*)g.A + (GATHER ? (size_t)0 : (size_t)nxt.pm * tstep) : cA; const char* nB = has_next ? (const char*)g.Bt + S.b_off(nxt) + (size_t)nxt.pn * tstep : cB;
        if constexpr (GATHER) { if (has_next) { PG8_GVOFF(nvA, nxt); } else {
#pragma unroll
            for (int h_ = 0; h_ < 2; ++h_)
#pragma unroll
                for (int i_ = 0; i_ < 2; ++i_) nvA[h_][i_] = vA[h_][i_]; } }
        for (int t = 0; t < nt; t += 2) {
            const bool last = (t == nt - 2);
            const char* a1 = cA + (size_t)(t + 1) * kstep;
            const char* a2 = last ? nA : cA + (size_t)(t + 2) * kstep; const char* b2 = last ? nB : cB + (size_t)(t + 2) * kstep;
            const char* a3 = a2 + kstep; const char* b3 = b2 + kstep;
            PG8_LDB(B0, 0, 0); PG8_LDB(B1, 0, 1); PG8_SCHED; PG8_LDA(At, 0, 0); PG8_STAGE(PG8_SA(1, 1), a1, vA[1]);
            PG8_WAIT_V(8); PG8_WAIT_L(0); PG8_BAR; PG8_MMA(0, 0, At, B0); PG8_MMA(0, 1, At, B1); PG8_BAR; PG8_SCHED;
            PG8_LDA(At, 0, 1); PG8_STAGE(PG8_SB(0, 0), b2, voffB); PG8_STAGE(PG8_SB(0, 1), b2 + hstep, voffB); PG8_STAGE_SEL(PG8_SA(0, 0), a2, last, nvA[0], vA[0]);
            PG8_WAIT_V(8); PG8_WAIT_L(0); PG8_BAR; PG8_MMA(1, 0, At, B0); PG8_MMA(1, 1, At, B1); PG8_BAR; PG8_SCHED;
            PG8_LDB(B0, 1, 0); PG8_LDB(B1, 1, 1); PG8_SCHED; PG8_LDA(At, 1, 0); PG8_STAGE_SEL(PG8_SA(0, 1), a2, last, nvA[1], vA[1]);
            PG8_WAIT_V(8); PG8_WAIT_L(0); PG8_BAR; PG8_MMA(0, 0, At, B0); PG8_MMA(0, 1, At, B1); PG8_BAR; PG8_SCHED;
            PG8_LDA(At, 1, 1); PG8_STAGE(PG8_SB(1, 0), b3, voffB); PG8_STAGE(PG8_SB(1, 1), b3 + hstep, voffB); PG8_STAGE_SEL(PG8_SA(1, 0), a3, last, nvA[0], vA[0]);
            PG8_WAIT_V(8); PG8_WAIT_L(0); PG8_BAR; PG8_MMA(1, 0, At, B0); PG8_MMA(1, 1, At, B1); PG8_BAR; PG8_SCHED;
        }
        if constexpr (ALIGN_EPI) { if (wr == 0) PG8_BAR; }
        E(acc, cur, wr, wc, fr, fq);
        if (!has_next) break;
#pragma unroll
        for (int a = 0; a < 2; ++a)
#pragma unroll
            for (int b = 0; b < 2; ++b)
#pragma unroll
                for (int m = 0; m < 4; ++m)
#pragma unroll
                    for (int n = 0; n < 2; ++n) acc[a][b][m][n] = (f32x4){0.f, 0.f, 0.f, 0.f};
        cur = nxt; cA = nA; cB = nB; ++ui;
        if constexpr (GATHER) {
#pragma unroll
            for (int h_ = 0; h_ < 2; ++h_)
#pragma unroll
                for (int i_ = 0; i_ < 2; ++i_) vA[h_][i_] = nvA[h_][i_]; }
        if constexpr (ALIGN_EPI) { if (wr == 1) PG8_BAR; }
    }
    PG8_WAIT_V(0);
    if constexpr (!ALIGN_EPI) { if (wr == 0) PG8_BAR; }
    PG8_BAR;
#undef PG8_GVOFF
#undef PG8_SA
#undef PG8_SB
#undef PG8_STAGE
#undef PG8_STAGE_SEL
#undef PG8_LDA
#undef PG8_LDB
#undef PG8_MMA
#undef PG8_WAIT_V
#undef PG8_WAIT_L
#undef PG8_BAR
#undef PG8_SCHED
}
}

template <int NB, class F>
__device__ __forceinline__ void ctx_tile_gemm(LAS unsigned char* lds, const bf16_t* __restrict__ A, const bf16_t* __restrict__ Bt, const int row0, const int col0, int wv, const F& epi) {
    const int tid = mk_tid(wv); const int lane = tid & 63, r32 = lane & 31, hi = lane >> 5; const int wid = __builtin_amdgcn_readfirstlane(tid >> 6);
    const bf16_t* ap = A + (size_t)(row0 + r32) * D + wid * 128 + 8 * hi;
    const bf16_t* bp = Bt + (size_t)(col0 + r32) * D + wid * 128 + 8 * hi;
    bf16x8 a0[8], a1[8], bb[NB][8];
#pragma unroll
    for (int ks = 0; ks < 8; ++ks) { a0[ks] = *(const bf16x8*)(ap + 16 * ks); a1[ks] = *(const bf16x8*)(ap + (size_t)32 * D + 16 * ks);
#pragma unroll
        for (int n = 0; n < NB; ++n) bb[n][ks] = *(const bf16x8*)(bp + (size_t)(32 * n) * D + 16 * ks); }
    f32x16 acc[2][NB];
#pragma unroll
    for (int m = 0; m < 2; ++m)
#pragma unroll
        for (int n = 0; n < NB; ++n) acc[m][n] = f32x16{};
#pragma unroll
    for (int ks = 0; ks < 8; ++ks)
#pragma unroll
        for (int n = 0; n < NB; ++n) { acc[0][n] = __builtin_amdgcn_mfma_f32_32x32x16_bf16(a0[ks], bb[n][ks], acc[0][n], 0, 0, 0); acc[1][n] = __builtin_amdgcn_mfma_f32_32x32x16_bf16(a1[ks], bb[n][ks], acc[1][n], 0, 0, 0); }
    constexpr int TW = 32 * NB;
    LAS float* part = (LAS float*)lds + wid * (64 * TW);
#pragma unroll
    for (int r = 0; r < 16; ++r) { const int row = (r & 3) + 8 * (r >> 2) + 4 * hi;
#pragma unroll
        for (int n = 0; n < NB; ++n) { part[row * TW + 32 * n + r32] = acc[0][n][r]; part[(32 + row) * TW + 32 * n + r32] = acc[1][n][r]; } }
    __syncthreads();
#pragma unroll
    for (int q = 0; q < NB; ++q) { const int o4 = tid + 512 * q;
      const LAS f32x4* p4 = (const LAS f32x4*)lds + o4;
      f32x4 v = p4[0];
#pragma unroll
      for (int w = 1; w < 8; ++w) v = v + p4[w * (16 * TW)];
      epi(row0 + o4 / (TW / 4), col0 + 4 * (o4 % (TW / 4)), v); }
    __syncthreads();
}

namespace att {
#define SBAR() __builtin_amdgcn_sched_barrier(0)
__device__ __forceinline__ int crow(int r, int hi) { return (r & 3) + 8 * (r >> 2) + 4 * hi; }
constexpr float THR = 8.f;
template <int DQK> struct KT {
    static constexpr int ROWB = (DQK == 64) ? 128 : 256;
    static constexpr int BYTES = 64 * ROWB;
    __device__ static __forceinline__ int swz(int row, int colB) { return row * ROWB + (colB ^ ((DQK == 64) ? (((row >> 1) & 7) << 4) : ((row & 15) << 4))); }
};
template <int DV> struct VT {
    static constexpr int NCB = DV / 32;
    static constexpr int BYTES = 64 * DV * 2;
    __device__ static __forceinline__ int v_st(int k, int c) { const int kk = (k & ~0xC) | ((k & 4) << 1) | ((k & 8) >> 1); return ((kk >> 3) * NCB + (c >> 5)) * 512 + ((kk & 7) * 32 + (c & 31)) * 2; }
    static constexpr int rd_off(int d0, int ks, int half) { return d0 * 512 + ks * (NCB * 1024) + half * (NCB * 512); }
};
__device__ __forceinline__ int v_rd_base(int lane) { return ((lane & 3) << 3) | (((lane >> 2) & 3) << 6) | (((lane >> 4) & 1) << 5) | (((lane >> 5) & 1) << 8); }
template <int OFF> __device__ __forceinline__ s16x4 tr_read(int vb) {
    s16x4 r; asm volatile("ds_read_b64_tr_b16 %0, %1 offset:%2" : "=&v"(r) : "v"(vb), "i"(OFF) : "memory"); return r;
}
__device__ __forceinline__ void partialSM(f32x16& p0, f32x16& p1, float& m_reg, float& alpha) {
    float pmax = p0[0];
#pragma unroll
    for (int r = 1; r < 16; ++r) pmax = fmaxf(pmax, p0[r]);
#pragma unroll
    for (int r = 0; r < 16; ++r) pmax = fmaxf(pmax, p1[r]);
    { auto rr = __builtin_amdgcn_permlane32_swap(__float_as_uint(pmax), __float_as_uint(pmax), false, false);
      pmax = fmaxf(__uint_as_float(rr[0]), __uint_as_float(rr[1])); }
    float mn;
    if (__builtin_expect(__all(pmax - m_reg <= THR), 1)) { mn = m_reg; alpha = 1.f; }
    else { mn = fmaxf(m_reg, pmax); alpha = __builtin_amdgcn_exp2f(m_reg - mn); m_reg = mn; }
#pragma unroll
    for (int r = 0; r < 16; ++r) p0[r] = p0[r] - mn;
#pragma unroll
    for (int r = 0; r < 16; ++r) p1[r] = p1[r] - mn;
#pragma unroll
    for (int r = 0; r < 16; ++r) p0[r] = __builtin_amdgcn_exp2f(p0[r]);
}
__device__ __forceinline__ void finishSM(f32x16& p0, f32x16& p1, float alpha, float& l_reg, bf16x8& pa0, bf16x8& pa1, bf16x8& pa2, bf16x8& pa3) {
#pragma unroll
    for (int r = 0; r < 16; ++r) p1[r] = __builtin_amdgcn_exp2f(p1[r]);
    float ps = 0;
#pragma unroll
    for (int r = 0; r < 16; ++r) ps += p0[r];
#pragma unroll
    for (int r = 0; r < 16; ++r) ps += p1[r];
    { auto rr = __builtin_amdgcn_permlane32_swap(__float_as_uint(ps), __float_as_uint(ps), false, false);
      ps = __uint_as_float(rr[0]) + __uint_as_float(rr[1]); }
    l_reg = l_reg * alpha + ps;
#define PK4(P, BASE, OUT) do { unsigned a0 = cvt_pk_bf16(P[BASE + 0], P[BASE + 1]), a1 = cvt_pk_bf16(P[BASE + 2], P[BASE + 3]);   \
    unsigned b0 = cvt_pk_bf16(P[BASE + 4], P[BASE + 5]), b1 = cvt_pk_bf16(P[BASE + 6], P[BASE + 7]);                              \
    auto r0 = __builtin_amdgcn_permlane32_swap(a0, b0, false, false); auto r1 = __builtin_amdgcn_permlane32_swap(a1, b1, false, false); \
    u32x4 w = {r0[0], r1[0], r0[1], r1[1]}; OUT = __builtin_bit_cast(bf16x8, w); } while (0)
    PK4(p0, 0, pa0); PK4(p0, 8, pa1); PK4(p1, 0, pa2); PK4(p1, 8, pa3);
#undef PK4
}

__device__ __forceinline__ unsigned cvtpk_v(float lo, float hi) { f32x2 v = {lo, hi}; bf16x2_t b = __builtin_convertvector(v, bf16x2_t); return __builtin_bit_cast(unsigned, b); }
#define PK4V(P, BASE, OUT) do { unsigned a0 = cvtpk_v(P[BASE + 0], P[BASE + 1]), a1 = cvtpk_v(P[BASE + 2], P[BASE + 3]);   \
    unsigned b0 = cvtpk_v(P[BASE + 4], P[BASE + 5]), b1 = cvtpk_v(P[BASE + 6], P[BASE + 7]);                              \
    auto r0 = __builtin_amdgcn_permlane32_swap(a0, b0, false, false); auto r1 = __builtin_amdgcn_permlane32_swap(a1, b1, false, false); \
    u32x4 w = {r0[0], r1[0], r0[1], r1[1]}; OUT = __builtin_bit_cast(bf16x8, w); } while (0)
__device__ __forceinline__ void partialSM_fix(f32x16& p0, float& l_reg, bf16x8& q0, bf16x8& q1) {
    float ps = 0.f;
#pragma unroll
    for (int r = 0; r < 16; ++r) { p0[r] = __builtin_amdgcn_exp2f(p0[r]); ps += p0[r]; }
    l_reg += ps;
    PK4V(p0, 0, q0); PK4V(p0, 8, q1);
}
__device__ __forceinline__ void finishSM_fix(f32x16& p1, float& l_reg, const bf16x8& q0, const bf16x8& q1, bf16x8& pa0, bf16x8& pa1, bf16x8& pa2, bf16x8& pa3) {
    float ps = 0.f;
#pragma unroll
    for (int r = 0; r < 16; ++r) { p1[r] = __builtin_amdgcn_exp2f(p1[r]); ps += p1[r]; }
    l_reg += ps;
    pa0 = q0; pa1 = q1; PK4V(p1, 0, pa2); PK4V(p1, 8, pa3);
}
template <int DQK> __device__ __forceinline__ void qkt(f32x16& p0, f32x16& p1, const LAS char* Ks, const bf16x8* qr, int r32, int hi) {
    p0 = f32x16{}; p1 = f32x16{};
#pragma unroll
    for (int d0 = 0; d0 < DQK / 16; ++d0) { const int cb = (d0 * 16 + hi * 8) * 2;
        const bf16x8 b0 = *(const LAS bf16x8*)(Ks + KT<DQK>::swz(r32, cb));
        const bf16x8 b1 = *(const LAS bf16x8*)(Ks + KT<DQK>::swz(32 + r32, cb));
        p0 = __builtin_amdgcn_mfma_f32_32x32x16_bf16(b0, qr[d0], p0, 0, 0, 0);
        p1 = __builtin_amdgcn_mfma_f32_32x32x16_bf16(b1, qr[d0], p1, 0, 0, 0);
        if constexpr (DQK == 96) { if (d0 == 1 || d0 == 3) SBAR(); } }
}
template <int DQK> __device__ __forceinline__ void qkt_q(f32x16& p0, f32x16& p1, const LAS char* Ks, const LAS char* Qs, int r32, int hi) {
    p0 = f32x16{}; p1 = f32x16{};
#pragma unroll
    for (int d0 = 0; d0 < DQK / 16; ++d0) { const int cb = (d0 * 16 + hi * 8) * 2;
        const bf16x8 b0 = *(const LAS bf16x8*)(Ks + KT<DQK>::swz(r32, cb));
        const bf16x8 b1 = *(const LAS bf16x8*)(Ks + KT<DQK>::swz(32 + r32, cb));
        const bf16x8 q = *(const LAS bf16x8*)(Qs + r32 * 208 + cb);
        p0 = __builtin_amdgcn_mfma_f32_32x32x16_bf16(b0, q, p0, 0, 0, 0);
        p1 = __builtin_amdgcn_mfma_f32_32x32x16_bf16(b1, q, p1, 0, 0, 0); }
}
template <int DV, int D0> __device__ __forceinline__ void pv_one(f32x16& od, int vb, bf16x8 pa0, bf16x8 pa1, bf16x8 pa2, bf16x8 pa3) {
    typedef VT<DV> V_;
    const s16x4 l0 = tr_read<V_::rd_off(D0, 0, 0)>(vb), h0 = tr_read<V_::rd_off(D0, 0, 1)>(vb), l1 = tr_read<V_::rd_off(D0, 1, 0)>(vb), h1 = tr_read<V_::rd_off(D0, 1, 1)>(vb);
    const s16x4 l2 = tr_read<V_::rd_off(D0, 2, 0)>(vb), h2 = tr_read<V_::rd_off(D0, 2, 1)>(vb), l3 = tr_read<V_::rd_off(D0, 3, 0)>(vb), h3 = tr_read<V_::rd_off(D0, 3, 1)>(vb);
    asm volatile("s_waitcnt lgkmcnt(0)" ::: "memory"); SBAR();
#define PK(L, H) (bf16x8){L[0], L[1], L[2], L[3], H[0], H[1], H[2], H[3]}
    od = __builtin_amdgcn_mfma_f32_32x32x16_bf16(pa0, PK(l0, h0), od, 0, 0, 0);
    od = __builtin_amdgcn_mfma_f32_32x32x16_bf16(pa1, PK(l1, h1), od, 0, 0, 0);
    od = __builtin_amdgcn_mfma_f32_32x32x16_bf16(pa2, PK(l2, h2), od, 0, 0, 0);
    od = __builtin_amdgcn_mfma_f32_32x32x16_bf16(pa3, PK(l3, h3), od, 0, 0, 0);
#undef PK
}
template <int DV> __device__ __forceinline__ void pv_all(f32x16* o, int vb, bf16x8 pa0, bf16x8 pa1, bf16x8 pa2, bf16x8 pa3) {
    pv_one<DV, 0>(o[0], vb, pa0, pa1, pa2, pa3); pv_one<DV, 1>(o[1], vb, pa0, pa1, pa2, pa3);
    if constexpr (DV == 128) { pv_one<DV, 2>(o[2], vb, pa0, pa1, pa2, pa3); pv_one<DV, 3>(o[3], vb, pa0, pa1, pa2, pa3); }
}
template <int DQK, int DV> constexpr int lds_bytes() { return 2 * VT<DV>::BYTES + 2 * KT<DQK>::BYTES + 8 * 64 * 4; }

template <int DQK, int DV, bool FIX = false, bool QLDS = false>
__device__ __forceinline__ void attn_unit(const bf16_t* __restrict__ Qb, const bf16_t* __restrict__ Kh, const bf16_t* __restrict__ Vh, bf16_t* __restrict__ Ob, int ldo, int seq, LAS char* lds, int wv) {
    typedef KT<DQK> K_; typedef VT<DV> V_;
    constexpr int NCB = V_::NCB, NQ = DQK / 16;
    constexpr int SHM_V = V_::BYTES, SHM_K = K_::BYTES;
    constexpr int NKC = (DQK == 64) ? 1 : 2, NVC = (DV == 64) ? 1 : 2;
    const int tid = mk_tid(wv);
    const int wid = tid >> 6, lane = tid & 63, r32 = lane & 31, hi = lane >> 5;
    LAS char* V_lds = lds; LAS char* K_lds = lds + 2 * SHM_V;
    LAS float* wsf = (LAS float*)(lds + 2 * SHM_V + 2 * SHM_K) + wid * 64; LAS float* li_l = wsf; LAS float* al_l = wsf + 32;
    float m_reg = -1e30f, l_reg = 0; f32x16 o[NCB]; bf16x8 qr[NQ];
#pragma unroll
    for (int d = 0; d < NCB; ++d) o[d] = f32x16{};
    const bf16_t* Qw = Qb + (long)(wid * 32 + r32) * DQK + hi * 8;
#pragma unroll
    for (int d0 = 0; d0 < NQ; ++d0) qr[d0] = *(const bf16x8*)(Qw + d0 * 16);
    LAS char* Qs = lds + lds_bytes<DQK, DV>() + wid * 6656;
    if constexpr (QLDS) {
#pragma unroll
        for (int d0 = 0; d0 < NQ; ++d0) *(LAS bf16x8*)(Qs + r32 * 208 + (d0 * 16 + hi * 8) * 2) = qr[d0];
    }
#define QKT(P0, P1, KB) do { if constexpr (QLDS) qkt_q<DQK>(P0, P1, KB, Qs, r32, hi); else qkt<DQK>(P0, P1, KB, qr, r32, hi); } while (0)
    int krow[NKC], kcol[NKC], vrow[NVC], vcol[NVC];
    if constexpr (DQK == 64) { krow[0] = tid >> 3; kcol[0] = (tid & 7) * 8; }
    else { const int c0 = tid, c1 = 512 + (tid & 255); krow[0] = c0 / 12; kcol[0] = (c0 % 12) * 8; krow[1] = c1 / 12; kcol[1] = (c1 % 12) * 8; }
    if constexpr (DV == 64) { vrow[0] = tid >> 3; vcol[0] = (tid & 7) * 8; }
    else { vrow[0] = tid >> 4; vcol[0] = (tid & 15) * 8; vrow[1] = 32 + (tid >> 4); vcol[1] = (tid & 15) * 8; }
    const int vb0 = (int)(uintptr_t)V_lds + v_rd_base(lane);
    bf16x8 ksE[NKC], vsE[NVC];
#define SLOAD(KS, VS, k0) do { _Pragma("unroll") for (int i_ = 0; i_ < NVC; ++i_) VS[i_] = *(const bf16x8*)(Vh + (long)((k0) + vrow[i_]) * DV + vcol[i_]); \
    _Pragma("unroll") for (int i_ = 0; i_ < NKC; ++i_) KS[i_] = *(const bf16x8*)(Kh + (long)((k0) + krow[i_]) * DQK + kcol[i_]); } while (0)
#define SWRITE(b, KS, VS) do { _Pragma("unroll") for (int i_ = 0; i_ < NVC; ++i_) *(LAS bf16x8*)(V_lds + (b) * SHM_V + V_::v_st(vrow[i_], vcol[i_])) = VS[i_]; \
    _Pragma("unroll") for (int i_ = 0; i_ < NKC; ++i_) *(LAS bf16x8*)(K_lds + (b) * SHM_K + K_::swz(krow[i_], kcol[i_] * 2)) = KS[i_]; } while (0)
#define RESC(a) do { if (__any((a) < 1.f)) { if (hi == 0) al_l[r32] = (a); asm volatile("s_waitcnt lgkmcnt(0)" ::: "memory"); \
    _Pragma("unroll") for (int d = 0; d < NCB; ++d) _Pragma("unroll") for (int r = 0; r < 16; ++r) o[d][r] *= al_l[crow(r, hi)]; } } while (0)
#define XSB() do { if constexpr (FIX && DQK == 96) SBAR(); } while (0)
    s16x4 fl0, fh0, fl1, fh1, fl2, fh2, fl3, fh3;
#define PVPRE(vb) do { if constexpr (FIX && DQK == 64) { fl0 = tr_read<V_::rd_off(0, 0, 0)>(vb); fh0 = tr_read<V_::rd_off(0, 0, 1)>(vb); fl1 = tr_read<V_::rd_off(0, 1, 0)>(vb); fh1 = tr_read<V_::rd_off(0, 1, 1)>(vb); \
        fl2 = tr_read<V_::rd_off(0, 2, 0)>(vb); fh2 = tr_read<V_::rd_off(0, 2, 1)>(vb); fl3 = tr_read<V_::rd_off(0, 3, 0)>(vb); fh3 = tr_read<V_::rd_off(0, 3, 1)>(vb); } } while (0)
#define PKF(L, H) (bf16x8){L[0], L[1], L[2], L[3], H[0], H[1], H[2], H[3]}
#define PVALL(vb) do { if constexpr (FIX && DQK == 64) { asm volatile("s_waitcnt lgkmcnt(0)" ::: "memory"); SBAR(); \
        o[0] = __builtin_amdgcn_mfma_f32_32x32x16_bf16(pa0, PKF(fl0, fh0), o[0], 0, 0, 0); o[0] = __builtin_amdgcn_mfma_f32_32x32x16_bf16(pa1, PKF(fl1, fh1), o[0], 0, 0, 0); \
        o[0] = __builtin_amdgcn_mfma_f32_32x32x16_bf16(pa2, PKF(fl2, fh2), o[0], 0, 0, 0); o[0] = __builtin_amdgcn_mfma_f32_32x32x16_bf16(pa3, PKF(fl3, fh3), o[0], 0, 0, 0); \
        pv_one<DV, 1>(o[1], vb, pa0, pa1, pa2, pa3); if constexpr (DV == 128) { pv_one<DV, 2>(o[2], vb, pa0, pa1, pa2, pa3); pv_one<DV, 3>(o[3], vb, pa0, pa1, pa2, pa3); } } \
      else pv_all<DV>(o, vb, pa0, pa1, pa2, pa3); } while (0)
    f32x16 pA0, pA1, pB0, pB1; float alA = 1.f, alB = 1.f; bf16x8 pa0, pa1, pa2, pa3, qA0, qA1, qB0, qB1; const int NT = seq / 64;
#define PSM(P0, P1, AL, Q0, Q1) do { if constexpr (FIX) partialSM_fix(P0, l_reg, Q0, Q1); else partialSM(P0, P1, m_reg, AL); } while (0)
#define FSM(P0, P1, AL, Q0, Q1) do { if constexpr (FIX) finishSM_fix(P1, l_reg, Q0, Q1, pa0, pa1, pa2, pa3); else finishSM(P0, P1, AL, l_reg, pa0, pa1, pa2, pa3); } while (0)
#define RSC(AL) do { if constexpr (!FIX) { RESC(AL); } } while (0)
    SLOAD(ksE, vsE, 0); SWRITE(0, ksE, vsE); __syncthreads();
    QKT(pA0, pA1, K_lds); PSM(pA0, pA1, alA, qA0, qA1);
    SLOAD(ksE, vsE, 64); SWRITE(1, ksE, vsE); if (2 < NT) SLOAD(ksE, vsE, 128);
    __syncthreads();
    for (int j = 1; j + 1 < NT; j += 2) {
        SBAR(); QKT(pB0, pB1, K_lds + SHM_K); XSB(); PVPRE(vb0);
        FSM(pA0, pA1, alA, qA0, qA1); SBAR();
        PVALL(vb0); XSB(); PSM(pB0, pB1, alB, qB0, qB1);
        __syncthreads(); SWRITE(0, ksE, vsE); SBAR();
        if (j + 2 < NT) SLOAD(ksE, vsE, (j + 2) * 64); SBAR();
        RSC(alB); __syncthreads();
        SBAR(); QKT(pA0, pA1, K_lds); XSB(); PVPRE(vb0 + SHM_V);
        FSM(pB0, pB1, alB, qB0, qB1); SBAR();
        PVALL(vb0 + SHM_V); XSB(); PSM(pA0, pA1, alA, qA0, qA1);
        __syncthreads(); SWRITE(1, ksE, vsE); SBAR();
        if (j + 3 < NT) SLOAD(ksE, vsE, (j + 3) * 64); SBAR();
        RSC(alA); __syncthreads();
    }
    SBAR(); QKT(pB0, pB1, K_lds + SHM_K); PVPRE(vb0);
    FSM(pA0, pA1, alA, qA0, qA1); SBAR();
    PVALL(vb0); PSM(pB0, pB1, alB, qB0, qB1);
    __syncthreads(); RSC(alB);
    PVPRE(vb0 + SHM_V);
    FSM(pB0, pB1, alB, qB0, qB1); SBAR();
    PVALL(vb0 + SHM_V);
    if constexpr (FIX) { auto rr = __builtin_amdgcn_permlane32_swap(__float_as_uint(l_reg), __float_as_uint(l_reg), false, false); l_reg = __uint_as_float(rr[0]) + __uint_as_float(rr[1]); }
#undef PSM
#undef PVPRE
#undef PVALL
#undef PKF
#undef XSB
#undef FSM
#undef RSC
    {
        const int tid2 = mk_tid(wv), wid2 = tid2 >> 6, lane2 = tid2 & 63, r32b = lane2 & 31, hib = lane2 >> 5;
        LAS float* li2 = (LAS float*)(lds + 2 * SHM_V + 2 * SHM_K) + wid2 * 64;
        if (hib == 0) li2[r32b] = l_reg; asm volatile("s_waitcnt lgkmcnt(0)" ::: "memory");
        float rli[16];
#pragma unroll
        for (int r = 0; r < 16; ++r) rli[r] = __builtin_amdgcn_rcpf(li2[crow(r, hib)]);
        bf16_t* Ow = Ob + (long)(wid2 * 32) * ldo;
#pragma unroll
        for (int r = 0; r < 16; ++r) { const int orow = crow(r, hib);
#pragma unroll
            for (int d0 = 0; d0 < NCB; ++d0) Ow[(long)orow * ldo + d0 * 32 + r32b] = (bf16_t)f2bf(o[d0][r] * rli[r]); }
    }
    __syncthreads();
#undef SLOAD
#undef QKT
#undef SWRITE
#undef RESC
}
#undef SBAR
}

namespace att64 {
using bf16=__hip_bfloat16;
using bf16x8=__attribute__((ext_vector_type(8)))short;
using s16x4=__attribute__((ext_vector_type(4)))short;
using f32x16=__attribute__((ext_vector_type(16)))float;
using u32x4=__attribute__((ext_vector_type(4)))unsigned;
constexpr int D=64;
constexpr int NW=8,QBLK=32,QB=QBLK*NW,KVBLK=64;
__device__ __forceinline__ int crow(int r,int hi){return (r&3)+8*(r>>2)+4*hi;}
#define SBAR() __builtin_amdgcn_sched_barrier(0)
__device__ __forceinline__ void cmask(f32x16&p0,f32x16&p1,int jb,int qrel,int hi){
  const float NEG=-INFINITY; int kb=64*jb+4*hi;
  #pragma unroll
  for(int r=0;r<16;++r){int kv=kb+(r&3)+8*(r>>2); if(kv>qrel)p0[r]=NEG; if(kv+32>qrel)p1[r]=NEG;}
}

constexpr int NSLOT=3, SLOTB=8192;
constexpr int LDS_K=0;
template<int DQ> constexpr int lds_v(){return NSLOT*(DQ/8)*1024;} template<int NVH,int DQ> constexpr int lds_ws(){return lds_v<DQ>()+NSLOT*SLOTB*NVH;} template<int NVH,int DQ> constexpr int lds_ost(){return lds_ws<NVH,DQ>()+NW*64*4;} template<int NVH,int DQ> constexpr int lds_bytes(){return lds_ost<NVH,DQ>()+NW*4096*NVH;}
constexpr float C2=0.125f*1.4426950408889634f;
__device__ __forceinline__ void glds16(const void*gsrc,unsigned lds_dst){unsigned keep;
  asm volatile("s_mov_b32 %0, m0\n\ts_mov_b32 m0, %2\n\ts_nop 0\n\tglobal_load_lds_dwordx4 %1, off\n\ts_mov_b32 m0, %0":"=&s"(keep):"v"(gsrc),"s"(lds_dst):"memory");}
__device__ __forceinline__ float max3f(float a,float b,float c){float r;asm("v_max3_f32 %0, %1, %2, %3":"=v"(r):"v"(a),"v"(b),"v"(c));return r;}
__device__ __forceinline__ float max2f(float a,float b){float r;asm("v_max_f32_e32 %0, %1, %2":"=v"(r):"v"(a),"v"(b));return r;}
__device__ __forceinline__ float fadd_s(float a,float b){float r;asm("v_add_f32_e32 %0, %1, %2":"=v"(r):"v"(a),"v"(b));return r;}
__device__ __forceinline__ float fsub_s(float a,float b){float r;asm("v_sub_f32_e32 %0, %1, %2":"=v"(r):"v"(a),"v"(b));return r;}
typedef float f32x2_t __attribute__((ext_vector_type(2))); typedef __bf16 bf16x2_t __attribute__((ext_vector_type(2)));
__device__ __forceinline__ unsigned cvtpk_s(float lo,float hi){f32x2_t v={lo,hi};bf16x2_t b=__builtin_convertvector(v,bf16x2_t);return __builtin_bit_cast(unsigned,b);}
#define WAIT_BAR(N) asm volatile("s_waitcnt vmcnt(" #N ") lgkmcnt(0)\n\ts_barrier":::"memory")
#define WAIT_N(n) do{ if constexpr((n)==0){WAIT_BAR(0);} else if constexpr((n)==1){WAIT_BAR(1);} else if constexpr((n)==2){WAIT_BAR(2);} else if constexpr((n)==3){WAIT_BAR(3);} else if constexpr((n)==4){WAIT_BAR(4);} else if constexpr((n)==5){WAIT_BAR(5);} else {WAIT_BAR(6);} }while(0)

template<int NQ> __device__ __forceinline__ void qkt(f32x16&p0,f32x16&p1,const char*Kslot,const bf16x8*qr,const f32x16&negm,int r32,int hi){
  const char*kb=Kslot+hi*1024+r32*16;
  #pragma unroll
  for(int d0=0;d0<NQ;++d0){
    const bf16x8 b0=*reinterpret_cast<const bf16x8*>(kb+d0*2048);
    const bf16x8 b1=*reinterpret_cast<const bf16x8*>(kb+d0*2048+512);
    if(d0==0){p0=__builtin_amdgcn_mfma_f32_32x32x16_bf16(b0,qr[0],negm,0,0,0);p1=__builtin_amdgcn_mfma_f32_32x32x16_bf16(b1,qr[0],negm,0,0,0);}
    else{p0=__builtin_amdgcn_mfma_f32_32x32x16_bf16(b0,qr[d0],p0,0,0,0);p1=__builtin_amdgcn_mfma_f32_32x32x16_bf16(b1,qr[d0],p1,0,0,0);}}
}
typedef __attribute__((address_space(3))) const char* lds_cptr;
typedef short v4i16_t __attribute__((ext_vector_type(4)));
__device__ __forceinline__ void kload8(bf16x8*kf,lds_cptr kp){
  kf[0]=*(const __attribute__((address_space(3))) bf16x8*)(kp);      kf[1]=*(const __attribute__((address_space(3))) bf16x8*)(kp+512);
  kf[2]=*(const __attribute__((address_space(3))) bf16x8*)(kp+2048); kf[3]=*(const __attribute__((address_space(3))) bf16x8*)(kp+2560);
  kf[4]=*(const __attribute__((address_space(3))) bf16x8*)(kp+4096); kf[5]=*(const __attribute__((address_space(3))) bf16x8*)(kp+4608);
  kf[6]=*(const __attribute__((address_space(3))) bf16x8*)(kp+6144); kf[7]=*(const __attribute__((address_space(3))) bf16x8*)(kp+6656);
}
__device__ __forceinline__ void kload2(bf16x8*kf,lds_cptr kp,int j){ kf[2*j]=*(const __attribute__((address_space(3))) bf16x8*)(kp+j*2048); kf[2*j+1]=*(const __attribute__((address_space(3))) bf16x8*)(kp+j*2048+512); }
template<int NQ> __device__ __forceinline__ void kloadn(bf16x8*kf,lds_cptr kp){
  #pragma unroll
  for(int j=0;j<NQ;++j)kload2(kf,kp,j);
}
__device__ __forceinline__ s16x4 vtr(lds_cptr p){ return __builtin_bit_cast(s16x4,__builtin_amdgcn_ds_read_tr16_b64_v4i16((__attribute__((address_space(3))) v4i16_t*)p)); }
__device__ __forceinline__ float rowmax(const f32x16&p0,const f32x16&p1){
  float a=max3f(p0[0],p0[1],p1[0]),b=max3f(p0[2],p0[3],p1[1]);a=max3f(a,p1[2],p1[3]);
  #pragma unroll
  for(int r=4;r<16;r+=4){a=max3f(a,p0[r],p0[r+1]);b=max3f(b,p0[r+2],p0[r+3]);a=max3f(a,p1[r],p1[r+1]);b=max3f(b,p1[r+2],p1[r+3]);}
  const float m=max2f(a,b);
  auto rr=__builtin_amdgcn_permlane32_swap(__float_as_uint(m),__float_as_uint(m),false,false);
  return max2f(__uint_as_float(rr[0]),__uint_as_float(rr[1]));
}
template<int NO> __device__ __forceinline__ void pv(f32x16*o,int vb,bf16x8 pa0,bf16x8 pa1,bf16x8 pa2,bf16x8 pa3){
  #pragma unroll
  for(int d0=0;d0<NO;++d0){s16x4 lo[4],hi[4];
    #pragma unroll
    for(int ks=0;ks<4;++ks){
      asm volatile("ds_read_b64_tr_b16 %0,%1 offset:%c2":"=&v"(lo[ks]):"v"(vb),"i"(d0*4096+ks*1024):"memory");
      asm volatile("ds_read_b64_tr_b16 %0,%1 offset:%c2":"=&v"(hi[ks]):"v"(vb),"i"(d0*4096+ks*1024+512):"memory");}
    asm volatile("s_waitcnt lgkmcnt(0)":::"memory");SBAR();
    #define PK(k) (bf16x8){lo[k][0],lo[k][1],lo[k][2],lo[k][3],hi[k][0],hi[k][1],hi[k][2],hi[k][3]}
    o[d0]=__builtin_amdgcn_mfma_f32_32x32x16_bf16(pa0,PK(0),o[d0],0,0,0);
    o[d0]=__builtin_amdgcn_mfma_f32_32x32x16_bf16(pa1,PK(1),o[d0],0,0,0);
    o[d0]=__builtin_amdgcn_mfma_f32_32x32x16_bf16(pa2,PK(2),o[d0],0,0,0);
    o[d0]=__builtin_amdgcn_mfma_f32_32x32x16_bf16(pa3,PK(3),o[d0],0,0,0);
    #undef PK
  }
}

#ifndef ATTN_STORE16
#define ATTN_STORE16(p,v) (*(u32x4*)(p)=(v))
#endif
template<int THRL,bool FIX=false,int NVH=1,int DQ=64,int EPI=0> __device__ __forceinline__ void attn_unit(const bf16*Qu,const int QP,const bf16*__restrict__ Kh,const bf16*__restrict__ Vh,const int KP,const int VP,bf16*Ou,const int OP,const int NT,char*shm,int wv,
    const bf16*O1=nullptr,const int OP1=0,const float lam=0.f,const float*gsub=nullptr,const float osc=1.f){
  static_assert(NVH==1||FIX,"the 128-wide V form exists only for the fixed-reference softmax");
  static_assert(DQ==64||(DQ==96&&NVH==2&&FIX),"96-wide q/k only in the fixed-reference 128-wide-V form");
  constexpr int NO=2*NVH, NQ=DQ/16, NKD=(DQ==64)?1:2, KSLOT=(DQ/8)*1024, LDS_V=lds_v<DQ>(), LDS_WS=lds_ws<NVH,DQ>(), LDS_OST=lds_ost<NVH,DQ>();
  const int tid=mk_tid(wv); const int lane=tid&63,r32=lane&31,hi=lane>>5; const int wid=__builtin_amdgcn_readfirstlane(tid>>6);
  const bf16*Qw=Qu+(long)(wid*QBLK)*QP;
  const unsigned lds0=(unsigned)(uintptr_t)shm;
  float*wsf=(float*)(shm+LDS_WS)+wid*64;
  const bf16*ksrc=Kh+(long)lane*KP+wid*8;
  const bf16*vsrc=Vh+(long)(16*(wid&3)+(lane>>2))*VP+(wid>>2)*32+(lane&3)*8;
  const unsigned kdst=lds0+LDS_K+wid*1024, vdst=lds0+LDS_V+wid*1024;
  #define KSL(sl) ((DQ==64)?(sl):((sl)+((sl)>>1)))
  #define DMA_K(t,slot) do{ glds16(ksrc+(long)(t)*KVBLK*KP,(unsigned)__builtin_amdgcn_readfirstlane(kdst+KSL(slot))); if constexpr(NKD==2) glds16(ksrc+(8+(wid&3)-wid)*8+(long)(t)*KVBLK*KP,(unsigned)__builtin_amdgcn_readfirstlane(kdst+KSL(slot)+(8+(wid&3)-wid)*1024)); }while(0)
  #define DMA_V(t,slot) do{ glds16(vsrc+(long)(t)*KVBLK*VP,(unsigned)__builtin_amdgcn_readfirstlane(vdst+(slot)*NVH)); if constexpr(NVH==2) glds16(vsrc+64+(long)(t)*KVBLK*VP,(unsigned)__builtin_amdgcn_readfirstlane(vdst+(slot)*NVH+8192)); }while(0)
  const int vb0=(int)(lds0+LDS_V)+((lane>>4)&1)*32+(lane&3)*8+(4*hi+((lane&15)>>2))*64;
  const char*Kbase=shm+LDS_K; bf16x8 kf[2*NQ];
  const lds_cptr shm3=(lds_cptr)shm; const lds_cptr kp0=shm3+LDS_K+hi*1024+r32*16; const lds_cptr vp0=shm3+LDS_V+((lane>>4)&1)*32+(lane&3)*8+(4*hi+((lane&15)>>2))*64;
  DMA_K(0,0);DMA_V(0,0);DMA_K(1,SLOTB);
  bf16x8 qr[NQ];
  #pragma unroll
  for(int d0=0;d0<NQ;++d0)qr[d0]=*reinterpret_cast<const bf16x8*>(&Qw[(long)r32*QP+d0*16+hi*8]);
  float mhat=0.f,l_reg=0.f;f32x16 o[NO];
  _Pragma("unroll") for(int d_=0;d_<NO;++d_)o[d_]=f32x16{};
  f32x16 negm=f32x16{}; if constexpr(!FIX){asm volatile("":"+v"(negm));}
  #define NEGM (FIX?f32x16{}:negm)
  const int qrel=wid*QBLK+r32;
  #define CMASK(P0,P1,t) do{}while(0)
  bool resc=false;
  #define START(P0,P1) do{ resc=false; if constexpr(!FIX){ const float rm=rowmax(P0,P1); \
    { const float dl=rm; mhat=fadd_s(mhat,dl); \
      _Pragma("unroll") for(int r=0;r<16;++r){P0[r]=fsub_s(P0[r],dl);P1[r]=fsub_s(P1[r],dl);} \
      _Pragma("unroll") for(int r=0;r<16;++r)negm[r]=-mhat; asm volatile("":"+v"(negm)); } } \
    _Pragma("unroll") for(int r=0;r<16;++r)P0[r]=__builtin_amdgcn_exp2f(P0[r]); }while(0)
  #define RESC() do{ if(resc){ asm volatile("s_waitcnt lgkmcnt(0)":::"memory"); \
      _Pragma("unroll") for(int d_=0;d_<NO;++d_) _Pragma("unroll") for(int r=0;r<16;++r)o[d_][r]*=wsf[crow(r,hi)]; } }while(0)
  f32x16 pA0,pA1,pB0,pB1;
  int sl_prev=0,sl_cur=0,sl_next=SLOTB;
  #define ROT() do{sl_prev=sl_cur;sl_cur=sl_next;sl_next=(sl_next==(NSLOT-1)*SLOTB)?0:sl_next+SLOTB;}while(0)
  DMA_K(2,2*SLOTB);
  WAIT_N(NVH+2*NKD);
  qkt<NQ>(pA0,pA1,Kbase,qr,NEGM,r32,hi);asm volatile("s_nop 15\n\ts_nop 7":"+v"(pA0),"+v"(pA1));CMASK(pA0,pA1,0);
  START(pA0,pA1);
  _Pragma("unroll") for(int r=0;r<16;++r)pA1[r]=__builtin_amdgcn_exp2f(pA1[r]);
  WAIT_BAR(0);
  DMA_K(3,0);DMA_V(1,SLOTB);
  ROT();
  kloadn<NQ>(kf,kp0+KSL(sl_cur));
  WAIT_N(NVH+NKD);
  s16x4 vlo[8],vhi[8]; u32x4 pw0,pw1,pw2,pw3;
  #define PKW(P,B) cvtpk_s(P[B],P[B+1])
  #define PAF(k) __builtin_bit_cast(bf16x8,pw##k)
  #define VFR(i) (bf16x8){vlo[i][0],vlo[i][1],vlo[i][2],vlo[i][3],vhi[i][0],vhi[i][1],vhi[i][2],vhi[i][3]}
  #define PIN(x) asm volatile("":"+v"(x))
  #define MX3(a,b,c) __builtin_fmaxf(__builtin_fmaxf((a),(b)),(c))
  #define GAPA(MF,A0,A1,A2,A3,W0,W1,PW) do{ MF; sacc+=A0; sacc+=A1; sacc+=A2; sacc+=A3; PIN(sacc); W0; W1; PIN(PW); SBAR(); }while(0)
  #define EX(v) __builtin_amdgcn_exp2f(v)
  #define GAPB(MF,X,B) do{ MF; X[B]=EX(X[B]); X[B+1]=EX(X[B+1]); X[B+2]=EX(X[B+2]); X[B+3]=EX(X[B+3]); PIN(X); SBAR(); }while(0)
  #define VRD(i) do{ vlo[i]=vtr(vp_+(((i)>>2)*4096+((i)&3)*1024)); vhi[i]=vtr(vp_+(((i)>>2)*4096+((i)&3)*1024+512)); }while(0)
  #define VRD2(i) do{ vlo[i]=vtr(vp_+(8192+((i)>>2)*4096+((i)&3)*1024)); vhi[i]=vtr(vp_+(8192+((i)>>2)*4096+((i)&3)*1024+512)); }while(0)
  #define GAPC(MF,RD,X,B) do{ MF; RD; X[B]=EX(X[B]); X[B+1]=EX(X[B+1]); PIN(X); SBAR(); }while(0)
  #define KRD(G,j) do{ if(G){ kload2(kf,kp0+KSL(sl_next),j); SBAR(); } }while(0)
  #define STEP(C0,C1,P0,P1,t,GK,GV,GL) do{ SBAR(); \
    const lds_cptr vp_=vp0+sl_prev*NVH; \
    VRD(0); SBAR(); float sacc=(P0[0]+P0[1]); \
    GAPA(C0=__builtin_amdgcn_mfma_f32_32x32x16_bf16(kf[0],qr[0],NEGM,0,0,0), P0[2],P0[3],P0[4],P0[5],     pw0[0]=PKW(P0,0), pw0[1]=PKW(P0,2), pw0); \
    VRD(4); SBAR(); GAPA(C1=__builtin_amdgcn_mfma_f32_32x32x16_bf16(kf[1],qr[0],NEGM,0,0,0), P0[6],P0[7],P0[8],P0[9],     pw0[2]=PKW(P0,4), pw0[3]=PKW(P0,6), pw0); \
    VRD(1); SBAR(); GAPA(C0=__builtin_amdgcn_mfma_f32_32x32x16_bf16(kf[2],qr[1],C0,0,0,0),   P0[10],P0[11],P0[12],P0[13], pw1[0]=PKW(P0,8), pw1[1]=PKW(P0,10), pw1); \
    VRD(5); SBAR(); GAPA(C1=__builtin_amdgcn_mfma_f32_32x32x16_bf16(kf[3],qr[1],C1,0,0,0),   P0[14],P0[15],P1[0],P1[1],   pw1[2]=PKW(P0,12),pw1[3]=PKW(P0,14), pw1); \
    VRD(2); SBAR(); GAPA(C0=__builtin_amdgcn_mfma_f32_32x32x16_bf16(kf[4],qr[2],C0,0,0,0),   P1[2],P1[3],P1[4],P1[5],     pw2[0]=PKW(P1,0), pw2[1]=PKW(P1,2), pw2); \
    VRD(6); SBAR(); GAPA(C1=__builtin_amdgcn_mfma_f32_32x32x16_bf16(kf[5],qr[2],C1,0,0,0),   P1[6],P1[7],P1[8],P1[9],     pw2[2]=PKW(P1,4), pw2[3]=PKW(P1,6), pw2); \
    VRD(3); SBAR(); GAPA(C0=__builtin_amdgcn_mfma_f32_32x32x16_bf16(kf[6],qr[3],C0,0,0,0),   P1[10],P1[11],P1[12],P1[13], pw3[0]=PKW(P1,8), pw3[1]=PKW(P1,10), pw3); \
    VRD(7); SBAR(); GAPA(C1=__builtin_amdgcn_mfma_f32_32x32x16_bf16(kf[7],qr[3],C1,0,0,0),   P1[14],P1[15],0.f,0.f,       pw3[2]=PKW(P1,12),pw3[3]=PKW(P1,14), pw3); \
    if constexpr(NQ==6){ C0=__builtin_amdgcn_mfma_f32_32x32x16_bf16(kf[8],qr[4],C0,0,0,0); C1=__builtin_amdgcn_mfma_f32_32x32x16_bf16(kf[9],qr[4],C1,0,0,0); C0=__builtin_amdgcn_mfma_f32_32x32x16_bf16(kf[10],qr[5],C0,0,0,0); C1=__builtin_amdgcn_mfma_f32_32x32x16_bf16(kf[11],qr[5],C1,0,0,0); SBAR(); } \
    l_reg+=sacc; \
    if(GK){DMA_K((t)+3,sl_cur);} if(GV){DMA_V((t)+1,sl_next);} \
    CMASK(C0,C1,t); \
        if constexpr(!FIX){ float a=MX3(C0[0],C0[1],C1[0]),b=MX3(C0[2],C0[3],C1[1]); a=MX3(a,C1[2],C1[3]); \
      _Pragma("unroll") for(int r=4;r<16;r+=4){a=MX3(a,C0[r],C0[r+1]);b=MX3(b,C0[r+2],C0[r+3]);a=MX3(a,C1[r],C1[r+1]);b=MX3(b,C1[r+2],C1[r+3]);} \
      float rm=__builtin_fmaxf(a,b); { auto rr=__builtin_amdgcn_permlane32_swap(__float_as_uint(rm),__float_as_uint(rm),false,false); rm=__builtin_fmaxf(__uint_as_float(rr[0]),__uint_as_float(rr[1])); } \
      resc=false; \
      if(__builtin_expect(__any(rm>(float)THRL),0)){ const float dl=__builtin_fmaxf(rm,0.f); mhat+=dl; \
        _Pragma("unroll") for(int r=0;r<16;++r){C0[r]-=dl;C1[r]-=dl;} \
        _Pragma("unroll") for(int r=0;r<16;++r)negm[r]=-mhat; asm volatile("":"+v"(negm)); \
        const float f=__builtin_amdgcn_exp2f(-dl); l_reg*=f; if(hi==0)wsf[r32]=f; resc=true; } } \
    SBAR(); \
    if constexpr(NVH==1){ \
    GAPB(o[0]=__builtin_amdgcn_mfma_f32_32x32x16_bf16(PAF(0),VFR(0),o[0],0,0,0), C0,0); \
    GAPB(o[1]=__builtin_amdgcn_mfma_f32_32x32x16_bf16(PAF(0),VFR(4),o[1],0,0,0), C0,4); \
    KRD(GL,0); GAPB(o[0]=__builtin_amdgcn_mfma_f32_32x32x16_bf16(PAF(1),VFR(1),o[0],0,0,0), C0,8); \
    KRD(GL,1); GAPB(o[1]=__builtin_amdgcn_mfma_f32_32x32x16_bf16(PAF(1),VFR(5),o[1],0,0,0), C0,12); \
    KRD(GL,2); GAPB(o[0]=__builtin_amdgcn_mfma_f32_32x32x16_bf16(PAF(2),VFR(2),o[0],0,0,0), C1,0); \
    KRD(GL,3); GAPB(o[1]=__builtin_amdgcn_mfma_f32_32x32x16_bf16(PAF(2),VFR(6),o[1],0,0,0), C1,4); \
    GAPB(o[0]=__builtin_amdgcn_mfma_f32_32x32x16_bf16(PAF(3),VFR(3),o[0],0,0,0), C1,8); \
    GAPB(o[1]=__builtin_amdgcn_mfma_f32_32x32x16_bf16(PAF(3),VFR(7),o[1],0,0,0), C1,12); \
    } else {   \
    GAPC(o[0]=__builtin_amdgcn_mfma_f32_32x32x16_bf16(PAF(0),VFR(0),o[0],0,0,0), VRD2(0), C0,0); \
    GAPC(o[1]=__builtin_amdgcn_mfma_f32_32x32x16_bf16(PAF(0),VFR(4),o[1],0,0,0), VRD2(4), C0,2); \
    KRD(GL,0); GAPC(o[0]=__builtin_amdgcn_mfma_f32_32x32x16_bf16(PAF(1),VFR(1),o[0],0,0,0), VRD2(1), C0,4); \
    KRD(GL,1); GAPC(o[1]=__builtin_amdgcn_mfma_f32_32x32x16_bf16(PAF(1),VFR(5),o[1],0,0,0), VRD2(5), C0,6); \
    KRD(GL,2); GAPC(o[0]=__builtin_amdgcn_mfma_f32_32x32x16_bf16(PAF(2),VFR(2),o[0],0,0,0), VRD2(2), C0,8); \
    KRD(GL,3); GAPC(o[1]=__builtin_amdgcn_mfma_f32_32x32x16_bf16(PAF(2),VFR(6),o[1],0,0,0), VRD2(6), C0,10); \
    if constexpr(NQ==6){KRD(GL,4);} GAPC(o[0]=__builtin_amdgcn_mfma_f32_32x32x16_bf16(PAF(3),VFR(3),o[0],0,0,0), VRD2(3), C0,12); \
    if constexpr(NQ==6){KRD(GL,5);} GAPC(o[1]=__builtin_amdgcn_mfma_f32_32x32x16_bf16(PAF(3),VFR(7),o[1],0,0,0), VRD2(7), C0,14); \
    GAPC(o[2]=__builtin_amdgcn_mfma_f32_32x32x16_bf16(PAF(0),VFR(0),o[2],0,0,0), (void)0, C1,0); \
    GAPC(o[3]=__builtin_amdgcn_mfma_f32_32x32x16_bf16(PAF(0),VFR(4),o[3],0,0,0), (void)0, C1,2); \
    GAPC(o[2]=__builtin_amdgcn_mfma_f32_32x32x16_bf16(PAF(1),VFR(1),o[2],0,0,0), (void)0, C1,4); \
    GAPC(o[3]=__builtin_amdgcn_mfma_f32_32x32x16_bf16(PAF(1),VFR(5),o[3],0,0,0), (void)0, C1,6); \
    GAPC(o[2]=__builtin_amdgcn_mfma_f32_32x32x16_bf16(PAF(2),VFR(2),o[2],0,0,0), (void)0, C1,8); \
    GAPC(o[3]=__builtin_amdgcn_mfma_f32_32x32x16_bf16(PAF(2),VFR(6),o[3],0,0,0), (void)0, C1,10); \
    GAPC(o[2]=__builtin_amdgcn_mfma_f32_32x32x16_bf16(PAF(3),VFR(3),o[2],0,0,0), (void)0, C1,12); \
    GAPC(o[3]=__builtin_amdgcn_mfma_f32_32x32x16_bf16(PAF(3),VFR(7),o[3],0,0,0), (void)0, C1,14); \
    } \
    }while(0)
  #define WAITS() WAIT_N(NVH+NKD)
  int t=1;
  #undef CMASK
  #define CMASK(P0,P1,t) do{}while(0)
  for(;t+5<NT;t+=2){
    STEP(pB0,pB1,pA0,pA1,t,true,true,true);     WAITS(); RESC(); ROT();
    STEP(pA0,pA1,pB0,pB1,t+1,true,true,true);   WAITS(); RESC(); ROT();
  }
  #undef CMASK
  #define CMASK(P0,P1,t) do{}while(0)
  #define ENDW(tt) do{ if((tt)+3<NT){WAITS();} else if((tt)+2<NT){ WAIT_N(NVH); } else {WAIT_BAR(0);} }while(0)
  for(;t+1<NT;t+=2){
    STEP(pB0,pB1,pA0,pA1,t,(t+3<NT),(t+1<NT),(t+1<NT));       ENDW(t);   RESC(); ROT();
    STEP(pA0,pA1,pB0,pB1,t+1,(t+4<NT),(t+2<NT),(t+2<NT));     ENDW(t+1); RESC(); ROT();
  }
  STEP(pB0,pB1,pA0,pA1,NT-1,false,false,false); RESC();
  { float sacc=pB0[0]+pB0[1]; _Pragma("unroll") for(int r=2;r<16;++r)sacc+=pB0[r]; _Pragma("unroll") for(int r=0;r<16;++r)sacc+=pB1[r]; l_reg+=sacc;
    pw0=(u32x4){PKW(pB0,0),PKW(pB0,2),PKW(pB0,4),PKW(pB0,6)};pw1=(u32x4){PKW(pB0,8),PKW(pB0,10),PKW(pB0,12),PKW(pB0,14)};pw2=(u32x4){PKW(pB1,0),PKW(pB1,2),PKW(pB1,4),PKW(pB1,6)};pw3=(u32x4){PKW(pB1,8),PKW(pB1,10),PKW(pB1,12),PKW(pB1,14)};
    SBAR(); pv<NO>(o,vb0+sl_cur*NVH,PAF(0),PAF(1),PAF(2),PAF(3)); }
  #undef PKW
  #undef PAF
  #undef VFR
  #undef PIN
  #undef MX3
  #undef GAPA
  #undef GAPB
  #undef EX
  #undef VRD
  #undef VRD2
  #undef GAPC
  #undef KRD
  #undef STEP
  #undef ENDW
  #undef WAITS
  {auto rr=__builtin_amdgcn_permlane32_swap(__float_as_uint(l_reg),__float_as_uint(l_reg),false,false);l_reg=__uint_as_float(rr[0])+__uint_as_float(rr[1]);}
  if(hi==0)wsf[32+r32]=l_reg;asm volatile("s_waitcnt lgkmcnt(0)":::"memory");
  float rli[16];
  #pragma unroll
  for(int r=0;r<16;++r)rli[r]=__builtin_amdgcn_rcpf(wsf[32+crow(r,hi)]);
  bf16*Ow=Ou+(long)(wid*QBLK)*OP;
  { constexpr int OW=64*NVH;
    bf16*stg=(bf16*)(shm+LDS_OST)+wid*(32*OW);
    #pragma unroll
    for(int r=0;r<16;++r){const int orow=crow(r,hi);
      #pragma unroll
      for(int d0=0;d0<NO;++d0)stg[orow*OW+d0*32+r32]=__float2bfloat16(o[d0][r]*rli[r]);}
    asm volatile("s_waitcnt lgkmcnt(0)":::"memory");
    constexpr int CPR=OW/8;
    #pragma unroll
    for(int i=0;i<32*CPR/64;++i){const int pid=i*64+lane,row=pid/CPR,ch=pid%CPR; u32x4 v=*(const u32x4*)(stg+row*OW+ch*8);
      if constexpr(EPI==1){ static_assert(EPI==0||NVH==2,"combine epilogue: 128-wide heads");
        const u32x4 w1=*(const u32x4*)(O1+(long)(wid*QBLK+row)*OP1+ch*8); float f1[8],f2[8]; unpack8(w1,f1); unpack8(v,f2); float ss=0.f;
        _Pragma("unroll") for(int k=0;k<8;++k){ f1[k]=f1[k]-lam*f2[k]; ss+=f1[k]*f1[k]; }
        ss+=dpp_x1(ss); ss+=dpp_x2(ss); ss+=dpp_x7(ss); ss+=dpp_x15(ss);
        const float rs=rsqrtf(ss*(1.f/128.f)+EPS)*osc;
        _Pragma("unroll") for(int k=0;k<8;++k) f1[k]=f1[k]*rs*gsub[ch*8+k];
        v=pack8(f1); }
      ATTN_STORE16(Ow+(long)row*OP+ch*8,v);} }
  asm volatile("s_waitcnt lgkmcnt(0)\n\ts_barrier":::"memory");
  #undef NEGM
  #undef KSL
  #undef DMA_K
  #undef DMA_V
  #undef CMASK
  #undef START
  #undef RESC
  #undef ROT
}
#undef SBAR
#undef WAIT_BAR
}

namespace att8 {
typedef int v8i __attribute__((ext_vector_type(8)));
typedef int v4i __attribute__((ext_vector_type(4)));
constexpr int NS = 8, PD = 5;
#define A8_SB() __builtin_amdgcn_sched_barrier(0)
__device__ __forceinline__ int crow(int r, int hi) { return (r & 3) + 8 * (r >> 2) + 4 * hi; }
__device__ __forceinline__ int pk4_f8(float a, float b, float c, float d) { int w = __builtin_amdgcn_cvt_pk_fp8_f32(a, b, 0, false); return __builtin_amdgcn_cvt_pk_fp8_f32(c, d, w, true); }
__device__ __forceinline__ int pk4_b8(float a, float b, float c, float d) { int w = __builtin_amdgcn_cvt_pk_bf8_f32(a, b, 0, false); return __builtin_amdgcn_cvt_pk_bf8_f32(c, d, w, true); }
template <int DQ> __device__ __forceinline__ int kswz(int key) { return DQ == 64 ? ((key >> 2) & 3) : ((key >> 1) & 7); }
template <int DQ> __device__ __forceinline__ int k_off(int k, int c) { return k * DQ + ((c ^ kswz<DQ>(k)) << 4); }
__device__ __forceinline__ int v_off(int n, int c) { return n * 64 + ((c ^ ((n >> 2) & 3)) << 4); }
__device__ __forceinline__ int v_key(int c, int r) { return 32 * (c & 1) + 4 * (c >> 1) + (r & 3) + 8 * (r >> 2); }
#if A8_QK6
__device__ __forceinline__ f32x16 mm_f8f8(v8i a, v8i b, f32x16 c) { return __builtin_amdgcn_mfma_scale_f32_32x32x64_f8f6f4(a, b, c, 2, 2, 0, 0, 0, 0); }
#else
__device__ __forceinline__ f32x16 mm_f8f8(v8i a, v8i b, f32x16 c) { return __builtin_amdgcn_mfma_scale_f32_32x32x64_f8f6f4(a, b, c, 0, 0, 0, 0, 0, 0); }
#endif
__device__ __forceinline__ f32x16 mm_b8f8(v8i a, v8i b, f32x16 c) { return __builtin_amdgcn_mfma_scale_f32_32x32x64_f8f6f4(a, b, c, 1, 0, 0, 0, 0, 0); }
__device__ __forceinline__ v8i ld8(const LAS char* p0, const LAS char* p1) { const v4i a = *(const LAS v4i*)p0, b = *(const LAS v4i*)p1; return (v8i){a.x, a.y, a.z, a.w, b.x, b.y, b.z, b.w}; }

template <int DQ, int DV, int EPI>
__device__ __forceinline__ void attn_unit(const unsigned char* __restrict__ Qu, const unsigned char* __restrict__ Kt, const unsigned char* __restrict__ Vt, bf16_t* Ou, const int OP, const int NT, LAS char* lds, int wv,
    const bf16_t* O1 = nullptr, const int OP1 = 0, const float lam = 0.f, const float* gsub = nullptr, const float osc = 1.f, float* chk = nullptr) {
  constexpr int KB = 64 * DQ, VB = DV * 64, SLOT = KB + VB, NKP = KB / 1024, NVP = VB / 1024, NQS = DQ / 64, NOB = DV / 32, NM = NOB + 1;
  const int tid = mk_tid(wv); const int lane = tid & 63, r32 = lane & 31, hi = lane >> 5; const int wid = __builtin_amdgcn_readfirstlane(tid >> 6);
  constexpr int NDMA = (DQ == 64 && DV == 64) ? 1 : 2;
  const unsigned lds0 = (unsigned)(size_t)lds;
  const int kp = (DQ == 64) ? (wid & 3) : wid, vp = (DV == 64) ? (wid & 3) : wid;
  const unsigned char* ksrc = Kt + kp * 1024 + lane * 16;
  const unsigned char* vsrc = Vt + vp * 1024 + lane * 16;
  const unsigned kdst = lds0 + kp * 1024, vdst = lds0 + KB + vp * 1024;
  const unsigned char* src1 = (NDMA == 1 && wid >= 4) ? vsrc : ksrc; const unsigned dst1 = (NDMA == 1 && wid >= 4) ? vdst : kdst;
  static_assert(NDMA == 2 || KB == VB, "single-piece form: equal tile strides");
#define A8_DMA(tt, sb) do { const int t_ = (tt) < NT ? (tt) : NT - 1; \
    att64::glds16(src1 + (size_t)t_ * KB, (unsigned)__builtin_amdgcn_readfirstlane(dst1 + (sb))); \
    if constexpr (NDMA == 2) att64::glds16(vsrc + (size_t)t_ * VB, (unsigned)__builtin_amdgcn_readfirstlane(vdst + (sb))); } while (0)
#define A8_WAIT() do { if constexpr (NDMA == 2) asm volatile("s_waitcnt vmcnt(4)" ::: "memory"); else asm volatile("s_waitcnt vmcnt(2)" ::: "memory"); __builtin_amdgcn_s_barrier(); asm volatile("" ::: "memory"); } while (0)
  v8i qf[NQS];
  { const unsigned char* qrow = Qu + (size_t)(wid * 32 + r32) * DQ + 32 * hi;
#pragma unroll
    for (int s = 0; s < NQS; ++s) { const v4i a = *(const v4i*)(qrow + 64 * s), b = *(const v4i*)(qrow + 64 * s + 16); qf[s] = (v8i){a.x, a.y, a.z, a.w, b.x, b.y, b.z, b.w}; } }
#pragma unroll
  for (int u = 0; u < PD; ++u) A8_DMA(u, u * SLOT);
  int kof[NQS][2], vof[2];
#pragma unroll
  for (int s = 0; s < NQS; ++s)
#pragma unroll
    for (int i = 0; i < 2; ++i) kof[s][i] = k_off<DQ>(r32, 4 * s + 2 * hi + i);
#pragma unroll
  for (int i = 0; i < 2; ++i) vof[i] = KB + v_off(r32, 2 * hi + i);
  f32x16 o[NOB], L = f32x16{}, SA0, SA1, SB0, SB1;
#pragma unroll
  for (int d = 0; d < NOB; ++d) o[d] = f32x16{};
  v8i kf[2][NQS], vf[NOB];
  const int one4 = pk4_f8(1.f, 1.f, 1.f, 1.f);
  const v8i ONES = (v8i){one4, one4, one4, one4, one4, one4, one4, one4};
  f32x16 NEG4 = {-4.f, -4.f, -4.f, -4.f, -4.f, -4.f, -4.f, -4.f, -4.f, -4.f, -4.f, -4.f, -4.f, -4.f, -4.f, -4.f};
  if constexpr (NQS == 1) asm volatile("" : "+v"(NEG4));
  v8i pk = (v8i){0, 0, 0, 0, 0, 0, 0, 0};
  int sb_prev = 0, sb_cur = 0, sb_next = SLOT, sb_dma = PD * SLOT;
#define A8_ROT() do { sb_prev = sb_cur; sb_cur = sb_next; sb_next = (sb_next == (NS - 1) * SLOT) ? 0 : sb_next + SLOT; sb_dma = (sb_dma == (NS - 1) * SLOT) ? 0 : sb_dma + SLOT; } while (0)
#define A8_LDK(sb) do { _Pragma("unroll") for (int m_ = 0; m_ < 2; ++m_) _Pragma("unroll") for (int s_ = 0; s_ < NQS; ++s_) { const LAS char* p_ = lds + (sb) + m_ * 32 * DQ; kf[m_][s_] = ld8(p_ + kof[s_][0], p_ + kof[s_][1]); } } while (0)
#define A8_LDV(sb) do { _Pragma("unroll") for (int d_ = 0; d_ < NOB; ++d_) { const LAS char* p_ = lds + (sb) + d_ * 2048; vf[d_] = ld8(p_ + vof[0], p_ + vof[1]); } } while (0)
#define A8_QK1(N, m) do { if constexpr (NQS == 1) N = mm_f8f8(kf[m][0], qf[0], NEG4); else { N = mm_f8f8(kf[m][0], qf[0], f32x16{}); N = mm_f8f8(kf[m][1], qf[1], N); } } while (0)
#define A8_EX(C0, C1, e) do { if ((e) < 16) C0[(e) & 15] = __builtin_amdgcn_exp2f(C0[(e) & 15]); else C1[(e) & 15] = __builtin_amdgcn_exp2f(C1[(e) & 15]); } while (0)
#define A8_PK1(W, P, B) do { W = __builtin_amdgcn_cvt_pk_bf8_f32(P[B], P[B + 1], W, false); W = __builtin_amdgcn_cvt_pk_bf8_f32(P[B + 2], P[B + 3], W, true); } while (0)
#define A8_PACKH(C, h) do { _Pragma("unroll") for (int j_ = 0; j_ < 4; ++j_) A8_PK1(pk[4 * (h) + j_], C, 4 * j_); } while (0)
  A8_WAIT();
  A8_DMA(PD, sb_dma);
  A8_LDK(sb_cur);
  A8_QK1(SA0, 0); A8_QK1(SA1, 1);
#pragma unroll
  for (int e = 0; e < 32; ++e) A8_EX(SA0, SA1, e);
  A8_PACKH(SA0, 0); A8_PACKH(SA1, 1);
  A8_LDK(sb_next);
  A8_QK1(SB0, 0); A8_QK1(SB1, 1);
  A8_LDV(sb_cur);
  A8_ROT();
#define A8_PRIO(p) do { A8_SB(); } while (0)
#define A8_STEP(C0, C1, N0, N1, tt, SYNC) do { \
    A8_SB(); if constexpr (SYNC) { A8_WAIT(); } A8_SB(); \
    _Pragma("unroll") for (int i = 0; i < NM; ++i) { \
      A8_PRIO(1); if (i < NOB) o[i < NOB ? i : 0] = mm_b8f8(pk, vf[i < NOB ? i : 0], o[i < NOB ? i : 0]); else L = mm_b8f8(pk, ONES, L); A8_PRIO(0); \
      if (i == 0) A8_LDK(sb_next); \
      _Pragma("unroll") for (int e = (32 * i) / NM; e < (32 * (i + 1)) / NM; ++e) A8_EX(C0, C1, e); \
      A8_SB(); } \
    A8_LDV(sb_cur); A8_SB(); \
    A8_PRIO(1); A8_QK1(N0, 0); A8_PRIO(0); A8_PACKH(C0, 0); A8_SB(); \
    A8_PRIO(1); A8_QK1(N1, 1); A8_PRIO(0); A8_PACKH(C1, 1); A8_SB(); \
    A8_DMA((tt) + PD, sb_dma); \
    A8_ROT(); A8_SB(); } while (0)
  { int t = 1;
    for (; t + 1 < NT; t += 2) { A8_STEP(SB0, SB1, SA0, SA1, t, true); A8_STEP(SA0, SA1, SB0, SB1, t + 1, false); }
    A8_STEP(SB0, SB1, SA0, SA1, NT - 1, true); }
#pragma unroll
  for (int i = 0; i < NOB; ++i) o[i] = mm_b8f8(pk, vf[i], o[i]);
  L = mm_b8f8(pk, ONES, L);
  asm volatile("s_waitcnt vmcnt(0) lgkmcnt(0)" ::: "memory");
  __builtin_amdgcn_s_barrier(); asm volatile("" ::: "memory");
#undef A8_DMA
#undef A8_WAIT
#undef A8_ROT
#undef A8_LDK
#undef A8_LDV
#undef A8_QK1
#undef A8_EX
#undef A8_PACKH
#undef A8_PK1
#undef A8_STEP
#undef A8_PRIO
  float rl[16];
#pragma unroll
  for (int r = 0; r < 16; ++r) rl[r] = __builtin_amdgcn_rcpf(L[r]);
  bf16_t* Ow = Ou + (size_t)(wid * 32) * OP;
  LAS bf16_t* stg = (LAS bf16_t*)lds + wid * (32 * DV);
  constexpr int CPR = DV / 8;
  u32x4 w1a[32 * CPR / 64]; float gsv[8];
  if constexpr (EPI == 1) { static_assert(EPI != 1 || 64 % CPR == 0, "a lane keeps its 16-byte column chunk");
#pragma unroll
    for (int i = 0; i < 32 * CPR / 64; ++i) { const int pid = i * 64 + lane, row = pid / CPR, ch = pid % CPR; w1a[i] = *(const u32x4*)(O1 + (size_t)(wid * 32 + row) * OP1 + ch * 8); }
#pragma unroll
    for (int k = 0; k < 8; ++k) gsv[k] = gsub[(lane % CPR) * 8 + k]; }
#pragma unroll
  for (int r = 0; r < 16; ++r) { const int orow = crow(r, hi);
#pragma unroll
    for (int d0 = 0; d0 < NOB; ++d0) stg[orow * DV + d0 * 32 + r32] = (bf16_t)f2bf(o[d0][r] * rl[r]); }
  asm volatile("s_waitcnt lgkmcnt(0)" ::: "memory");
  float cs_d = 0.f, cs_o = 0.f;
#pragma unroll
  for (int i = 0; i < 32 * CPR / 64; ++i) { const int pid = i * 64 + lane, row = pid / CPR, ch = pid % CPR; u32x4 v = *(const LAS u32x4*)(stg + row * DV + ch * 8);
    if constexpr (EPI == 1) { static_assert(EPI != 1 || DV == 128, "combine epilogue: 128-wide heads");
      const u32x4 w1 = w1a[i]; float f1[8], f2[8]; unpack8(w1, f1); unpack8(v, f2); float ss = 0.f;
#pragma unroll
      for (int k = 0; k < 8; ++k) { f1[k] = f1[k] - lam * f2[k]; ss += f1[k] * f1[k]; }
      ss += dpp_x1(ss); ss += dpp_x2(ss); ss += dpp_x7(ss); ss += dpp_x15(ss);
      const float rs = rsqrtf(ss * (1.f / 128.f) + EPS) * osc;
#pragma unroll
      for (int k = 0; k < 8; ++k) f1[k] = f1[k] * rs * gsv[k];
      v = pack8(f1); }
    if constexpr (EPI == 2) { const u32x4 w1 = *(const u32x4*)(Ow + (size_t)row * OP + ch * 8); float f1[8], f2[8]; unpack8(w1, f1); unpack8(v, f2);
#pragma unroll
      for (int k = 0; k < 8; ++k) { const float dd = f2[k] - f1[k]; cs_d += dd * dd; cs_o += f1[k] * f1[k]; } }
    else *(u32x4*)(Ow + (size_t)row * OP + ch * 8) = v; }
  if constexpr (EPI == 2) { cs_d = wave_sum(cs_d); cs_o = wave_sum(cs_o); if (lane == 0) { atomicAdd(chk, cs_d); atomicAdd(chk + 1, cs_o); } }
  asm volatile("s_waitcnt lgkmcnt(0)" ::: "memory");
  __builtin_amdgcn_s_barrier(); asm volatile("" ::: "memory");
}
#undef A8_SB
}

struct Args {
    const float* in[33];
    float* out; unsigned char* ws;
    int ph_lo, ph_hi;
};
enum { I_X = 0, I_C, I_CTX, I_CCTX, I_WADA, I_BADA, I_GMIX, I_GFFN, I_EWIN, I_EWOUT, I_EGQ, I_EGK, I_ECONVW, I_ECONVB, I_EBG, I_EGH,
       I_OWIN, I_OWOUT, I_OGQC, I_OGKC, I_OLAM, I_OGSUB, I_OGCQ, I_OWUQ, I_OGCKV, I_OWUKV, I_OGQD, I_OGKD, I_WR, I_BR, I_W1, I_W3, I_W2 };
enum { PH_PRO = 0, PH_ENORM, PH_EINPROJ, PH_EPOST, PH_EATTN, PH_MLA, PH_MLB, PH_MLC, PH_EOUT, PH_M0NORM, PH_M0GATHER, PH_M0G1, PH_M0G2, PH_M0COMB,
       PH_OINPROJ, PH_OPOST, PH_OGEMM, PH_OPOST2, PH_OATTN, PH_OSUB, PH_OOUT, PH_M1NORM, PH_M1GATHER, PH_M1G1, PH_M1G2, PH_M1COMB, NPH };

struct Ctx {
    LAS unsigned char* lds; int tid, lane, wave, vcu, G, gw, NGW;
};

__device__ __forceinline__ Args load_args() {
    extern __shared__ __attribute__((aligned(16))) unsigned char lds_dyn3_[];
    const LAS unsigned* p = (const LAS unsigned*)((LAS unsigned char*)lds_dyn3_ + ARGS_OFF);
    Args a;
#pragma unroll
    for (int i = 0; i < 33; ++i) { const unsigned lo = __builtin_amdgcn_readfirstlane(p[2 * i]), hi = __builtin_amdgcn_readfirstlane(p[2 * i + 1]); a.in[i] = (const float*)(const GAS float*)(((unsigned long long)hi << 32) | lo); }
    { const unsigned lo = __builtin_amdgcn_readfirstlane(p[66]), hi = __builtin_amdgcn_readfirstlane(p[67]); a.out = (float*)(GAS float*)(((unsigned long long)hi << 32) | lo); }
    { const unsigned lo = __builtin_amdgcn_readfirstlane(p[68]), hi = __builtin_amdgcn_readfirstlane(p[69]); a.ws = (unsigned char*)(GAS unsigned char*)(((unsigned long long)hi << 32) | lo); }
    a.ph_lo = __builtin_amdgcn_readfirstlane(p[70]); a.ph_hi = __builtin_amdgcn_readfirstlane(p[71]);
    return a;
}
__device__ __forceinline__ Ctx fresh(const Ctx& c0) {
    Ctx c; int bx = blockIdx.x, G = gridDim.x; const int tid = mk_tid(c0.wave);
    asm volatile("" : "+s"(bx), "+s"(G));
    extern __shared__ __attribute__((aligned(16))) unsigned char lds_dyn_[];
    c.lds = (LAS unsigned char*)lds_dyn_;
    const int vcu = (G % 8 == 0) ? (bx % 8) * (G / 8) + bx / 8 : bx;
    c.tid = tid; c.lane = tid & 63; c.wave = __builtin_amdgcn_readfirstlane(tid >> 6); c.vcu = vcu; c.G = G; c.gw = vcu * 8 + c.wave; c.NGW = G * 8;
    (void)c0;
    return c;
}
__device__ __forceinline__ void grid_sync(const Ctx& c) {
    extern __shared__ __attribute__((aligned(16))) unsigned char lds_dyn4_[];
    XcdBarrier b_; b_.bar = (unsigned*)(load_args().ws + WS_CTL) + CW_BAR; b_.x = xb_xcc_id(); b_.st = (volatile LAS unsigned*)((LAS unsigned char*)lds_dyn4_ + MISC_OFF) + 8; xcd_barrier(b_, mk_tid(c.wave));
}
__device__ __forceinline__ int row_bsel(int row) { return row < TC ? 2 : (row - TC) / SEQ; }
__device__ __forceinline__ bool fast8_e(const Args& a, int lane) { float gq = fabsf(a.in[I_EGQ][lane]), gk = fabsf(a.in[I_EGK][lane]); gq = wave_max(gq); gk = wave_max(gk); return A8_ENABLE && (0.125f * LOG2E * 64.f * gq * gk) < 17.f; }
__device__ __forceinline__ bool fast8_c(const Args& a, int lane) { float gq = fabsf(a.in[I_OGQC][lane]), gk = fabsf(a.in[I_OGKC][lane]); gq = wave_max(gq); gk = wave_max(gk); return A8_ENABLE && (0.125f * LOG2E * 64.f * gq * gk) < 17.f; }
__device__ __forceinline__ bool fast8_d(const Args& a, int lane) {
    float gq2 = fmaxf(fabsf(a.in[I_OGQD][lane]), lane < 32 ? fabsf(a.in[I_OGQD][64 + lane]) : 0.f), gk2 = fmaxf(fabsf(a.in[I_OGKD][lane]), lane < 32 ? fabsf(a.in[I_OGKD][64 + lane]) : 0.f);
    gq2 = wave_max(gq2); gk2 = wave_max(gk2); return A8_ENABLE && (0.10206207261596575f * LOG2E * 96.f * gq2 * gk2) < 20.5f; }
__device__ __forceinline__ void pk8_f6(const float* f, unsigned& lo, unsigned& hi) {
    unsigned cd[8];
#pragma unroll
    for (int i = 0; i < 4; ++i) { const unsigned w = (unsigned)__builtin_amdgcn_cvt_pk_fp8_f32(f[2 * i], f[2 * i + 1], 0, false); const unsigned b0 = w & 0xffu, b1 = (w >> 8) & 0xffu;
        cd[2 * i] = min(b0 & 0x7fu, 31u) | ((b0 & 0x80u) >> 2); cd[2 * i + 1] = min(b1 & 0x7fu, 31u) | ((b1 & 0x80u) >> 2); }
    lo = cd[0] | (cd[1] << 6) | (cd[2] << 12) | (cd[3] << 18) | (cd[4] << 24) | (cd[5] << 30);
    hi = (cd[5] >> 2) | (cd[6] << 4) | (cd[7] << 10);
}
__device__ __forceinline__ void st6(unsigned char* p0, unsigned char* p1, int j4, unsigned lo, unsigned hi) {
    const int o = 6 * j4;
#pragma unroll
    for (int t = 0; t < 3; ++t) { const int x = o + 2 * t; const unsigned short v = (unsigned short)(t == 0 ? lo : (t == 1 ? (lo >> 16) : hi)); *(unsigned short*)((x < 16 ? p0 : p1 - 16) + x) = v; }
}
__device__ __forceinline__ u32x2 pk8_f8(const float* f) { u32x2 w; w.x = (unsigned)att8::pk4_f8(f[0], f[1], f[2], f[3]); w.y = (unsigned)att8::pk4_f8(f[4], f[5], f[6], f[7]); return w; }
template <int DV> __device__ __forceinline__ void vquant_items(const bf16_t* src, int pitch, int col0, int hstride, int nheads, unsigned char* V8, int gw, int NGW, int lane) {
    constexpr int G = DV / 16;
    const int nitems = BATCH * nheads * NTILE * G;
    for (int it0 = gw; it0 < nitems; it0 += 4 * NGW) {
        unsigned short raw[4][16];
#pragma unroll
        for (int u = 0; u < 4; ++u) { const int it = it0 + u * NGW;
            if (it < nitems) {
                const int g = it % G; int r = it / G; const int tile = r % NTILE; r /= NTILE; const int head = r % nheads, b = r / nheads;
                const int cc = DV == 64 ? g : (g >> 1), n = DV == 64 ? lane : ((g & 1) * 64 + lane);
                const int row0 = tile < 4 ? b * CTX + tile * 64 : TC + b * SEQ + (tile - 4) * 64;
                const unsigned short* p = (const unsigned short*)(src + (size_t)row0 * pitch + col0 + head * hstride + n);
#pragma unroll
                for (int q = 0; q < 16; ++q) raw[u][q] = p[(size_t)att8::v_key(cc, q) * pitch]; } }
#pragma unroll
        for (int u = 0; u < 4; ++u) { const int it = it0 + u * NGW;
            if (it < nitems) {
                const int g = it % G; int r = it / G; const int tile = r % NTILE; r /= NTILE; const int head = r % nheads, b = r / nheads;
                const int cc = DV == 64 ? g : (g >> 1), n = DV == 64 ? lane : ((g & 1) * 64 + lane);
                float f[16];
#pragma unroll
                for (int q = 0; q < 16; ++q) f[q] = bf2f(raw[u][q]);
                att8::v4i w; w.x = att8::pk4_f8(f[0], f[1], f[2], f[3]); w.y = att8::pk4_f8(f[4], f[5], f[6], f[7]); w.z = att8::pk4_f8(f[8], f[9], f[10], f[11]); w.w = att8::pk4_f8(f[12], f[13], f[14], f[15]);
                *(att8::v4i*)(V8 + ((size_t)((b * nheads + head) * NTILE + tile)) * (DV * 64) + att8::v_off(n, cc)) = w; } }
    }
}

__device__ __forceinline__ void transpose_item(const float* W, int ldw, int K, bf16_t* WT, int row_off, int mode, int which, LAS float* scr, int kb, int nb, int lane) {
    const int k0 = 64 * kb, n0 = 32 * nb;
    { float t_[32];
#pragma unroll
      for (int i = 0; i < 32; ++i) t_[i] = W[(size_t)(k0 + 2 * i + (lane >> 5)) * ldw + n0 + (lane & 31)];
#pragma unroll
      for (int i = 0; i < 32; ++i) scr[(2 * i + (lane >> 5)) * 33 + (lane & 31)] = t_[i]; }
    LDS_WAIT(); asm volatile("" ::: "memory");
    const int c = lane & 7;
#pragma unroll
    for (int j = 0; j < 4; ++j) { const int n = (lane >> 3) + 8 * j; const LAS float* s = scr + (8 * c) * 33 + n;
        u32x4 o; o.x = pk2(s[0 * 33], s[1 * 33]); o.y = pk2(s[2 * 33], s[3 * 33]); o.z = pk2(s[4 * 33], s[5 * 33]); o.w = pk2(s[6 * 33], s[7 * 33]);
        const int ng = n0 + n;
        const int orow = mode == 0 ? row_off + ng : (64 * (ng >> 5) + ((ng & 31) >> 4) * 32 + which * 16 + (ng & 15));
        *(u32x4*)(WT + (size_t)orow * K + k0 + 8 * c) = o; }
    LDS_WAIT(); asm volatile("" ::: "memory");
}

__device__ __forceinline__ void transpose_load(const float* W, int ldw, int kb, int nb, int lane, float (&t_)[32]) {
    const int k0 = 64 * kb, n0 = 32 * nb;
#pragma unroll
    for (int i = 0; i < 32; ++i) t_[i] = W[(size_t)(k0 + 2 * i + (lane >> 5)) * ldw + n0 + (lane & 31)];
}
__device__ __forceinline__ void transpose_finish(const float (&t_)[32], int K, bf16_t* WT, int row_off, int mode, int which, LAS float* scr, int kb, int nb, int lane) {
    const int k0 = 64 * kb, n0 = 32 * nb;
#pragma unroll
    for (int i = 0; i < 32; ++i) scr[(2 * i + (lane >> 5)) * 33 + (lane & 31)] = t_[i];
    LDS_WAIT(); asm volatile("" ::: "memory");
    const int c = lane & 7;
#pragma unroll
    for (int j = 0; j < 4; ++j) { const int n = (lane >> 3) + 8 * j; const LAS float* s = scr + (8 * c) * 33 + n;
        u32x4 o; o.x = pk2(s[0 * 33], s[1 * 33]); o.y = pk2(s[2 * 33], s[3 * 33]); o.z = pk2(s[4 * 33], s[5 * 33]); o.w = pk2(s[6 * 33], s[7 * 33]);
        const int ng = n0 + n;
        const int orow = mode == 0 ? row_off + ng : (64 * (ng >> 5) + ((ng & 31) >> 4) * 32 + which * 16 + (ng & 15));
        *(u32x4*)(WT + (size_t)orow * K + k0 + 8 * c) = o; }
    LDS_WAIT(); asm volatile("" ::: "memory");
}

__device__ __forceinline__ void phase_pro(const Args& a, const Ctx& c0) {
    const Ctx c = fresh(c0);
    unsigned char* ws = a.ws;
    for (int it = blockIdx.x; it < 192; it += c.G) {
        const int l = it / 96, rem = it % 96, chunk = rem / 8, s = rem % 8;
        LAS float* sc = (LAS float*)c.lds;
        if (c.tid < 384) { const int bs = c.tid / 128, k = s * 128 + (c.tid % 128);
            const float v = bs < 2 ? a.in[I_C][bs * D + k] : a.in[I_CCTX][k]; sc[c.tid] = siluf(v); }
        __syncthreads();
        const int col = chunk * 512 + c.tid;
        const float* w = a.in[I_WADA] + (size_t)l * D * 6144 + (size_t)(s * 128) * 6144 + col;
        float a0 = 0.f, a1 = 0.f, a2 = 0.f;
#pragma unroll 16
        for (int k = 0; k < 128; ++k) { const float wv = w[(size_t)k * 6144]; a0 += sc[k] * wv; a1 += sc[128 + k] * wv; a2 += sc[256 + k] * wv; }
        float* mp = (float*)(ws + WS_MODP) + (size_t)s * 3 * 12288 + l * 6144 + col;
        mp[0] = a0; mp[12288] = a1; mp[2 * 12288] = a2;
        __syncthreads();
    }
    LAS float* scr = (LAS float*)(c.lds + 4096 + c.wave * 16384);
    bf16_t* wsm = (bf16_t*)(ws + WS_WSM);
    constexpr int I_E = 16 * 88, I_O = 16 * 61, I_W = 16 * 32, I_UQ = 4 * 12, I_UKV = 2 * 24;
    constexpr int NIT = I_E + I_O + 2 * I_W + I_UQ + I_UKV;
    for (int it = c.gw; it < NIT; it += c.NGW) {
        int r = it;
        if (r < I_E) { transpose_item(a.in[I_EWIN], IN_EVEN, D, wsm + WO_WINE / 2, 0, 0, 0, scr, r / 88, r % 88, c.lane); continue; } r -= I_E;
        if (r < I_O) { transpose_item(a.in[I_OWIN], IN_ODD, D, wsm + WO_WINO / 2, 0, 0, 0, scr, r / 61, r % 61, c.lane); continue; } r -= I_O;
        if (r < I_W) { transpose_item(a.in[I_EWOUT], D, D, wsm + WO_WOUTE / 2, 0, 0, 0, scr, r / 32, r % 32, c.lane); continue; } r -= I_W;
        if (r < I_W) { transpose_item(a.in[I_OWOUT], D, D, wsm + WO_WOUTO / 2, 0, 0, 0, scr, r / 32, r % 32, c.lane); continue; } r -= I_W;
        if (r < I_UQ) { transpose_item(a.in[I_OWUQ], 384, 256, wsm + WO_WUQ / 2, 0, 0, 0, scr, r / 12, r % 12, c.lane); continue; } r -= I_UQ;
        transpose_item(a.in[I_OWUKV], 768, 128, wsm + WO_WUKV / 2, 0, 0, 0, scr, r / 24, r % 24, c.lane);
    }
    {
        const int gt = c.vcu * 512 + c.tid, NT = c.G * 512;
        u32x4* z0 = (u32x4*)(ws + WS_WSM + WO_WINO + (size_t)1952 * D * 2);
        for (int i = gt; i < 96 * 2048 / 16; i += NT) z0[i] = (u32x4){0u, 0u, 0u, 0u};
        u32x4* z1 = (u32x4*)(ws + WS_WSM + WO_WUQ + (size_t)384 * 256 * 2);
        for (int i = gt; i < 128 * 512 / 16; i += NT) z1[i] = (u32x4){0u, 0u, 0u, 0u};
        float* t64 = (float*)(ws + WS_ROPE64); float* td = (float*)(ws + WS_ROPED);
        for (int i = gt; i < 256 * 16 + 256 * 8; i += NT) {
            if (i < 4096) { const int pos = i >> 4, fi = i & 15; float sn, cs; sincosf((float)pos * powf(10000.f, -(float)fi / 16.f), &sn, &cs); t64[2 * i] = cs; t64[2 * i + 1] = sn; }
            else { const int k = i - 4096, pos = k >> 3, fi = k & 7; float sn, cs; sincosf((float)pos * powf(10000.f, -(float)fi / 8.f), &sn, &cs); td[2 * k] = cs; td[2 * k + 1] = sn; } }
    }
}

__device__ __forceinline__ void norm_mod_row(const float* xrow, const float* gain, const float* sh, const float* sc, int lane, f32x4 (&v)[4]) {
    const f32x4* xr = (const f32x4*)xrow + lane;
    float s = 0.f;
#pragma unroll
    for (int j = 0; j < 4; ++j) { v[j] = xr[64 * j]; s += (v[j].x * v[j].x + v[j].y * v[j].y) + (v[j].z * v[j].z + v[j].w * v[j].w); }
    const float rstd = rsqrtf(wave_sum(s) * (1.f / D) + EPS);
#pragma unroll
    for (int j = 0; j < 4; ++j) { const f32x4 g = ((const f32x4*)gain)[lane + 64 * j], a = ((const f32x4*)sc)[lane + 64 * j], b = ((const f32x4*)sh)[lane + 64 * j];
        v[j] = (v[j] * rstd) * g * (a + 1.0f) + b; }
}
__device__ __forceinline__ void store_row_bf16(bf16_t* orow, int lane, const f32x4 (&v)[4]) {
    u32x2* o8 = (u32x2*)orow + lane;
#pragma unroll
    for (int j = 0; j < 4; ++j) { u32x2 w; w.x = pk2(v[j].x, v[j].y); w.y = pk2(v[j].z, v[j].w); o8[64 * j] = w; }
}

template <int NEXP> __device__ __forceinline__ void row_dots(const f32x4 (&v)[4], const LAS float* wT, int lane, float (&p)[NEXP]) {
    f32x4 wa[8], wb[8];
#define RD_LOAD(W, G) do { _Pragma("unroll") for (int ei_ = 0; ei_ < 2; ++ei_) _Pragma("unroll") for (int j_ = 0; j_ < 4; ++j_) W[ei_ * 4 + j_] = ((const LAS f32x4*)(wT + ((G) * 2 + ei_) * D))[lane + 64 * j_]; asm volatile("" ::: "memory"); } while (0)
#define RD_COMP(W, G) do { _Pragma("unroll") for (int ei_ = 0; ei_ < 2; ++ei_) { float acc_ = 0.f; _Pragma("unroll") for (int j_ = 0; j_ < 4; ++j_) { const f32x4 w_ = W[ei_ * 4 + j_]; \
        acc_ = fmaf(v[j_].x, w_.x, acc_); acc_ = fmaf(v[j_].y, w_.y, acc_); acc_ = fmaf(v[j_].z, w_.z, acc_); acc_ = fmaf(v[j_].w, w_.w, acc_); } p[(G) * 2 + ei_] = acc_; } } while (0)
    RD_LOAD(wa, 0);
#pragma unroll
    for (int g = 0; g < NEXP / 2; g += 2) {
        RD_LOAD(wb, g + 1);
        RD_COMP(wa, g);
        if (g + 2 < NEXP / 2) RD_LOAD(wa, g + 2);
        RD_COMP(wb, g + 1);
    }
#undef RD_LOAD
#undef RD_COMP
}
__device__ __forceinline__ void phase_enorm(const Args& a, const Ctx& c0) {
    const Ctx c = fresh(c0);
    unsigned char* ws = a.ws;
    const float* modp = (const float*)(ws + WS_MODP);
    float* mod = (float*)(ws + WS_MOD);
    LAS float* lmod = (LAS float*)c.lds;
    LAS float* wgT = (LAS float*)(c.lds + 24576);
#pragma unroll 4
    for (int i = c.tid; i < 6144; i += 512) { const int bs = i / 2048, ch = (i % 2048) / 1024, col = i % 1024, j = ch * 1024 + col;
        float v = a.in[I_BADA][j];
#pragma unroll
        for (int s = 0; s < 8; ++s) v += modp[(size_t)s * 3 * 12288 + bs * 12288 + j];
        lmod[i] = v; }
    for (int i = c.vcu * 512 + c.tid; i < 2 * 3 * 6144; i += c.G * 512) { const int l = i / 18432, bs = (i % 18432) / 6144, j = i % 6144;
        float v = a.in[I_BADA][l * 6144 + j];
#pragma unroll
        for (int s = 0; s < 8; ++s) v += modp[(size_t)s * 3 * 12288 + bs * 12288 + l * 6144 + j];
        mod[i] = v; }
    for (int k = c.tid; k < D; k += 512) { const f32x4* src = (const f32x4*)(a.in[I_EWIN] + (size_t)k * IN_EVEN + NZE);
#pragma unroll
        for (int q = 0; q < 4; ++q) { const f32x4 w = src[q]; wgT[(4 * q + 0) * D + k] = w.x; wgT[(4 * q + 1) * D + k] = w.y; wgT[(4 * q + 2) * D + k] = w.z; wgT[(4 * q + 3) * D + k] = w.w; } }
    __syncthreads();
    bf16_t* H = (bf16_t*)(ws + WS_HMF);
    float* Gt = (float*)(ws + WS_G);
    const float* gmix = a.in[I_GMIX];
    const int lane = c.lane;
    f32x4 gmx[4], xn[4];
    const float ebg = a.in[I_EBG][((lane >> 5) & 1) * 8 + ((lane >> 4) & 1) * 4 + ((lane >> 3) & 1) * 2 + ((lane >> 2) & 1)];
#pragma unroll
    for (int j = 0; j < 4; ++j) gmx[j] = ((const f32x4*)gmix)[lane + 64 * j];
    { const int row0 = c.gw; if (row0 < NROW) { const float* xr0 = row0 < TC ? a.in[I_CTX] + (size_t)row0 * D : a.in[I_X] + (size_t)(row0 - TC) * D;
#pragma unroll
        for (int j = 0; j < 4; ++j) xn[j] = ((const f32x4*)xr0)[lane + 64 * j]; } }
    for (int row = c.gw; row < NROW; row += c.NGW) {
        const int bs = row_bsel(row);
        f32x4 v[4]; float s = 0.f;
#pragma unroll
        for (int j = 0; j < 4; ++j) { v[j] = xn[j]; s += (v[j].x * v[j].x + v[j].y * v[j].y) + (v[j].z * v[j].z + v[j].w * v[j].w); }
        { const int nrow = row + c.NGW; if (nrow < NROW) { const float* xr1 = nrow < TC ? a.in[I_CTX] + (size_t)nrow * D : a.in[I_X] + (size_t)(nrow - TC) * D;
#pragma unroll
            for (int j = 0; j < 4; ++j) xn[j] = ((const f32x4*)xr1)[lane + 64 * j]; } }
        const float rstd = rsqrtf(wave_sum(s) * (1.f / D) + EPS);
        const LAS f32x4* shp = (const LAS f32x4*)(lmod + bs * 2048), *scp = (const LAS f32x4*)(lmod + bs * 2048 + 1024);
#pragma unroll
        for (int j = 0; j < 4; ++j) v[j] = (v[j] * rstd) * gmx[j] * (scp[lane + 64 * j] + 1.0f) + shp[lane + 64 * j];
        store_row_bf16(H + (size_t)row * D, lane, v);
        float p[16];
        row_dots<16>(v, wgT, lane, p);
#pragma unroll
        for (int i = 0; i < 8; ++i) { const bool up = (lane & 32) != 0; const float send = up ? p[i] : p[i + 8]; const float recv = xshfl<32>(send); p[i] = (up ? p[i + 8] : p[i]) + recv; }
#pragma unroll
        for (int i = 0; i < 4; ++i) { const bool up = (lane & 16) != 0; const float send = up ? p[i] : p[i + 4]; const float recv = xshfl<16>(send); p[i] = (up ? p[i + 4] : p[i]) + recv; }
#pragma unroll
        for (int i = 0; i < 2; ++i) { const bool up = (lane & 8) != 0; const float send = up ? p[i] : p[i + 2]; const float recv = dpp_x15(send); p[i] = (up ? p[i + 2] : p[i]) + recv; }
        { const bool up = (lane & 4) != 0; const float send = up ? p[0] : p[1]; const float recv = dpp_x7(send); p[0] = (up ? p[1] : p[0]) + recv; }
        p[0] += dpp_x2(p[0]); p[0] += dpp_x1(p[0]);
        if ((lane & 3) == 0) { const int idx = ((lane >> 5) & 1) * 8 + ((lane >> 4) & 1) * 4 + ((lane >> 3) & 1) * 2 + ((lane >> 2) & 1);
            float gv = p[0] + ebg;
            const int gt = idx >> 2;
            if (gt & 1) gv = logsigmoidf_(gv);
            Gt[(size_t)row * 16 + idx] = gv; }
    }
}

struct Rope4 { float c[4], s[4]; };
__device__ __forceinline__ Rope4 rope64_angles(int t, int lane, const float* tab) {
    const int pos = ((lane & 7) < 4) ? (t / GRIDW) : (t % GRIDW), fi = ((lane & 7) & 3) * 4;
    const f32x4* p = (const f32x4*)(tab + (pos * 16 + fi) * 2); const f32x4 a = p[0], b = p[1];
    Rope4 r; r.c[0] = a.x; r.s[0] = a.y; r.c[1] = a.z; r.s[1] = a.w; r.c[2] = b.x; r.s[2] = b.y; r.c[3] = b.z; r.s[3] = b.w;
    return r;
}
__device__ __forceinline__ void rope_apply8(float* f, const Rope4& r) {
#pragma unroll
    for (int i = 0; i < 4; ++i) { const float x0 = f[2 * i], x1 = f[2 * i + 1]; f[2 * i] = x0 * r.c[i] - x1 * r.s[i]; f[2 * i + 1] = x0 * r.s[i] + x1 * r.c[i]; }
}
__device__ __forceinline__ float sum8(float v) { v += dpp_x1(v); v += dpp_x2(v); v += dpp_x7(v); return v; }
__device__ __forceinline__ float sum16(float v) { v = sum8(v); v += dpp_x15(v); return v; }
__device__ __forceinline__ float ssq8(const float* f) { float s = 0.f;
#pragma unroll
    for (int i = 0; i < 8; ++i) s += f[i] * f[i];
    return s; }

__device__ __forceinline__ void phase_epost(const Args& a, const Ctx& c0) {
    const Ctx c = fresh(c0);
    unsigned char* ws = a.ws;
    const bf16_t* Z = (const bf16_t*)(ws + WS_RA);
    bf16_t* QKB = (bf16_t*)(ws + WS_RC);
    bf16_t* Qa = (bf16_t*)(ws + WS_RB);
    bf16_t* Ka = Qa + (size_t)BATCH * 8 * SEQ * 64;
    bf16_t* Va = Ka + (size_t)BATCH * 2 * SKV * 64;
    bf16_t* Qc = Va + (size_t)BATCH * 2 * SKV * 64;
    const int lane = c.lane;
    float gq[8], gk[8]; const float* rtab = (const float*)(ws + WS_ROPE64);
#pragma unroll
    for (int i = 0; i < 8; ++i) { gq[i] = a.in[I_EGQ][(lane & 7) * 8 + i]; gk[i] = a.in[I_EGK][(lane & 7) * 8 + i]; }
    float cw[2][3][8], cb[2][8];
#pragma unroll
    for (int jj = 0; jj < 2; ++jj)
#pragma unroll
        for (int i = 0; i < 8; ++i) { const int ch = 8 * lane + 512 * jj + i; cb[jj][i] = a.in[I_ECONVB][ch];
#pragma unroll
            for (int j = 0; j < 3; ++j) cw[jj][j][i] = a.in[I_ECONVW][j * 1024 + ch]; }
    const float qscale = 0.125f * LOG2E;
    const bool f8 = fast8_e(a, lane), w16 = !f8 || A8_DEBUG == 1;
    unsigned char* Q8a = ws + F8_EQ; unsigned char* K8a = ws + F8_EK; unsigned char* Q8c = ws + F8_EQC;
    u32x4 nq = {0, 0, 0, 0}, nk = {0, 0, 0, 0}, ncv[2][3]; Rope4 nrp;
#define EP_LOAD(R) do { const int r_ = (R); const bool ic_ = r_ < TC; const int t_ = ic_ ? r_ % CTX : (r_ - TC) % SEQ, sl_ = ic_ ? CTX : SEQ; const bf16_t* z_ = Z + (size_t)r_ * NZE; \
        nq = *(const u32x4*)(z_ + 8 * lane); nk = *(const u32x4*)(z_ + 512 + 8 * (lane & 15)); nrp = rope64_angles(t_, lane, rtab); \
        _Pragma("unroll") for (int jj_ = 0; jj_ < 2; ++jj_) _Pragma("unroll") for (int j_ = 0; j_ < 3; ++j_) { const int tt_ = t_ + j_ - 1; const int dj_ = (tt_ >= 0 && tt_ < sl_) ? j_ - 1 : 0; \
            ncv[jj_][j_] = *(const u32x4*)(z_ + (long)dj_ * NZE + 768 + 8 * lane + 512 * jj_); } } while (0)
    if (c.gw < NROW) EP_LOAD(c.gw);
    for (int row = c.gw; row < NROW; row += c.NGW) {
        const bool isctx = row < TC;
        const int b = isctx ? row / CTX : (row - TC) / SEQ, t = isctx ? row % CTX : (row - TC) % SEQ;
        const int slen = isctx ? CTX : SEQ;
        const bf16_t* zr = Z + (size_t)row * NZE;
        const u32x4 cq_ = nq, ck_ = nk; u32x4 ccv[2][3];
#pragma unroll
        for (int jj = 0; jj < 2; ++jj)
#pragma unroll
            for (int j = 0; j < 3; ++j) ccv[jj][j] = ncv[jj][j];
        const Rope4 rp = nrp;
        if (row + c.NGW < NROW) EP_LOAD(row + c.NGW);
        float f[8];
        { const u32x4 w = cq_; unpack8(w, f);
          const float rstd = rsqrtf(sum8(ssq8(f)) * (1.f / 64.f) + EPS);
#pragma unroll
          for (int i = 0; i < 8; ++i) f[i] = f[i] * rstd * gq[i];
          if (!isctx) rope_apply8(f, rp);
#pragma unroll
          for (int i = 0; i < 8; ++i) f[i] *= qscale;
          const int h = lane >> 3;
          if (f8) { unsigned char* r8 = isctx ? Q8c + ((size_t)(b * 8 + h) * CTX + t) * 64 : Q8a + ((size_t)(b * 8 + h) * SEQ + t) * 64; const int j8 = lane & 7;
            if constexpr (A8_QK6) { float g6[8]; _Pragma("unroll") for (int i = 0; i < 8; ++i) g6[i] = f[i] * 0.03125f; unsigned lo6, hi6; pk8_f6(g6, lo6, hi6); unsigned char* gp = r8 + (j8 >> 2) * 32; st6(gp, gp + 16, j8 & 3, lo6, hi6); }
            else *(u32x2*)(r8 + j8 * 8) = pk8_f8(f); }
          if (w16) { bf16_t* dst = isctx ? Qc + ((size_t)(b * 8 + h) * CTX + t) * 64 + (lane & 7) * 8 : Qa + ((size_t)(b * 8 + h) * SEQ + t) * 64 + (lane & 7) * 8;
            *(u32x4*)dst = pack8(f); } }
        if (lane < 16) {
            const int hk = lane >> 3, pos = isctx ? t : CTX + t;
            { const u32x4 w = ck_; unpack8(w, f); }
            const float rstd = rsqrtf(sum8(ssq8(f)) * (1.f / 64.f) + EPS);
#pragma unroll
            for (int i = 0; i < 8; ++i) f[i] = f[i] * rstd * gk[i];
            if (!isctx) rope_apply8(f, rp);
            if (f8) { const int j8 = lane & 7; unsigned char* tb = K8a + ((size_t)((b * 2 + hk) * NTILE + (pos >> 6))) * 4096;
              if constexpr (A8_QK6) { float g6[8]; _Pragma("unroll") for (int i = 0; i < 8; ++i) g6[i] = f[i] * 0.0078125f; unsigned lo6, hi6; pk8_f6(g6, lo6, hi6); const int gg = j8 >> 2;
                st6(tb + att8::k_off<64>(pos & 63, 2 * gg), tb + att8::k_off<64>(pos & 63, 2 * gg + 1), j8 & 3, lo6, hi6); }
              else *(u32x2*)(tb + att8::k_off<64>(pos & 63, j8 >> 1) + (j8 & 1) * 8) = pk8_f8(f); }
            if (w16) { *(u32x4*)(Ka + ((size_t)(b * 2 + hk) * SKV + pos) * 64 + (lane & 7) * 8) = pack8(f);
                const u32x4 wv = *(const u32x4*)(zr + 640 + 8 * lane);
                *(u32x4*)(Va + ((size_t)(b * 2 + hk) * SKV + pos) * 64 + (lane & 7) * 8) = wv; }
        }
#pragma unroll
        for (int jj = 0; jj < 2; ++jj) {
            const int ch = 8 * lane + 512 * jj;
            float accv[8];
#pragma unroll
            for (int i = 0; i < 8; ++i) accv[i] = cb[jj][i];
#pragma unroll
            for (int j = 0; j < 3; ++j) { const int tt = t + j - 1;
                if (tt >= 0 && tt < slen) { const u32x4 w = ccv[jj][j]; float g[8]; unpack8(w, g);
#pragma unroll
                    for (int i = 0; i < 8; ++i) accv[i] += g[i] * cw[jj][j][i]; } }
            const float ks = jj ? 0.08838834764831845f : 1.0f;
#pragma unroll
            for (int i = 0; i < 8; ++i) accv[i] = siluf(accv[i]) * ks;
            *(u32x4*)(QKB + (size_t)row * D + ch) = pack8(accv);
        }
    }
#undef EP_LOAD
    if (f8) vquant_items<64>(Z, NZE, 640, 64, 2, ws + F8_EV, c.gw, c.NGW, lane);
}

__device__ __forceinline__ void phase_eattn(const Args& a, const Ctx& c0) {
    const Ctx c = fresh(c0);
    unsigned char* ws = a.ws;
    const bf16_t* Qa = (const bf16_t*)(ws + WS_RB);
    const bf16_t* Ka = Qa + (size_t)BATCH * 8 * SEQ * 64;
    const bf16_t* Va = Ka + (size_t)BATCH * 2 * SKV * 64;
    const bf16_t* Qc = Va + (size_t)BATCH * 2 * SKV * 64;
    bf16_t* MIX = (bf16_t*)(ws + WS_HMF);
    LAS char* lds = (LAS char*)c.lds;
    float gq = fabsf(a.in[I_EGQ][c.lane]), gk = fabsf(a.in[I_EGK][c.lane]);
    gq = wave_max(gq); gk = wave_max(gk);
    const bool fast = (0.125f * LOG2E * 64.f * gq * gk) < 90.f;
#define EATT(FIXV) do { \
    for (int L = c.vcu; L < 16; L += c.G) { const int b = L / 8, h = L % 8, kvh = h / 4; \
        att64::attn_unit<8, FIXV>((const att64::bf16*)(Qc + (size_t)(b * 8 + h) * CTX * 64), 64, (const att64::bf16*)(Ka + (size_t)(b * 2 + kvh) * SKV * 64), (const att64::bf16*)(Va + (size_t)(b * 2 + kvh) * SKV * 64), 64, 64, \
                               (att64::bf16*)(MIX + (size_t)(b * CTX) * D + h * 64), D, CTX / 64, (char*)lds, c.wave); } \
    for (int L = c.vcu; L < 1024; L += c.G) { const int bk = L / 256, rem = L % 256, b = bk / 2, kvh = bk % 2, hq = rem / 64, qb = rem % 64, h = kvh * 4 + hq; \
        att64::attn_unit<8, FIXV>((const att64::bf16*)(Qa + ((size_t)(b * 8 + h) * SEQ + qb * 256) * 64), 64, (const att64::bf16*)(Ka + (size_t)(b * 2 + kvh) * SKV * 64), (const att64::bf16*)(Va + (size_t)(b * 2 + kvh) * SKV * 64), 64, 64, \
                               (att64::bf16*)(MIX + (size_t)(TC + b * SEQ + qb * 256) * D + h * 64), D, SKV / 64, (char*)lds, c.wave); } } while (0)
    const bool f8 = fast8_e(a, c.lane);
#define EATT8(EPIV, CHK) do { \
    for (int L = c.vcu; L < 16; L += c.G) { const int b = L / 8, h = L % 8, kvh = h / 4; \
        att8::attn_unit<64, 64, EPIV>(ws + F8_EQC + (size_t)(b * 8 + h) * CTX * 64, ws + F8_EK + (size_t)(b * 2 + kvh) * NTILE * 4096, ws + F8_EV + (size_t)(b * 2 + kvh) * NTILE * 4096, \
                                      MIX + (size_t)(b * CTX) * D + h * 64, D, CTX / 64, lds, c.wave, nullptr, 0, 0.f, nullptr, 1.f, CHK); } \
    for (int L = c.vcu; L < 1024; L += c.G) { const int bk = L / 256, rem = L % 256, b = bk / 2, kvh = bk % 2, hq = rem / 64, qb = rem % 64, h = kvh * 4 + hq; \
        att8::attn_unit<64, 64, EPIV>(ws + F8_EQ + ((size_t)(b * 8 + h) * SEQ + qb * 256) * 64, ws + F8_EK + (size_t)(b * 2 + kvh) * NTILE * 4096, ws + F8_EV + (size_t)(b * 2 + kvh) * NTILE * 4096, \
                                      MIX + (size_t)(TC + b * SEQ + qb * 256) * D + h * 64, D, NTILE, lds, c.wave, nullptr, 0, 0.f, nullptr, 1.f, CHK); } } while (0)
#if A8_DEBUG == 1
    if (fast) EATT(true); else EATT(false);
    if (f8) { grid_sync(c); EATT8(2, (float*)(ws + WS_CTL) + CW_CHK); }
#else
    if (f8) EATT8(0, nullptr); else if (fast) EATT(true); else EATT(false);
#endif
#undef EATT8
#undef EATT
}

__device__ __forceinline__ int ml_row0(int b, int nc) { return nc < 2 ? b * CTX + nc * 128 : TC + b * SEQ + (nc - 2) * 128; }
__device__ __forceinline__ float wave_scan_add(float v, int lane) {
#ifdef TEST_HIP_SCAN
    for (int o = 1; o < 64; o <<= 1) { const float t = __shfl_up(v, o); if (lane >= o) v += t; } return v;
#endif
    v += DPPF(0.f, v, 0x111, 0xf); v += DPPF(0.f, v, 0x112, 0xf); v += DPPF(0.f, v, 0x114, 0xf); v += DPPF(0.f, v, 0x118, 0xf);
    v += DPPF(0.f, v, 0x142, 0xa); v += DPPF(0.f, v, 0x143, 0xc); (void)lane;
    return v;
}
__device__ __forceinline__ float wave_scan_max(float v, int lane) {
#ifdef TEST_HIP_SCAN
    for (int o = 1; o < 64; o <<= 1) { const float t = __shfl_up(v, o); if (lane >= o) v = fmaxf(v, t); } return v;
#endif
    v = fmaxf(v, DPPF(-INFINITY, v, 0x111, 0xf)); v = fmaxf(v, DPPF(-INFINITY, v, 0x112, 0xf)); v = fmaxf(v, DPPF(-INFINITY, v, 0x114, 0xf)); v = fmaxf(v, DPPF(-INFINITY, v, 0x118, 0xf));
    v = fmaxf(v, DPPF(-INFINITY, v, 0x142, 0xa)); v = fmaxf(v, DPPF(-INFINITY, v, 0x143, 0xc)); (void)lane;
    return v;
}
__device__ __forceinline__ void ml_gate_scan(const float* Gt, int row0, int h, LAS float* av, LAS float* bc, LAS float* pm, LAS float* sc, int wave, int lane) {
    if (wave < 2) {
        const int dir = wave;
        const int u0 = dir ? 127 - 2 * lane : 2 * lane, u1 = dir ? 126 - 2 * lane : 2 * lane + 1;
        const float i0 = Gt[(size_t)(row0 + u0) * 16 + dir * 8 + h], i1 = Gt[(size_t)(row0 + u1) * 16 + dir * 8 + h];
        const float f0 = Gt[(size_t)(row0 + u0) * 16 + dir * 8 + 4 + h], f1 = Gt[(size_t)(row0 + u1) * 16 + dir * 8 + 4 + h];
        const float s = f0 + f1, incl = wave_scan_add(s, lane), excl = incl - s;
        const float b0 = excl + f0, b1 = incl;
        const float a0 = i0 - b0, a1 = i1 - b1;
        const float m01 = fmaxf(a0, a1), inclm = wave_scan_max(m01, lane);
#ifdef TEST_HIP_SCAN
        float exclm = __shfl_up(inclm, 1); if (lane == 0) exclm = -INFINITY;
#else
        const float exclm = DPPF(-INFINITY, inclm, 0x138, 0xf);
#endif
        LAS float* avd = av + dir * 128; LAS float* bcd = bc + dir * 128; LAS float* pmd = pm + dir * 128;
        avd[u0] = a0; avd[u1] = a1; bcd[u0] = b0; bcd[u1] = b1; pmd[u0] = fmaxf(exclm, a0); pmd[u1] = fmaxf(exclm, m01);
        if (lane == 63) { sc[dir * 4 + 0] = incl; sc[dir * 4 + 1] = inclm; }
    }
}
constexpr int MLP = 136;
__device__ __forceinline__ void ml_stage_rm(const bf16_t* g, int gp, LAS bf16_t* l, int tid) {
#pragma unroll
    for (int it = 0; it < 4; ++it) { const int cid = tid + 512 * it, u = cid >> 4, cc = cid & 15;
        const u32x4 w = *(const u32x4*)(g + (size_t)u * gp + cc * 8); *(LAS u32x4*)(l + u * MLP + cc * 8) = w; }
}
__device__ __forceinline__ void ml_stage_tr(const bf16_t* g, int gp, LAS bf16_t* l0, int tid) {
#pragma unroll
    for (int it = 0; it < 4; ++it) { const int cid = tid + 512 * it, u = cid & 127, ec = cid >> 7;
        const u32x4 w = *(const u32x4*)(g + (size_t)u * gp + ec * 8);
        const unsigned ww[4] = {w.x, w.y, w.z, w.w};
#pragma unroll
        for (int i = 0; i < 4; ++i) { l0[(ec * 8 + 2 * i) * MLP + u] = (bf16_t)(ww[i] & 0xffffu); l0[(ec * 8 + 2 * i + 1) * MLP + u] = (bf16_t)(ww[i] >> 16); } }
}
__device__ __forceinline__ void ml_stage_tr_scaled2(const bf16_t* g, int gp, LAS bf16_t* l0, LAS bf16_t* l1, const LAS float* s0, const LAS float* s1, int tid) {
#pragma unroll
    for (int it = 0; it < 4; ++it) { const int cid = tid + 512 * it, u = cid & 127, ec = cid >> 7;
        const u32x4 w = *(const u32x4*)(g + (size_t)u * gp + ec * 8); float f[8]; unpack8(w, f);
        const float g0 = s0[u], g1 = s1[u];
#pragma unroll
        for (int i = 0; i < 8; ++i) { l0[(ec * 8 + i) * MLP + u] = (bf16_t)f2bf(f[i] * g0); l1[(ec * 8 + i) * MLP + u] = (bf16_t)f2bf(f[i] * g1); } }
}
__device__ __forceinline__ bf16x8 ml_frag(const LAS bf16_t* t, int row, int k0, int lane) { return *(const LAS bf16x8*)(t + (row + (lane & 15)) * MLP + k0 + 8 * (lane >> 4)); }

__device__ __forceinline__ void phase_mla(const Args& a, const Ctx& c0) {
    const Ctx c = fresh(c0);
    unsigned char* ws = a.ws;
    const bf16_t* Z = (const bf16_t*)(ws + WS_RA);
    const bf16_t* QKB = (const bf16_t*)(ws + WS_RC);
    const float* Gt = (const float*)(ws + WS_G);
    bf16_t* KL = (bf16_t*)(ws + WS_RB);
    float* BL = (float*)(ws + WS_ML + ML_BL); float* MLc = (float*)(ws + WS_ML + ML_ML); float* NL = (float*)(ws + WS_ML + ML_NL);
    LAS bf16_t* vT = (LAS bf16_t*)c.lds;
    LAS bf16_t* kgF = vT + 128 * MLP;
    LAS bf16_t* kgB = kgF + 128 * MLP;
    LAS float* av = (LAS float*)(kgB + 128 * MLP); LAS float* bc = av + 256; LAS float* pm = bc + 256; LAS float* sc = pm + 256; LAS float* gs = sc + 16;
    const int tid = c.tid, lane = c.lane, wave = c.wave;
    for (int U = (c.vcu + 16) % c.G; U < BATCH * 4 * NCHUNK; U += c.G) {
        const int b = U / (4 * NCHUNK), h = (U / NCHUNK) % 4, nc = U % NCHUNK;
        const int row0 = ml_row0(b, nc);
        ml_gate_scan(Gt, row0, h, av, bc, pm, sc, wave, lane);
        __syncthreads();
        if (tid < 256) { const int dir = tid >> 7, u = tid & 127; gs[tid] = __expf(av[dir * 128 + u] - sc[dir * 4 + 1]); }
        __syncthreads();
        ml_stage_tr(Z + (size_t)row0 * NZE + 1792 + h * 128, NZE, vT, tid);
        ml_stage_tr_scaled2(QKB + (size_t)row0 * D + 512 + h * 128, D, kgF, kgB, gs, gs + 128, tid);
        __syncthreads();
        const int cf = nc, cbk = nc < 2 ? 1 - nc : 131 - nc;
        const int chf = (b * 4 + h) * 2, chb = chf + 1;
        if (tid < 2) { const int dir = tid; const int ch = dir ? chb : chf, cc = dir ? cbk : cf; BL[ch * NCHUNK + cc] = sc[dir * 4 + 0]; MLc[ch * NCHUNK + cc] = sc[dir * 4 + 0] + sc[dir * 4 + 1]; }
        if (tid < 256) { const int dir = tid >> 7, d = tid & 127; const LAS bf16_t* r = (dir ? kgB : kgF) + d * MLP; float s = 0.f;
#pragma unroll
            for (int j = 0; j < 16; ++j) { const u32x4 w = *(const LAS u32x4*)(r + 8 * j);
                s += ((bflo(w.x) + bfhi(w.x)) + (bflo(w.y) + bfhi(w.y))) + ((bflo(w.z) + bfhi(w.z)) + (bflo(w.w) + bfhi(w.w))); }
            NL[((size_t)(dir ? chb : chf) * NCHUNK + (dir ? cbk : cf)) * 128 + d] = s; }
        f32x4 accF[8], accB[8];
#pragma unroll
        for (int n = 0; n < 8; ++n) { accF[n] = (f32x4){0.f, 0.f, 0.f, 0.f}; accB[n] = (f32x4){0.f, 0.f, 0.f, 0.f}; }
#pragma unroll
        for (int k0 = 0; k0 < 128; k0 += 32) { const bf16x8 af = ml_frag(vT, 16 * wave, k0, lane);
#pragma unroll
            for (int n = 0; n < 8; ++n) { accF[n] = __builtin_amdgcn_mfma_f32_16x16x32_bf16(af, ml_frag(kgF, 16 * n, k0, lane), accF[n], 0, 0, 0);
                                          accB[n] = __builtin_amdgcn_mfma_f32_16x16x32_bf16(af, ml_frag(kgB, 16 * n, k0, lane), accB[n], 0, 0, 0); } }
        bf16_t* of = KL + ((size_t)chf * NCHUNK + cf) * 16384, *ob = KL + ((size_t)chb * NCHUNK + cbk) * 16384;
#pragma unroll
        for (int n = 0; n < 8; ++n)
#pragma unroll
            for (int r = 0; r < 4; ++r) { const int e = 16 * wave + 4 * (lane >> 4) + r, d = 16 * n + (lane & 15);
                of[e * 128 + d] = (bf16_t)f2bf(accF[n][r]); ob[e * 128 + d] = (bf16_t)f2bf(accB[n][r]); }
        __syncthreads();
    }
}

__device__ __forceinline__ void phase_mlb(const Args& a, const Ctx& c0) {
    const Ctx c = fresh(c0);
    unsigned char* ws = a.ws;
    bf16_t* KL = (bf16_t*)(ws + WS_RB);
    const float* BL = (const float*)(ws + WS_ML + ML_BL); const float* MLc = (const float*)(ws + WS_ML + ML_ML);
    float* MS = (float*)(ws + WS_ML + ML_MS); float* NL = (float*)(ws + WS_ML + ML_NL);
    const int NTH = c.G * 512;
    constexpr int GRP = 13;
    static_assert((NCHUNK / GRP) % 2 == 0 && NCHUNK % GRP == 0, "group pairs");
#define MLB_LOAD(G_, KV, BLV, MLV) do { _Pragma("unroll") for (int i = 0; i < GRP; ++i) { KV[i] = base[(size_t)((G_) * GRP + i) * STRIDE]; BLV[i] = bl[(G_) * GRP + i]; MLV[i] = ml[(G_) * GRP + i]; } } while (0)
    for (int idx = c.vcu * 512 + c.tid; idx < NCHAIN * 8192; idx += NTH) {
        const int ch = idx / 8192, el2 = idx % 8192;
        float st0 = 0.f, st1 = 0.f, m = 0.f;
        const float* bl = BL + ch * NCHUNK; const float* ml = MLc + ch * NCHUNK;
        unsigned* base = (unsigned*)(KL + (size_t)ch * NCHUNK * 16384) + el2;
        constexpr int STRIDE = 8192;
        unsigned kvA[GRP], kvB[GRP]; float blA[GRP], mlA[GRP], blB[GRP], mlB[GRP];
#define MLB_PROC(G_, KV, BLV, MLV) do { _Pragma("unroll") for (int i = 0; i < GRP; ++i) { \
                const float mn = fmaxf(BLV[i] + m, MLV[i]), decay = __expf(BLV[i] + m - mn), wl = __expf(MLV[i] - mn); \
                base[(size_t)((G_) * GRP + i) * STRIDE] = pk2(st0, st1); \
                st0 = decay * st0 + wl * bflo(KV[i]); st1 = decay * st1 + wl * bfhi(KV[i]); m = mn; } } while (0)
        MLB_LOAD(0, kvA, blA, mlA);
        for (int g = 0; g < NCHUNK / GRP; g += 2) {
            MLB_LOAD(g + 1, kvB, blB, mlB);
            MLB_PROC(g, kvA, blA, mlA);
            if (g + 2 < NCHUNK / GRP) MLB_LOAD(g + 2, kvA, blA, mlA);
            MLB_PROC(g + 1, kvB, blB, mlB);
        }
#undef MLB_PROC
    }
    if (c.tid < 8)
    for (int idx = c.vcu * 8 + c.tid; idx < NCHAIN * 128; idx += c.G * 8) {
        const int ch = idx / 128, el = idx % 128;
        float st = 0.f, m = 0.f;
        const float* bl = BL + ch * NCHUNK; const float* ml = MLc + ch * NCHUNK;
        float* base = NL + (size_t)ch * NCHUNK * 128 + el;
        constexpr int STRIDE = 128;
        float kvA[GRP], kvB[GRP], blA[GRP], mlA[GRP], blB[GRP], mlB[GRP];
#define MLB_PROC(G_, KV, BLV, MLV) do { _Pragma("unroll") for (int i = 0; i < GRP; ++i) { \
                const float mn = fmaxf(BLV[i] + m, MLV[i]), decay = __expf(BLV[i] + m - mn), wl = __expf(MLV[i] - mn); \
                base[(size_t)((G_) * GRP + i) * STRIDE] = st; if (el == 0) MS[ch * NCHUNK + (G_) * GRP + i] = m; \
                st = decay * st + wl * KV[i]; m = mn; } } while (0)
        MLB_LOAD(0, kvA, blA, mlA);
        for (int g = 0; g < NCHUNK / GRP; g += 2) {
            MLB_LOAD(g + 1, kvB, blB, mlB);
            MLB_PROC(g, kvA, blA, mlA);
            if (g + 2 < NCHUNK / GRP) MLB_LOAD(g + 2, kvA, blA, mlA);
            MLB_PROC(g + 1, kvB, blB, mlB);
        }
#undef MLB_PROC
    }
#undef MLB_LOAD
}

__device__ __forceinline__ void phase_mlc(const Args& a, const Ctx& c0) {
    const Ctx c = fresh(c0);
    unsigned char* ws = a.ws;
    const bf16_t* Z = (const bf16_t*)(ws + WS_RA);
    const bf16_t* QKB = (const bf16_t*)(ws + WS_RC);
    const float* Gt = (const float*)(ws + WS_G);
    const bf16_t* CS = (const bf16_t*)(ws + WS_RB);
    const float* MS = (const float*)(ws + WS_ML + ML_MS); const float* NS = (const float*)(ws + WS_ML + ML_NL);
    bf16_t* MIX = (bf16_t*)(ws + WS_HMF);
    LAS bf16_t* qT = (LAS bf16_t*)c.lds;
    LAS bf16_t* kT = qT + 128 * MLP;
    LAS bf16_t* vT = kT + 144 * MLP;
    LAS bf16_t* cT = vT + 128 * MLP;
    LAS float* av = (LAS float*)(cT + 128 * MLP); LAS float* bc = av + 256; LAS float* pm = bc + 256; LAS float* sc = pm + 256;
    const int tid = c.tid, lane = c.lane, wave = c.wave;
    const int fr = lane & 15, fq = lane >> 4;
    for (int U = c.vcu; U < BATCH * 4 * NCHUNK; U += c.G) {
        const int b = U / (4 * NCHUNK), h = (U / NCHUNK) % 4, nc = U % NCHUNK;
        const int row0 = ml_row0(b, nc);
        const int cf = nc, cbk = nc < 2 ? 1 - nc : 131 - nc;
        const int chf = (b * 4 + h) * 2, chb = chf + 1;
        ml_gate_scan(Gt, row0, h, av, bc, pm, sc, wave, lane);
        ml_stage_rm(QKB + (size_t)row0 * D + h * 128, D, qT, tid);
        ml_stage_rm(QKB + (size_t)row0 * D + 512 + h * 128, D, kT, tid);
        ml_stage_tr(Z + (size_t)row0 * NZE + 1792 + h * 128, NZE, vT, tid);
        ml_stage_rm(CS + ((size_t)chf * NCHUNK + cf) * 16384, 128, cT, tid);
        u32x4 csb[4];
        { const bf16_t* gb = CS + ((size_t)chb * NCHUNK + cbk) * 16384;
#pragma unroll
          for (int it = 0; it < 4; ++it) { const int cid = tid + 512 * it, u = cid >> 4, cc = cid & 15; csb[it] = *(const u32x4*)(gb + (size_t)u * 128 + cc * 8); } }
        if (tid < 256) { const int dir = tid >> 7, d = tid & 127; kT[(128 + dir) * MLP + d] = (bf16_t)f2bf(NS[((size_t)(dir ? chb : chf) * NCHUNK + (dir ? cbk : cf)) * 128 + d]); }
        for (int i = tid; i < 14 * 128; i += 512) kT[(130 + i / 128) * MLP + (i % 128)] = 0;
        const float mF = MS[chf * NCHUNK + cf], mB = MS[chb * NCHUNK + cbk];
        __syncthreads();
        f32x4 S[9];
#pragma unroll
        for (int n = 0; n < 9; ++n) S[n] = (f32x4){0.f, 0.f, 0.f, 0.f};
#pragma unroll
        for (int k0 = 0; k0 < 128; k0 += 32) { const bf16x8 af = ml_frag(qT, 16 * wave, k0, lane);
#pragma unroll
            for (int n = 0; n < 9; ++n) S[n] = __builtin_amdgcn_mfma_f32_16x16x32_bf16(af, ml_frag(kT, 16 * n, k0, lane), S[n], 0, 0, 0); }
        float AF[4], AB[4], rsF[4], rsB[4];
#pragma unroll
        for (int r = 0; r < 4; ++r) { const int j = 16 * wave + 4 * fq + r; AF[r] = fmaxf(mF, pm[j]); AB[r] = fmaxf(mB, pm[128 + j]); rsF[r] = 0.f; rsB[r] = 0.f; }
        float PF[8][4], PB[8][4];
#pragma unroll
        for (int n = 0; n < 8; ++n) { const int s = 16 * n + fr; const float afs = av[s], abs_ = av[128 + s];
#pragma unroll
            for (int r = 0; r < 4; ++r) { const int j = 16 * wave + 4 * fq + r;
                const float pf = (s <= j) ? S[n][r] * __expf(afs - AF[r]) : 0.f, pb = (s >= j) ? S[n][r] * __expf(abs_ - AB[r]) : 0.f;
                PF[n][r] = pf; PB[n][r] = pb; rsF[r] += pf; rsB[r] += pb; } }
        float cF[4], cB[4], iDF[4], iDB[4];
#pragma unroll
        for (int r = 0; r < 4; ++r) { const int j = 16 * wave + 4 * fq + r;
            const float sF = sum16(rsF[r]), sB = sum16(rsB[r]);
            const float sv = S[8][r];
            const float qnF = fq == 0 ? rdlane(sv, 0) : fq == 1 ? rdlane(sv, 16) : fq == 2 ? rdlane(sv, 32) : rdlane(sv, 48);
            const float qnB = fq == 0 ? rdlane(sv, 1) : fq == 1 ? rdlane(sv, 17) : fq == 2 ? rdlane(sv, 33) : rdlane(sv, 49);
            const float aiF = __expf(mF - AF[r]), aiB = __expf(mB - AB[r]);
            const float denF = aiF * qnF + sF, denB = aiB * qnB + sB;
            const float DF = fmaxf(fabsf(denF), __expf(-(bc[j] + AF[r]))), DB = fmaxf(fabsf(denB), __expf(-(bc[128 + j] + AB[r])));
            iDF[r] = 1.f / DF; iDB[r] = 1.f / DB; cF[r] = aiF * iDF[r]; cB[r] = aiB * iDB[r]; }
        __syncthreads();
#pragma unroll
        for (int n = 0; n < 8; ++n)
#pragma unroll
            for (int r = 0; r < 4; ++r) kT[(16 * wave + 4 * fq + r) * MLP + 16 * n + fr] = (bf16_t)f2bf(PF[n][r] * iDF[r] + PB[n][r] * iDB[r]);
        __syncthreads();
        f32x4 O[8], X[8];
#pragma unroll
        for (int n = 0; n < 8; ++n) { O[n] = (f32x4){0.f, 0.f, 0.f, 0.f}; X[n] = (f32x4){0.f, 0.f, 0.f, 0.f}; }
#pragma unroll
        for (int k0 = 0; k0 < 128; k0 += 32) { const bf16x8 ap = ml_frag(kT, 16 * wave, k0, lane), aq = ml_frag(qT, 16 * wave, k0, lane);
#pragma unroll
            for (int n = 0; n < 8; ++n) { O[n] = __builtin_amdgcn_mfma_f32_16x16x32_bf16(ap, ml_frag(vT, 16 * n, k0, lane), O[n], 0, 0, 0);
                                          X[n] = __builtin_amdgcn_mfma_f32_16x16x32_bf16(aq, ml_frag(cT, 16 * n, k0, lane), X[n], 0, 0, 0); } }
#pragma unroll
        for (int n = 0; n < 8; ++n)
#pragma unroll
            for (int r = 0; r < 4; ++r) O[n][r] += cF[r] * X[n][r];
        __syncthreads();
#pragma unroll
        for (int it = 0; it < 4; ++it) { const int cid = tid + 512 * it, u = cid >> 4, cc = cid & 15; *(LAS u32x4*)(cT + u * MLP + cc * 8) = csb[it]; }
        ml_stage_rm(Z + (size_t)row0 * NZE + 2304 + h * 128, NZE, kT, tid);
        float ghe[8];
#pragma unroll
        for (int n = 0; n < 8; ++n) ghe[n] = a.in[I_EGH][h * 128 + 16 * n + fr];
        __syncthreads();
#pragma unroll
        for (int n = 0; n < 8; ++n) X[n] = (f32x4){0.f, 0.f, 0.f, 0.f};
#pragma unroll
        for (int k0 = 0; k0 < 128; k0 += 32) { const bf16x8 aq = ml_frag(qT, 16 * wave, k0, lane);
#pragma unroll
            for (int n = 0; n < 8; ++n) X[n] = __builtin_amdgcn_mfma_f32_16x16x32_bf16(aq, ml_frag(cT, 16 * n, k0, lane), X[n], 0, 0, 0); }
        float ssq[4] = {0.f, 0.f, 0.f, 0.f};
#pragma unroll
        for (int n = 0; n < 8; ++n)
#pragma unroll
            for (int r = 0; r < 4; ++r) { O[n][r] += cB[r] * X[n][r]; ssq[r] += O[n][r] * O[n][r]; }
#pragma unroll
        for (int r = 0; r < 4; ++r) { const float rstd = rsqrtf(sum16(ssq[r]) * (1.f / 128.f) + EPS); const int row = row0 + 16 * wave + 4 * fq + r;
#pragma unroll
            for (int n = 0; n < 8; ++n) { const int e = 16 * n + fr;
                const float obv = bf2f(kT[(16 * wave + 4 * fq + r) * MLP + e]);
                MIX[(size_t)row * D + 512 + h * 128 + e] = (bf16_t)f2bf(O[n][r] * rstd * ghe[n] * sigmoidf_(obv)); } }
        __syncthreads();
    }
}

__device__ __forceinline__ float reduce32(float* p, int lane) {
#pragma unroll
    for (int i = 0; i < 16; ++i) { const bool up = (lane & 32) != 0; const float send = up ? p[i] : p[i + 16]; const float recv = xshfl<32>(send); p[i] = (up ? p[i + 16] : p[i]) + recv; }
#pragma unroll
    for (int i = 0; i < 8; ++i) { const bool up = (lane & 16) != 0; const float send = up ? p[i] : p[i + 8]; const float recv = xshfl<16>(send); p[i] = (up ? p[i + 8] : p[i]) + recv; }
#pragma unroll
    for (int i = 0; i < 4; ++i) { const bool up = (lane & 8) != 0; const float send = up ? p[i] : p[i + 4]; const float recv = dpp_x15(send); p[i] = (up ? p[i + 4] : p[i]) + recv; }
#pragma unroll
    for (int i = 0; i < 2; ++i) { const bool up = (lane & 4) != 0; const float send = up ? p[i] : p[i + 2]; const float recv = dpp_x7(send); p[i] = (up ? p[i + 2] : p[i]) + recv; }
    { const bool up = (lane & 2) != 0; const float send = up ? p[0] : p[1]; const float recv = dpp_x2(send); p[0] = (up ? p[1] : p[0]) + recv; }
    p[0] += dpp_x1(p[0]);
    return p[0];
}
__device__ __forceinline__ void phase_mnorm(const Args& a, const Ctx& c0, int layer, int dry = 0) {
    const Ctx c = fresh(c0);
    unsigned char* ws = a.ws;
    const bf16_t* X = (const bf16_t*)(ws + WS_X);
    bf16_t* F = (bf16_t*)(ws + WS_HMF);
    const float* mod = (const float*)(ws + WS_MOD) + (size_t)layer * 3 * 6144;
    int* RTE = (int*)(ws + WS_RT + RT_E); int* RTP = (int*)(ws + WS_RT + RT_POS); float* RTG = (float*)(ws + WS_RT + RT_GATE);
    unsigned* gcnt = (unsigned*)(ws + WS_CTL) + (layer ? CW_CNT1 : CW_CNT0);
    LAS float* wT = (LAS float*)c.lds;
    LAS unsigned* lcnt = (LAS unsigned*)(c.lds + 131072);
    LAS unsigned* lbase = lcnt + 32;
    const int lane = c.lane, tid = c.tid;
    for (int k = tid; k < D; k += 512) { const f32x4* src = (const f32x4*)(a.in[I_WR] + (size_t)k * NE);
#pragma unroll
        for (int q = 0; q < 8; ++q) { const f32x4 w = src[q]; wT[(4 * q + 0) * D + k] = w.x; wT[(4 * q + 1) * D + k] = w.y; wT[(4 * q + 2) * D + k] = w.z; wT[(4 * q + 3) * D + k] = w.w; } }
    if (tid < 32) lcnt[tid] = 0u;
    __syncthreads();
    const float* gffn = a.in[I_GFFN] + layer * D;
    const int rlo = layer ? TC : 0;
    int my_e0 = 0, my_e1 = 0, my_p0 = 0, my_p1 = 0; int it = 0;
    f32x4 gsc[4], msh[4]; u32x2 xa[4], xb[4]; int cur_bs = -1;
    const float rbias = a.in[I_BR][lane >> 1];
#define MN_LOADX(X, R) do { if ((R) < NROW) { _Pragma("unroll") for (int j = 0; j < 4; ++j) X[j] = ((const u32x2*)(X_ + (size_t)(R) * D))[lane + 64 * j]; } } while (0)
    const bf16_t* X_ = X;
    MN_LOADX(xa, rlo + c.gw); MN_LOADX(xb, rlo + c.gw + c.NGW);
#define MN_NORM(V, XR, ROW, NEXTROW) do { const int bs = row_bsel(ROW); \
        if (bs != cur_bs) { cur_bs = bs; _Pragma("unroll") for (int j = 0; j < 4; ++j) { msh[j] = ((const f32x4*)(mod + bs * 6144 + 3 * 1024))[lane + 64 * j]; gsc[j] = ((const f32x4*)gffn)[lane + 64 * j] * (((const f32x4*)(mod + bs * 6144 + 4 * 1024))[lane + 64 * j] + 1.0f); } } \
        float ssq_ = 0.f; \
        _Pragma("unroll") for (int j = 0; j < 4; ++j) { V[j] = bf4_to_f32(XR[j]); ssq_ += (V[j].x * V[j].x + V[j].y * V[j].y) + (V[j].z * V[j].z + V[j].w * V[j].w); } \
        MN_LOADX(XR, NEXTROW); \
        const float rstd_ = rsqrtf(wave_sum(ssq_) * (1.f / D) + EPS); \
        _Pragma("unroll") for (int j = 0; j < 4; ++j) V[j] = (V[j] * rstd_) * gsc[j] + msh[j]; \
        store_row_bf16(F + (size_t)(ROW) * D, lane, V); } while (0)
#define RMAXF(x) do { x = fmaxf(x, dpp_x1(x)); x = fmaxf(x, dpp_x2(x)); x = fmaxf(x, dpp_x7(x)); x = fmaxf(x, dpp_x15(x)); } while (0)
#define DPPI(v, ctrl) __builtin_amdgcn_update_dpp(0, (v), (ctrl), 0xf, 0xf, false)
#define RMINI(x) do { x = min(x, DPPI(x, 0xB1)); x = min(x, DPPI(x, 0x4E)); x = min(x, DPPI(x, 0x141)); x = min(x, DPPI(x, 0x140)); } while (0)
#define MN_ROUTE(P, ROW, IT) do { const float mine = reduce32(P, lane); int e0, e1; float s0, s1_; { \
            const int ex = lane >> 1; \
            const float scl = sigmoidf_(mine), sl = scl + rbias; \
            float m1 = sl; RMAXF(m1); \
            int i1 = (sl == m1) ? ex : 127; RMINI(i1); \
            const float sl2 = (ex == i1) ? -INFINITY : sl; \
            float m2 = sl2; RMAXF(m2); \
            int i2 = (sl2 == m2) ? ex : 127; RMINI(i2); \
            float c1 = (ex == i1) ? scl : -INFINITY; RMAXF(c1); \
            float c2 = (ex == i2) ? scl : -INFINITY; RMAXF(c2); \
            const float gs = m1 + m2; \
            const float q0 = rdlane(gs, 0), q1 = rdlane(gs, 16), q2 = rdlane(gs, 32), q3 = rdlane(gs, 48); \
            int bg = 0; float bv = q0; if (q1 > bv) { bv = q1; bg = 1; } if (q2 > bv) { bv = q2; bg = 2; } if (q3 > bv) { bv = q3; bg = 3; } \
            const int bl = __builtin_amdgcn_readfirstlane(bg * 16); \
            e0 = __builtin_amdgcn_readlane(i1, bl); e1 = __builtin_amdgcn_readlane(i2, bl); \
            s0 = __builtin_bit_cast(float, __builtin_amdgcn_readlane(__builtin_bit_cast(int, c1), bl)); s1_ = __builtin_bit_cast(float, __builtin_amdgcn_readlane(__builtin_bit_cast(int, c2), bl)); } \
        const float inv = 1.f / (s0 + s1_); \
        int p0 = 0, p1 = 0; \
        if (lane == 0 && !dry) { p0 = (int)__hip_atomic_fetch_add(&lcnt[e0], 1u, __ATOMIC_RELAXED, __HIP_MEMORY_SCOPE_WORKGROUP); p1 = (int)__hip_atomic_fetch_add(&lcnt[e1], 1u, __ATOMIC_RELAXED, __HIP_MEMORY_SCOPE_WORKGROUP); \
            RTG[(size_t)(ROW) * 2] = s0 * inv; RTG[(size_t)(ROW) * 2 + 1] = s1_ * inv; RTE[(size_t)(ROW) * 2] = e0; RTE[(size_t)(ROW) * 2 + 1] = e1; } \
        p0 = __builtin_amdgcn_readfirstlane(p0); p1 = __builtin_amdgcn_readfirstlane(p1); \
        if (lane == (IT)) { my_e0 = e0; my_e1 = e1; my_p0 = p0; my_p1 = p1; } } while (0)
    for (int row = rlo + c.gw; row < NROW; row += 2 * c.NGW, it += 2) {
        const int row1 = row + c.NGW; const bool has1 = row1 < NROW;
        f32x4 v0[4], v1[4];
        MN_NORM(v0, xa, row, row + 2 * c.NGW);
        if (has1) MN_NORM(v1, xb, row1, row1 + 2 * c.NGW);
        else {
#pragma unroll
            for (int j = 0; j < 4; ++j) v1[j] = (f32x4){0.f, 0.f, 0.f, 0.f}; }
        f32x2 vx[16];
#pragma unroll
        for (int j = 0; j < 4; ++j) { vx[4 * j] = (f32x2){v0[j].x, v1[j].x}; vx[4 * j + 1] = (f32x2){v0[j].y, v1[j].y}; vx[4 * j + 2] = (f32x2){v0[j].z, v1[j].z}; vx[4 * j + 3] = (f32x2){v0[j].w, v1[j].w}; }
        float pa[32], pb[32];
        { f32x4 wa[4], wb[4];
#define RD_LOAD(W, E) do { _Pragma("unroll") for (int j_ = 0; j_ < 4; ++j_) W[j_] = ((const LAS f32x4*)(wT + (E) * D))[lane + 64 * j_]; asm volatile("" ::: "memory"); } while (0)
#define RD_COMP(W, E) do { f32x2 acc_ = (f32x2){0.f, 0.f}; _Pragma("unroll") for (int j_ = 0; j_ < 4; ++j_) { const f32x4 w_ = W[j_]; \
        acc_ = __builtin_elementwise_fma(vx[4 * j_], (f32x2){w_.x, w_.x}, acc_); acc_ = __builtin_elementwise_fma(vx[4 * j_ + 1], (f32x2){w_.y, w_.y}, acc_); \
        acc_ = __builtin_elementwise_fma(vx[4 * j_ + 2], (f32x2){w_.z, w_.z}, acc_); acc_ = __builtin_elementwise_fma(vx[4 * j_ + 3], (f32x2){w_.w, w_.w}, acc_); } pa[E] = acc_.x; pb[E] = acc_.y; } while (0)
          RD_LOAD(wa, 0);
#pragma unroll
          for (int e = 0; e < 32; e += 2) {
              RD_LOAD(wb, e + 1);
              RD_COMP(wa, e);
              if (e + 2 < 32) RD_LOAD(wa, e + 2);
              RD_COMP(wb, e + 1);
          }
#undef RD_LOAD
#undef RD_COMP
        }
        MN_ROUTE(pa, row, it);
        if (has1) MN_ROUTE(pb, row1, it + 1);
    }
#undef MN_LOADX
#undef MN_NORM
#undef MN_ROUTE
#undef RMAXF
#undef DPPI
#undef RMINI
    __syncthreads();
    if (tid < 32 && !dry) lbase[tid] = atomicAdd(&gcnt[tid], lcnt[tid]);
    __syncthreads();
    { const int row = rlo + c.gw + lane * c.NGW;
      if (lane < it && row < NROW && !dry) { RTP[(size_t)row * 2] = (int)lbase[my_e0] + my_p0; RTP[(size_t)row * 2 + 1] = (int)lbase[my_e1] + my_p1; } }
}

__device__ __forceinline__ void phase_mnorm2(const Args& a, const Ctx& c0, int layer, int dry = 0) {
    const Ctx c = fresh(c0);
    unsigned char* ws = a.ws;
    const bf16_t* X = (const bf16_t*)(ws + WS_X);
    bf16_t* F = (bf16_t*)(ws + WS_HMF);
    const float* mod = (const float*)(ws + WS_MOD) + (size_t)layer * 3 * 6144;
    int* RTE = (int*)(ws + WS_RT + RT_E); int* RTP = (int*)(ws + WS_RT + RT_POS); float* RTG = (float*)(ws + WS_RT + RT_GATE);
    unsigned* gcnt = (unsigned*)(ws + WS_CTL) + (layer ? CW_CNT1 : CW_CNT0);
    constexpr int WP = 1032, RMAX = 144;
    LAS bf16_t* Wh = (LAS bf16_t*)c.lds; LAS bf16_t* Wl = Wh + 32 * WP;
    LAS float* RAW = (LAS float*)(c.lds + 2 * 32 * WP * 2);
    LAS float* Cc = RAW + RMAX * 32;
    LAS unsigned* lcnt = (LAS unsigned*)(Cc + 96); LAS unsigned* lbase = lcnt + 32;
    const int lane = c.lane, tid = c.tid, wave = c.wave;
    const float* gffn = a.in[I_GFFN] + layer * D; const float* Wr = a.in[I_WR];
    const int rlo = layer ? TC : 0, nper = (NROW - rlo + c.G - 1) / c.G;
    const int R0 = rlo + c.vcu * nper, R1 = min(R0 + nper, NROW);
    if (tid < 32) lcnt[tid] = 0u;
    { const int e = tid & 31, g = tid >> 5; float a0 = 0.f, a1 = 0.f, a2 = 0.f;
#pragma unroll 1
      for (int i0 = g; i0 < D; i0 += 16 * 16) { float w_[16], h0[16], h1[16], h2[16];
#pragma unroll
          for (int u = 0; u < 16; ++u) { const int i = i0 + 16 * u; w_[u] = Wr[i * NE + e]; h0[u] = mod[0 * 6144 + 3 * 1024 + i]; h1[u] = mod[1 * 6144 + 3 * 1024 + i]; h2[u] = mod[2 * 6144 + 3 * 1024 + i]; }
#pragma unroll
          for (int u = 0; u < 16; ++u) { a0 += h0[u] * w_[u]; a1 += h1[u] * w_[u]; a2 += h2[u] * w_[u]; } }
      LAS float* part = RAW;
      part[g * 96 + e] = a0; part[g * 96 + 32 + e] = a1; part[g * 96 + 64 + e] = a2;
      __syncthreads();
      if (tid < 96) { float acc = 0.f;
#pragma unroll
          for (int q = 0; q < 16; ++q) acc += part[q * 96 + tid];
          Cc[tid] = acc; }
      __syncthreads(); }
    const float rbias = a.in[I_BR][lane >> 1];
    int my_e0 = 0, my_e1 = 0, my_p0 = 0, my_p1 = 0, my_row = 0; int it = 0;
#define RMAXF(x) do { x = fmaxf(x, dpp_x1(x)); x = fmaxf(x, dpp_x2(x)); x = fmaxf(x, dpp_x7(x)); x = fmaxf(x, dpp_x15(x)); } while (0)
#define DPPI(v, ctrl) __builtin_amdgcn_update_dpp(0, (v), (ctrl), 0xf, 0xf, false)
#define RMINI(x) do { x = min(x, DPPI(x, 0xB1)); x = min(x, DPPI(x, 0x4E)); x = min(x, DPPI(x, 0x141)); x = min(x, DPPI(x, 0x140)); } while (0)
    for (int s0 = R0; s0 < R1; ) {
        const int bs = row_bsel(s0);
        const int bend = bs == 2 ? TC : TC + (bs + 1) * SEQ;
        const int s1 = min(R1, bend);
        __syncthreads();
        { const float* sc = mod + bs * 6144 + 4 * 1024; LAS float* gsl = (LAS float*)(lbase + 32);
          for (int k = tid; k < D; k += 512) gsl[k] = gffn[k] * (sc[k] + 1.0f);
          __syncthreads();
#pragma unroll 1
          for (int i0 = tid; i0 < NE * D; i0 += 512 * 16) { float w_[16];
#pragma unroll
              for (int u = 0; u < 16; ++u) w_[u] = Wr[i0 + 512 * u];
#pragma unroll
              for (int u = 0; u < 16; ++u) { const int idx = i0 + 512 * u, k = idx >> 5, e = idx & 31; const float w = w_[u] * gsl[k];
                  const unsigned h = f2bf(w); const float lo = w - bf2f((unsigned short)h); Wh[e * WP + k] = (bf16_t)h; Wl[e * WP + k] = (bf16_t)f2bf(lo); } } }
        __syncthreads();
        const int ntile = (s1 - s0 + 15) / 16;
        for (int t = wave; t < ntile; t += 8) {
            const int rr = min(s0 + 16 * t + (lane & 15), s1 - 1);
            const bf16_t* xr = X + (size_t)rr * D + 8 * (lane >> 4);
            bf16x8 av[32];
#pragma unroll
            for (int ks = 0; ks < 32; ++ks) av[ks] = *(const bf16x8*)(xr + 32 * ks);
            f32x4 acc0 = (f32x4){0.f, 0.f, 0.f, 0.f}, acc1 = acc0;
            const LAS bf16_t* bh = Wh + (lane & 15) * WP + 8 * (lane >> 4); const LAS bf16_t* bl = Wl + (lane & 15) * WP + 8 * (lane >> 4);
#pragma unroll
            for (int ks = 0; ks < 32; ++ks) {
                const bf16x8 b00 = *(const LAS bf16x8*)(bh + 32 * ks), b01 = *(const LAS bf16x8*)(bl + 32 * ks), b10 = *(const LAS bf16x8*)(bh + 16 * WP + 32 * ks), b11 = *(const LAS bf16x8*)(bl + 16 * WP + 32 * ks);
                acc0 = __builtin_amdgcn_mfma_f32_16x16x32_bf16(av[ks], b00, acc0, 0, 0, 0); acc0 = __builtin_amdgcn_mfma_f32_16x16x32_bf16(av[ks], b01, acc0, 0, 0, 0);
                acc1 = __builtin_amdgcn_mfma_f32_16x16x32_bf16(av[ks], b10, acc1, 0, 0, 0); acc1 = __builtin_amdgcn_mfma_f32_16x16x32_bf16(av[ks], b11, acc1, 0, 0, 0); }
#pragma unroll
            for (int r = 0; r < 4; ++r) { const int lr = (s0 - R0) + 16 * t + 4 * (lane >> 4) + r;
                if (lr < RMAX) { RAW[lr * 32 + (lane & 15)] = acc0[r]; RAW[lr * 32 + 16 + (lane & 15)] = acc1[r]; } }
        }
        __syncthreads();
        f32x4 gsc[4], msh[4];
#pragma unroll
        for (int j = 0; j < 4; ++j) { msh[j] = ((const f32x4*)(mod + bs * 6144 + 3 * 1024))[lane + 64 * j]; gsc[j] = ((const f32x4*)gffn)[lane + 64 * j] * (((const f32x4*)(mod + bs * 6144 + 4 * 1024))[lane + 64 * j] + 1.0f); }
        u32x2 xq0[4][4], xq1[4][4];
#define MR_LOAD(Q, RB) do { _Pragma("unroll") for (int b_ = 0; b_ < 4; ++b_) { const int r_ = (RB) + 8 * b_; if (r_ < s1) { _Pragma("unroll") for (int j = 0; j < 4; ++j) Q[b_][j] = ((const u32x2*)(X + (size_t)r_ * D))[lane + 64 * j]; } } } while (0)
        auto proc_row = [&](const u32x2 (&XR_)[4], const int row) {
            f32x4 v[4]; float ssq_ = 0.f;
#pragma unroll
            for (int j = 0; j < 4; ++j) { v[j] = bf4_to_f32(XR_[j]); ssq_ += (v[j].x * v[j].x + v[j].y * v[j].y) + (v[j].z * v[j].z + v[j].w * v[j].w); }
            const float rstd_ = rsqrtf(wave_sum(ssq_) * (1.f / D) + EPS);
#pragma unroll
            for (int j = 0; j < 4; ++j) v[j] = (v[j] * rstd_) * gsc[j] + msh[j];
            store_row_bf16(F + (size_t)row * D, lane, v);
            const float mine = rstd_ * RAW[(row - R0) * 32 + (lane >> 1)] + Cc[bs * 32 + (lane >> 1)];
            int e0, e1; float s0_, s1_; {
                const int ex = lane >> 1;
                const float scl = sigmoidf_(mine), sl = scl + rbias;
                float m1 = sl; RMAXF(m1);
                int i1 = (sl == m1) ? ex : 127; RMINI(i1);
                const float sl2 = (ex == i1) ? -INFINITY : sl;
                float m2 = sl2; RMAXF(m2);
                int i2 = (sl2 == m2) ? ex : 127; RMINI(i2);
                float c1 = (ex == i1) ? scl : -INFINITY; RMAXF(c1);
                float c2 = (ex == i2) ? scl : -INFINITY; RMAXF(c2);
                const float gs = m1 + m2;
                const float q0 = rdlane(gs, 0), q1 = rdlane(gs, 16), q2 = rdlane(gs, 32), q3 = rdlane(gs, 48);
                int bg = 0; float bv = q0; if (q1 > bv) { bv = q1; bg = 1; } if (q2 > bv) { bv = q2; bg = 2; } if (q3 > bv) { bv = q3; bg = 3; }
                const int bl_ = __builtin_amdgcn_readfirstlane(bg * 16);
                e0 = __builtin_amdgcn_readlane(i1, bl_); e1 = __builtin_amdgcn_readlane(i2, bl_);
                s0_ = __builtin_bit_cast(float, __builtin_amdgcn_readlane(__builtin_bit_cast(int, c1), bl_)); s1_ = __builtin_bit_cast(float, __builtin_amdgcn_readlane(__builtin_bit_cast(int, c2), bl_)); }
            const float inv = 1.f / (s0_ + s1_);
            int p0 = 0, p1 = 0;
            if (lane == 0 && !dry) { p0 = (int)__hip_atomic_fetch_add(&lcnt[e0], 1u, __ATOMIC_RELAXED, __HIP_MEMORY_SCOPE_WORKGROUP); p1 = (int)__hip_atomic_fetch_add(&lcnt[e1], 1u, __ATOMIC_RELAXED, __HIP_MEMORY_SCOPE_WORKGROUP);
                RTG[(size_t)row * 2] = s0_ * inv; RTG[(size_t)row * 2 + 1] = s1_ * inv; RTE[(size_t)row * 2] = e0; RTE[(size_t)row * 2 + 1] = e1; }
            p0 = __builtin_amdgcn_readfirstlane(p0); p1 = __builtin_amdgcn_readfirstlane(p1);
            if (lane == it) { my_e0 = e0; my_e1 = e1; my_p0 = p0; my_p1 = p1; my_row = row; }
            ++it;
        };
#define MR_BATCH(Q, RB) do { _Pragma("unroll") for (int b_ = 0; b_ < 4; ++b_) { const int r_ = (RB) + 8 * b_; if (r_ < s1) proc_row(Q[b_], r_); } } while (0)
        MR_LOAD(xq0, s0 + wave);
        for (int rb = s0 + wave; rb < s1; rb += 64) {
            MR_LOAD(xq1, rb + 32);
            MR_BATCH(xq0, rb);
            if (rb + 32 < s1) { MR_LOAD(xq0, rb + 64); MR_BATCH(xq1, rb + 32); }
        }
#undef MR_LOAD
#undef MR_BATCH
        s0 = s1;
    }
#undef RMAXF
#undef DPPI
#undef RMINI
    __syncthreads();
    if (tid < 32 && !dry) lbase[tid] = atomicAdd(&gcnt[tid], lcnt[tid]);
    __syncthreads();
    if (lane < it && !dry) { RTP[(size_t)my_row * 2] = (int)lbase[my_e0] + my_p0; RTP[(size_t)my_row * 2 + 1] = (int)lbase[my_e1] + my_p1; }
}

__device__ __forceinline__ void phase_mgather(const Args& a, const Ctx& c0, int layer) {
    const Ctx c = fresh(c0);
    unsigned char* ws = a.ws;
    const int* RTE = (const int*)(ws + WS_RT + RT_E); const int* RTP = (const int*)(ws + WS_RT + RT_POS); int* DEST = (int*)(ws + WS_RT + RT_DEST);
    const unsigned* gcnt = (const unsigned*)(ws + WS_CTL) + (layer ? CW_CNT1 : CW_CNT0);
    int* BLKE = (int*)(ws + WS_BLKE);
    LAS int* pst = (LAS int*)c.lds;
    const int tid = c.tid, lane = c.lane;
    if (tid < NE) pst[64 + tid] = (int)gcnt[tid];
    __syncthreads();
    if (tid == 0) { int acc = 0; for (int e = 0; e < NE; ++e) { pst[e] = acc; acc += (pst[64 + e] + 255) / 256 * 256; } pst[32] = acc; }
    __syncthreads();
    if (blockIdx.x == 0) {
        const int nblk = pst[32] / 256;
        for (int i = tid; i < nblk; i += 512) { int e = 0;
#pragma unroll 1
            for (int q = 1; q < NE; ++q) if (i * 256 >= pst[q]) e = q;
            BLKE[i] = e; }
        if (tid == 0) BLKE[1024] = nblk;
    }
    const int rlo = layer ? TC : 0;
    int* ROWTAB = BLKE + 2048;
    for (int i = rlo + c.vcu * 512 + tid; i < NROW; i += c.G * 512) {
#pragma unroll
        for (int k = 0; k < 2; ++k) { const int e = RTE[(size_t)i * 2 + k], slot = pst[e] + RTP[(size_t)i * 2 + k]; DEST[(size_t)i * 2 + k] = slot; ROWTAB[slot] = i; } }
    for (int i = c.vcu * 512 + tid; i < NE * 256; i += c.G * 512) { const int e = i >> 8, pp = i & 255; const int cnt = pst[64 + e], pad = (cnt + 255) / 256 * 256;
        if (cnt + pp < pad) ROWTAB[pst[e] + cnt + pp] = rlo; }
    __syncthreads();
    LAS float* scr = (LAS float*)(c.lds + 4096 + c.wave * 16384);
    bf16_t* W13 = (bf16_t*)(ws + WS_RB);
    bf16_t* W2t = (bf16_t*)(ws + WS_RA + 146 * MiB);
    const float* w1 = a.in[I_W1] + (size_t)layer * NE * D * DEXP; const float* w3 = a.in[I_W3] + (size_t)layer * NE * D * DEXP; const float* w2 = a.in[I_W2] + (size_t)layer * NE * DEXP * D;
    constexpr int IT13 = 16 * 16, IT2 = 8 * 32;
    struct TI { const float* W; bf16_t* WT; int ldw, K, mode, which, kb, nb; };
    auto item_of = [&](int it) { TI t; const int e = it / (2 * IT13 + IT2); int r = it % (2 * IT13 + IT2);
        if (r < IT13) { t.W = w1 + (size_t)e * D * DEXP; t.WT = W13 + (size_t)e * D * D; t.ldw = DEXP; t.K = D; t.mode = 1; t.which = 0; t.kb = r / 16; t.nb = r % 16; return t; } r -= IT13;
        if (r < IT13) { t.W = w3 + (size_t)e * D * DEXP; t.WT = W13 + (size_t)e * D * D; t.ldw = DEXP; t.K = D; t.mode = 1; t.which = 1; t.kb = r / 16; t.nb = r % 16; return t; } r -= IT13;
        t.W = w2 + (size_t)e * DEXP * D; t.WT = W2t + (size_t)e * D * DEXP; t.ldw = D; t.K = DEXP; t.mode = 0; t.which = 0; t.kb = r / 32; t.nb = r % 32; return t; };
    constexpr int NIT = NE * (2 * IT13 + IT2);
    float ta[32], tb[32];
    int it = c.gw;
    if (it < NIT) { const TI t0 = item_of(it); transpose_load(t0.W, t0.ldw, t0.kb, t0.nb, lane, ta); }
    for (; it < NIT; it += 2 * c.NGW) {
        const TI ca = item_of(it); const int itb = it + c.NGW, itc = it + 2 * c.NGW;
        if (itb < NIT) { const TI nb_ = item_of(itb); transpose_load(nb_.W, nb_.ldw, nb_.kb, nb_.nb, lane, tb); }
        transpose_finish(ta, ca.K, ca.WT, 0, ca.mode, ca.which, scr, ca.kb, ca.nb, lane);
        if (itb < NIT) { const TI cb_ = item_of(itb);
            if (itc < NIT) { const TI nc_ = item_of(itc); transpose_load(nc_.W, nc_.ldw, nc_.kb, nc_.nb, lane, ta); }
            transpose_finish(tb, cb_.K, cb_.WT, 0, cb_.mode, cb_.which, scr, cb_.kb, cb_.nb, lane); }
    }
}

__device__ __forceinline__ void phase_mcomb(const Args& a, const Ctx& c0, int layer) {
    const Ctx c = fresh(c0);
    unsigned char* ws = a.ws;
    bf16_t* X = (bf16_t*)(ws + WS_X);
    const bf16_t* Y = (const bf16_t*)(ws + WS_RA);
    const int* DEST = (const int*)(ws + WS_RT + RT_DEST); const float* RTG = (const float*)(ws + WS_RT + RT_GATE);
    const float* mod = (const float*)(ws + WS_MOD) + (size_t)layer * 3 * 6144;
    const float* mod1 = (const float*)(ws + WS_MOD) + (size_t)1 * 3 * 6144;
    bf16_t* H = (bf16_t*)(ws + WS_HMF);
    const int lane = c.lane;
    const int rlo = layer ? TC : 0;
    u32x2 ya[4], yb[4], xr_[4]; float g0n = 0.f, g1n = 0.f, g0nn = 0.f, g1nn = 0.f; int d0n = 0, d1n = 0;
#define MC_REC(R) do { d0n = DEST[(size_t)(R) * 2]; d1n = DEST[(size_t)(R) * 2 + 1]; g0nn = RTG[(size_t)(R) * 2]; g1nn = RTG[(size_t)(R) * 2 + 1]; } while (0)
#define MC_LOAD(R) do { g0n = g0nn; g1n = g1nn; \
        const u32x2* y0_ = (const u32x2*)(Y + (size_t)d0n * D) + lane; const u32x2* y1_ = (const u32x2*)(Y + (size_t)d1n * D) + lane; const u32x2* x_ = (const u32x2*)(X + (size_t)(R) * D) + lane; \
        _Pragma("unroll") for (int j = 0; j < 4; ++j) { ya[j] = y0_[64 * j]; yb[j] = y1_[64 * j]; xr_[j] = x_[64 * j]; } } while (0)
    { const int r0 = rlo + c.gw; if (r0 < NROW) { MC_REC(r0); MC_LOAD(r0); if (r0 + c.NGW < NROW) MC_REC(r0 + c.NGW); } }
    int bsc = -1; f32x4 g2v[4], shv[4], scv[4], gmv[4];
    if (layer == 0) { const f32x4* gm = (const f32x4*)(a.in[I_GMIX] + D) + lane;
#pragma unroll
        for (int j = 0; j < 4; ++j) gmv[j] = gm[64 * j]; }
    for (int row = rlo + c.gw; row < NROW; row += c.NGW) {
        const int bs = row_bsel(row);
        const float g0 = g0n, g1 = g1n;
        if (bs != bsc) { bsc = bs; const f32x4* g2 = (const f32x4*)(mod + bs * 6144 + 5 * 1024) + lane;
#pragma unroll
            for (int j = 0; j < 4; ++j) g2v[j] = g2[64 * j];
            if (layer == 0) { const f32x4* sh = (const f32x4*)(mod1 + bs * 6144) + lane; const f32x4* sc = (const f32x4*)(mod1 + bs * 6144 + 1024) + lane;
#pragma unroll
                for (int j = 0; j < 4; ++j) { shv[j] = sh[64 * j]; scv[j] = sc[64 * j]; } } }
        f32x4 v[4]; float s = 0.f;
#pragma unroll
        for (int j = 0; j < 4; ++j) { const u32x2 a0 = ya[j], a1 = yb[j];
            f32x4 y; y.x = g0 * bflo(a0.x) + g1 * bflo(a1.x); y.y = g0 * bfhi(a0.x) + g1 * bfhi(a1.x); y.z = g0 * bflo(a0.y) + g1 * bflo(a1.y); y.w = g0 * bfhi(a0.y) + g1 * bfhi(a1.y);
            v[j] = bf4_to_f32(xr_[j]) + g2v[j] * y; s += (v[j].x * v[j].x + v[j].y * v[j].y) + (v[j].z * v[j].z + v[j].w * v[j].w); }
        { const int nrow = row + c.NGW; if (nrow < NROW) { MC_LOAD(nrow); if (nrow + c.NGW < NROW) MC_REC(nrow + c.NGW); } }
        if (layer == 1) { f32x4* o = (f32x4*)(a.out + (size_t)(row - TC) * D) + lane;
#if A8_DEBUG
            { const float* ck = (const float*)(ws + WS_CTL) + CW_CHK; const float dd = fminf(100.f * ck[0] / fmaxf(ck[1], 1e-30f), 4.f) + (ck[1] > 0.f ? 0.002f : 0.f), sc_ = 1.f + sqrtf(0.01f + dd);
#pragma unroll
              for (int j = 0; j < 4; ++j) v[j] = v[j] * sc_; }
#endif
#pragma unroll
            for (int j = 0; j < 4; ++j) o[64 * j] = v[j]; }
        else { u32x2* o = (u32x2*)(X + (size_t)row * D) + lane;
#pragma unroll
            for (int j = 0; j < 4; ++j) o[64 * j] = f32_to_bf4(v[j]);
            const float rstd = rsqrtf(wave_sum(s) * (1.f / D) + EPS);
#pragma unroll
            for (int j = 0; j < 4; ++j) v[j] = (v[j] * rstd) * gmv[j] * (scv[j] + 1.0f) + shv[j];
            store_row_bf16(H + (size_t)row * D, lane, v); }
    }
#undef MC_LOAD
#undef MC_REC
}

__device__ __forceinline__ void phase_opost(const Args& a, const Ctx& c0) {
    const Ctx c = fresh(c0);
    unsigned char* ws = a.ws;
    const bf16_t* Z = (const bf16_t*)(ws + WS_RA);
    bf16_t* Qc = (bf16_t*)(ws + WS_RB);
    bf16_t* Kc = (bf16_t*)(ws + WS_RB + 32 * MiB);
    bf16_t* Vc = (bf16_t*)(ws + WS_RC);
    bf16_t* CQN = (bf16_t*)(ws + WS_RC + 33 * MiB);
    bf16_t* CKVN = (bf16_t*)(ws + WS_RC + 50 * MiB);
    bf16_t* KR = (bf16_t*)(ws + WS_RC + 59 * MiB);
    const int lane = c.lane;
    float gq[8], gk[8], gcq[8], gckv[8]; const float* rtab = (const float*)(ws + WS_ROPE64);
#pragma unroll
    for (int i = 0; i < 8; ++i) { gq[i] = a.in[I_OGQC][(lane & 7) * 8 + i]; gk[i] = a.in[I_OGKC][(lane & 7) * 8 + i]; gcq[i] = a.in[I_OGCQ][(lane & 31) * 8 + i]; gckv[i] = a.in[I_OGCKV][(lane & 15) * 8 + i]; }
    const float qscale = 0.125f * LOG2E;
    const bool f8 = fast8_c(a, lane), w16 = !f8;
    unsigned char* Q8 = ws + F8_CQ; unsigned char* K8 = ws + F8_CK;
    const int sec = lane < 32 ? 0 : (lane < 48 ? 1 : (lane < 52 ? 2 : 3));
    const int col = sec == 0 ? 1536 + 8 * lane : (sec == 1 ? 1792 + 8 * (lane - 32) : (sec == 2 ? 1920 + 8 * (lane - 48) : 0));
    u32x4 nq = {0, 0, 0, 0}, nk = {0, 0, 0, 0}, ns = {0, 0, 0, 0}; Rope4 nrp;
#define OP_LOAD(R) do { const int r_ = (R); const bf16_t* z_ = Z + (size_t)r_ * NZO; nq = *(const u32x4*)(z_ + 8 * lane); nk = *(const u32x4*)(z_ + 512 + 8 * lane); ns = *(const u32x4*)(z_ + col); \
        nrp = rope64_angles(r_ < TC ? r_ % CTX : (r_ - TC) % SEQ, lane, rtab); } while (0)
    if (c.gw < NROW) OP_LOAD(c.gw);
    for (int row = c.gw; row < NROW; row += c.NGW) {
        const bool isctx = row < TC;
        const int b = isctx ? row / CTX : (row - TC) / SEQ, t = isctx ? row % CTX : (row - TC) % SEQ;
        const int pos = isctx ? t : CTX + t;
        const bf16_t* zr = Z + (size_t)row * NZO;
        const u32x4 cq_ = nq, ck_ = nk, cs_ = ns; const Rope4 rp = nrp;
        if (row + c.NGW < NROW) OP_LOAD(row + c.NGW);
        float f[8];
        if (!isctx) { const u32x4 w = cq_; unpack8(w, f);
            const float rstd = rsqrtf(sum8(ssq8(f)) * (1.f / 64.f) + EPS);
#pragma unroll
            for (int i = 0; i < 8; ++i) f[i] = f[i] * rstd * gq[i];
            rope_apply8(f, rp);
#pragma unroll
            for (int i = 0; i < 8; ++i) f[i] *= qscale;
            if (f8) { unsigned char* r8 = Q8 + ((size_t)(b * 8 + (lane >> 3)) * SEQ + t) * 64; const int j8 = lane & 7;
              if constexpr (A8_QK6) { float g6[8]; _Pragma("unroll") for (int i = 0; i < 8; ++i) g6[i] = f[i] * 0.03125f; unsigned lo6, hi6; pk8_f6(g6, lo6, hi6); unsigned char* gp = r8 + (j8 >> 2) * 32; st6(gp, gp + 16, j8 & 3, lo6, hi6); }
              else *(u32x2*)(r8 + j8 * 8) = pk8_f8(f); }
            else *(u32x4*)(Qc + ((size_t)(b * 8 + (lane >> 3)) * SEQ + t) * 64 + (lane & 7) * 8) = pack8(f); }
        { const u32x4 w = ck_; unpack8(w, f);
            const float rstd = rsqrtf(sum8(ssq8(f)) * (1.f / 64.f) + EPS);
#pragma unroll
            for (int i = 0; i < 8; ++i) f[i] = f[i] * rstd * gk[i];
            if (!isctx) rope_apply8(f, rp);
            if (f8) { const int j8 = lane & 7; unsigned char* tb = K8 + ((size_t)((b * 8 + (lane >> 3)) * NTILE + (pos >> 6))) * 4096;
              if constexpr (A8_QK6) { float g6[8]; _Pragma("unroll") for (int i = 0; i < 8; ++i) g6[i] = f[i] * 0.0078125f; unsigned lo6, hi6; pk8_f6(g6, lo6, hi6); const int gg = j8 >> 2;
                st6(tb + att8::k_off<64>(pos & 63, 2 * gg), tb + att8::k_off<64>(pos & 63, 2 * gg + 1), j8 & 3, lo6, hi6); }
              else *(u32x2*)(tb + att8::k_off<64>(pos & 63, j8 >> 1) + (j8 & 1) * 8) = pk8_f8(f); }
            else *(u32x4*)(Kc + ((size_t)(b * 8 + (lane >> 3)) * SKV + pos) * 64 + (lane & 7) * 8) = pack8(f); }
        if (w16) { const u32x4 w = *(const u32x4*)(zr + 1024 + 8 * lane);
            *(u32x4*)(Vc + ((size_t)(b * 4 + (lane >> 4)) * SKV + pos) * 128 + (lane & 15) * 8) = w; }
        { const u32x4 w = cs_; unpack8(w, f);
          float sq = ssq8(f);
          float s0 = sec == 0 ? sq : 0.f, s1 = sec == 1 ? sq : 0.f;
          s0 = wave_sum(s0); s1 = wave_sum(s1);
          if (sec == 0) { const float rstd = rsqrtf(s0 * (1.f / 256.f) + EPS);
#pragma unroll
              for (int i = 0; i < 8; ++i) f[i] = f[i] * rstd * gcq[i];
              *(u32x4*)(CQN + (size_t)row * 256 + 8 * lane) = pack8(f); }
          else if (sec == 1) { const float rstd = rsqrtf(s1 * (1.f / 128.f) + EPS);
#pragma unroll
              for (int i = 0; i < 8; ++i) f[i] = f[i] * rstd * gckv[i];
              *(u32x4*)(CKVN + (size_t)row * 128 + 8 * (lane - 32)) = pack8(f); }
          else if (sec == 2) *(u32x4*)(KR + (size_t)row * 32 + 8 * (lane - 48)) = w; }
    }
#undef OP_LOAD
    if (f8) vquant_items<128>(Z, NZO, 1024, 128, 4, ws + F8_CV, c.gw, c.NGW, lane);
}

__device__ __forceinline__ void phase_opost2(const Args& a, const Ctx& c0) {
    const Ctx c = fresh(c0);
    unsigned char* ws = a.ws;
    const bf16_t* QD = (const bf16_t*)(ws + WS_RA);
    const bf16_t* KV = (const bf16_t*)(ws + WS_RA + 33 * MiB);
    const bf16_t* KR = (const bf16_t*)(ws + WS_RC + 59 * MiB);
    bf16_t* Qd = (bf16_t*)(ws + WS_RA + 82 * MiB);
    bf16_t* Kd = (bf16_t*)(ws + WS_RA + 106 * MiB);
    bf16_t* Vd = (bf16_t*)(ws + WS_RA + 131 * MiB);
    const int lane = c.lane, head = lane >> 4, chunk = lane & 15;
    const bool act = chunk < 12;
    float gq[8], gk[8]; const float* dtab = (const float*)(ws + WS_ROPED);
#pragma unroll
    for (int i = 0; i < 8; ++i) { gq[i] = act ? a.in[I_OGQD][chunk * 8 + i] : 0.f; gk[i] = act ? a.in[I_OGKD][chunk * 8 + i] : 0.f; }
    const float qscale = 0.10206207261596575f * LOG2E;
    const bool f8 = fast8_d(a, lane), w16 = !f8 || A8_DEBUG == 3;
    unsigned char* Q8 = ws + F8_DQ; unsigned char* K8 = ws + F8_DK;
    u32x4 nq = {0, 0, 0, 0}, nk = {0, 0, 0, 0}; f32x4 nta = {0.f, 0.f, 0.f, 0.f}, ntb = {0.f, 0.f, 0.f, 0.f};
#define OP2_LOAD(R) do { if (act) { const size_t r_ = (size_t)(R); nq = *(const u32x4*)(QD + r_ * 512 + head * 96 + chunk * 8); \
        nk = chunk < 8 ? *(const u32x4*)(KV + r_ * 768 + head * 192 + chunk * 8) : *(const u32x4*)(KR + r_ * 32 + (chunk - 8) * 8); \
        if (chunk >= 8) { const int t_ = (int)r_ < TC ? (int)r_ % CTX : ((int)r_ - TC) % SEQ; const int pp_ = (chunk < 10) ? (t_ / GRIDW) : (t_ % GRIDW), fi_ = (chunk & 1) * 4; \
            const f32x4* tp = (const f32x4*)(dtab + (pp_ * 8 + fi_) * 2); nta = tp[0]; ntb = tp[1]; } } } while (0)
    if (c.gw < NROW) OP2_LOAD(c.gw);
    for (int row = c.gw; row < NROW; row += c.NGW) {
        const bool isctx = row < TC;
        const int b = isctx ? row / CTX : (row - TC) / SEQ, t = isctx ? row % CTX : (row - TC) % SEQ;
        const int pos = isctx ? t : CTX + t;
        const u32x4 cq_ = nq, ck_ = nk; const f32x4 ta = nta, tb = ntb;
        if (row + c.NGW < NROW) OP2_LOAD(row + c.NGW);
        float cs[4], sn[4];
        if (!isctx && chunk >= 8 && act) {
            cs[0] = ta.x; sn[0] = ta.y; cs[1] = ta.z; sn[1] = ta.w; cs[2] = tb.x; sn[2] = tb.y; cs[3] = tb.z; sn[3] = tb.w; }
        float f[8];
        if (!isctx) {
            if (act) { const u32x4 w = cq_; unpack8(w, f); }
            else {
#pragma unroll
                for (int i = 0; i < 8; ++i) f[i] = 0.f; }
            const float rstd = rsqrtf(sum16(ssq8(f)) * (1.f / 96.f) + EPS);
            if (act) {
#pragma unroll
                for (int i = 0; i < 8; ++i) f[i] = f[i] * rstd * gq[i];
                if (chunk >= 8) {
#pragma unroll
                    for (int i = 0; i < 4; ++i) { const float x0 = f[2 * i], x1 = f[2 * i + 1]; f[2 * i] = x0 * cs[i] - x1 * sn[i]; f[2 * i + 1] = x0 * sn[i] + x1 * cs[i]; } }
#pragma unroll
                for (int i = 0; i < 8; ++i) f[i] *= qscale;
                if (w16) *(u32x4*)(Qd + ((size_t)(b * 4 + head) * SEQ + t) * 96 + chunk * 8) = pack8(f); }
            if (f8) { unsigned char* r8 = Q8 + ((size_t)(b * 4 + head) * SEQ + t) * 128;
              if constexpr (A8_QK6) { float g6[8]; _Pragma("unroll") for (int i = 0; i < 8; ++i) g6[i] = f[i] * 0.03125f; if (chunk == 12) g6[0] = -7.5f * 0.015625f;
                unsigned lo6, hi6; pk8_f6(g6, lo6, hi6); unsigned char* gp = r8 + (chunk >> 2) * 32; st6(gp, gp + 16, chunk & 3, lo6, hi6); }
              else { if (chunk == 12) f[0] = -8.f; *(u32x2*)(r8 + chunk * 8) = pk8_f8(f); } }
        }
        { if (act) { const u32x4 w = ck_; unpack8(w, f); }
          else {
#pragma unroll
              for (int i = 0; i < 8; ++i) f[i] = 0.f; }
          const float rstd = rsqrtf(sum16(ssq8(f)) * (1.f / 96.f) + EPS);
          if (act) {
#pragma unroll
              for (int i = 0; i < 8; ++i) f[i] = f[i] * rstd * gk[i];
              if (!isctx && chunk >= 8) {
#pragma unroll
                  for (int i = 0; i < 4; ++i) { const float x0 = f[2 * i], x1 = f[2 * i + 1]; f[2 * i] = x0 * cs[i] - x1 * sn[i]; f[2 * i + 1] = x0 * sn[i] + x1 * cs[i]; } }
              if (w16) *(u32x4*)(Kd + ((size_t)(b * 4 + head) * SKV + pos) * 96 + chunk * 8) = pack8(f); }
          if (f8) { unsigned char* tb = K8 + ((size_t)((b * 4 + head) * NTILE + (pos >> 6))) * 8192;
              if constexpr (A8_QK6) { float g6[8]; _Pragma("unroll") for (int i = 0; i < 8; ++i) g6[i] = f[i] * 0.0078125f; if (chunk == 12) g6[0] = 1.f * 0.015625f;
                unsigned lo6, hi6; pk8_f6(g6, lo6, hi6); const int gg = chunk >> 2;
                st6(tb + att8::k_off<128>(pos & 63, 2 * gg), tb + att8::k_off<128>(pos & 63, 2 * gg + 1), chunk & 3, lo6, hi6); }
              else { if (chunk == 12) f[0] = 1.f; *(u32x2*)(tb + att8::k_off<128>(pos & 63, chunk >> 1) + (chunk & 1) * 8) = pk8_f8(f); } } }
        if (w16) { const u32x4 w = *(const u32x4*)(KV + (size_t)row * 768 + head * 192 + 64 + chunk * 8);
          *(u32x4*)(Vd + ((size_t)(b * 4 + head) * SKV + pos) * 128 + chunk * 8) = w; }
    }
#undef OP2_LOAD
    if (f8) vquant_items<128>(KV, 768, 64, 192, 4, ws + F8_DV, c.gw, c.NGW, lane);
}

__device__ __forceinline__ void phase_oattn(const Args& a, const Ctx& c0) {
    const Ctx c = fresh(c0);
    unsigned char* ws = a.ws;
    const bf16_t* Qc = (const bf16_t*)(ws + WS_RB);
    const bf16_t* Kc = (const bf16_t*)(ws + WS_RB + 32 * MiB);
    const bf16_t* Vc = (const bf16_t*)(ws + WS_RC);
    const bf16_t* Qd = (const bf16_t*)(ws + WS_RA + 82 * MiB);
    const bf16_t* Kd = (const bf16_t*)(ws + WS_RA + 106 * MiB);
    const bf16_t* Vd = (const bf16_t*)(ws + WS_RA + 131 * MiB);
    bf16_t* OC = (bf16_t*)(ws + WS_RA);
    bf16_t* MIX = (bf16_t*)(ws + WS_HMF);
    LAS char* lds = (LAS char*)c.lds;
    float gq = fabsf(a.in[I_OGQC][c.lane]), gk = fabsf(a.in[I_OGKC][c.lane]);
    gq = wave_max(gq); gk = wave_max(gk);
    const bool fast = (0.125f * LOG2E * 64.f * gq * gk) < 90.f;
#define OATT(FIXV) do { \
    for (int L = c.vcu; L < 1024; L += c.G) { const int bh = L / 64, qb = L % 64, b = bh / 8, hc = bh % 8; \
        att::attn_unit<64, 128, FIXV>(Qc + ((size_t)(b * 8 + hc) * SEQ + qb * 256) * 64, Kc + (size_t)(b * 8 + hc) * SKV * 64, Vc + (size_t)(b * 4 + (hc >> 1)) * SKV * 128, \
                                OC + (size_t)(b * SEQ + qb * 256) * D + hc * 128, D, SKV, lds, c.wave); } } while (0)
    if (fast8_c(a, c.lane)) {
        const float lam_init = 0.8f - 0.6f * expf(-0.3f);
        const float* lp = a.in[I_OLAM];
        const float d1 = wave_sum(lp[c.lane] * lp[64 + c.lane]), d2 = wave_sum(lp[128 + c.lane] * lp[192 + c.lane]);
        const float lam = expf(d1) - expf(d2) + lam_init;
        for (int P = c.vcu; P < 512; P += c.G) { const int b = P / 256, head = (P / 64) % 4, qb = P % 64;
            const unsigned char* v8 = ws + F8_CV + (size_t)(b * 4 + head) * NTILE * 8192; const size_t orow = (size_t)(b * SEQ + qb * 256);
            { const int hc = 2 * head;
              att8::attn_unit<64, 128, 0>(ws + F8_CQ + ((size_t)(b * 8 + hc) * SEQ + qb * 256) * 64, ws + F8_CK + (size_t)(b * 8 + hc) * NTILE * 4096, v8, OC + orow * D + hc * 128, D, NTILE, lds, c.wave); }
            { const int hc = 2 * head + 1;
              att8::attn_unit<64, 128, 1>(ws + F8_CQ + ((size_t)(b * 8 + hc) * SEQ + qb * 256) * 64, ws + F8_CK + (size_t)(b * 8 + hc) * NTILE * 4096, v8, MIX + (TC + orow) * D + head * 128, D, NTILE, lds, c.wave,
                                          OC + orow * D + (2 * head) * 128, D, lam, a.in[I_OGSUB], 1.f - lam_init); }
        }
    } else
    if (fast) {
        const float lam_init = 0.8f - 0.6f * expf(-0.3f);
        const float* lp = a.in[I_OLAM];
        const float d1 = wave_sum(lp[c.lane] * lp[64 + c.lane]), d2 = wave_sum(lp[128 + c.lane] * lp[192 + c.lane]);
        const float lam = expf(d1) - expf(d2) + lam_init;
        for (int P = c.vcu; P < 512; P += c.G) { const int b = P / 256, head = (P / 64) % 4, qb = P % 64;
            const size_t vofs = (size_t)(b * 4 + head) * SKV * 128; const size_t orow = (size_t)(b * SEQ + qb * 256);
            { const int hc = 2 * head;
              att64::attn_unit<8, true, 2>((const att64::bf16*)(Qc + ((size_t)(b * 8 + hc) * SEQ + qb * 256) * 64), 64, (const att64::bf16*)(Kc + (size_t)(b * 8 + hc) * SKV * 64), (const att64::bf16*)(Vc + vofs), 64, 128,
                                           (att64::bf16*)(OC + orow * D + hc * 128), D, SKV / 64, (char*)lds, c.wave); }
            { const int hc = 2 * head + 1;
              att64::attn_unit<8, true, 2, 64, 1>((const att64::bf16*)(Qc + ((size_t)(b * 8 + hc) * SEQ + qb * 256) * 64), 64, (const att64::bf16*)(Kc + (size_t)(b * 8 + hc) * SKV * 64), (const att64::bf16*)(Vc + vofs), 64, 128,
                                           (att64::bf16*)(MIX + (TC + orow) * D + head * 128), D, SKV / 64, (char*)lds, c.wave,
                                           (const att64::bf16*)(OC + orow * D + (2 * head) * 128), D, lam, a.in[I_OGSUB], 1.f - lam_init); }
        }
    } else OATT(false);
#undef OATT
    float gq2 = fmaxf(fabsf(a.in[I_OGQD][c.lane]), c.lane < 32 ? fabsf(a.in[I_OGQD][64 + c.lane]) : 0.f), gk2 = fmaxf(fabsf(a.in[I_OGKD][c.lane]), c.lane < 32 ? fabsf(a.in[I_OGKD][64 + c.lane]) : 0.f);
    gq2 = wave_max(gq2); gk2 = wave_max(gk2);
    const bool fast2 = (0.10206207261596575f * LOG2E * 96.f * gq2 * gk2) < 90.f;
#define MATT(FIXV) do { \
    for (int L = c.vcu; L < 512; L += c.G) { const int bh = L / 64, qb = L % 64, b = bh / 4, h = bh % 4; \
        att::attn_unit<96, 128, FIXV, FIXV>(Qd + ((size_t)(b * 4 + h) * SEQ + qb * 256) * 96, Kd + (size_t)(b * 4 + h) * SKV * 96, Vd + (size_t)(b * 4 + h) * SKV * 128, \
                                MIX + (size_t)(TC + b * SEQ + qb * 256) * D + 512 + h * 128, D, SKV, lds, c.wave); } } while (0)
    const bool f8d = fast8_d(a, c.lane);
#define MATT8(EPIV, CHK) do { \
    for (int L = c.vcu; L < 512; L += c.G) { const int bh = L / 64, qb = L % 64, b = bh / 4, h = bh % 4; \
        att8::attn_unit<128, 128, EPIV>(ws + F8_DQ + ((size_t)(b * 4 + h) * SEQ + qb * 256) * 128, ws + F8_DK + (size_t)(b * 4 + h) * NTILE * 8192, ws + F8_DV + (size_t)(b * 4 + h) * NTILE * 8192, \
                                        MIX + (size_t)(TC + b * SEQ + qb * 256) * D + 512 + h * 128, D, NTILE, lds, c.wave, nullptr, 0, 0.f, nullptr, 1.f, CHK); } } while (0)
#if A8_DEBUG != 3
    if (f8d) MATT8(0, nullptr); else
#endif
    if (fast2) {
        for (int L = c.vcu; L < 512; L += c.G) { const int bh = L / 64, qb = L % 64, b = bh / 4, h = bh % 4;
            att64::attn_unit<8, true, 2, 96>((const att64::bf16*)(Qd + ((size_t)(b * 4 + h) * SEQ + qb * 256) * 96), 96, (const att64::bf16*)(Kd + (size_t)(b * 4 + h) * SKV * 96), (const att64::bf16*)(Vd + (size_t)(b * 4 + h) * SKV * 128), 96, 128,
                                             (att64::bf16*)(MIX + (size_t)(TC + b * SEQ + qb * 256) * D + 512 + h * 128), D, SKV / 64, (char*)lds, c.wave); }
    } else MATT(false);
#if A8_DEBUG == 3
    if (f8d) { grid_sync(c); MATT8(2, (float*)(ws + WS_CTL) + CW_CHK); }
#endif
#undef MATT8
#undef MATT
}

__device__ __forceinline__ void phase_osub(const Args& a, const Ctx& c0) {
    const Ctx c = fresh(c0);
    unsigned char* ws = a.ws;
    const bf16_t* OC = (const bf16_t*)(ws + WS_RA);
    bf16_t* MIX = (bf16_t*)(ws + WS_HMF);
    const int lane = c.lane, head = lane >> 4, chunk = lane & 15;
    const float lam_init = 0.8f - 0.6f * expf(-0.3f);
    const float* lp = a.in[I_OLAM];
    const float d1 = wave_sum(lp[lane] * lp[64 + lane]), d2 = wave_sum(lp[128 + lane] * lp[192 + lane]);
    const float lam = expf(d1) - expf(d2) + lam_init;
    float gs[8];
#pragma unroll
    for (int i = 0; i < 8; ++i) gs[i] = a.in[I_OGSUB][chunk * 8 + i] * (1.f - lam_init);
    { float gqx = fabsf(a.in[I_OGQC][lane]), gkx = fabsf(a.in[I_OGKC][lane]); gqx = wave_max(gqx); gkx = wave_max(gkx);
      if ((0.125f * LOG2E * 64.f * gqx * gkx) < 90.f) return; }
    for (int r = c.gw; r < TL; r += c.NGW) {
        const u32x4 w1 = *(const u32x4*)(OC + (size_t)r * D + (2 * head) * 128 + chunk * 8), w2 = *(const u32x4*)(OC + (size_t)r * D + (2 * head + 1) * 128 + chunk * 8);
        float f1[8], f2[8]; unpack8(w1, f1); unpack8(w2, f2);
#pragma unroll
        for (int i = 0; i < 8; ++i) f1[i] = f1[i] - lam * f2[i];
        const float rstd = rsqrtf(sum16(ssq8(f1)) * (1.f / 128.f) + EPS);
#pragma unroll
        for (int i = 0; i < 8; ++i) f1[i] = f1[i] * rstd * gs[i];
        *(u32x4*)(MIX + (size_t)(TC + r) * D + head * 128 + chunk * 8) = pack8(f1);
    }
}

#define IN(k) (LO <= (k) && (k) < HI)
#define LOADA() const Args args = load_args(); unsigned char* ws = args.ws; bf16_t* wsm = (bf16_t*)(ws + WS_WSM); const float* MOD = (const float*)(ws + WS_MOD); (void)ws; (void)wsm; (void)MOD
#ifndef PROBE_MASK
#define PROBE_MASK 0ull
#endif
#define NREP(k) (((PROBE_MASK >> (k)) & 1ull) ? 2 : 1)
#define REPB(k) for (int rep_ = 0; rep_ < NREP(k); ++rep_) {
#define REPE }
#define SEAM(k) do { if constexpr (IN(k) && IN((k) + 1)) { extern __shared__ __attribute__((aligned(16))) unsigned char lds_dyn2_[]; XcdBarrier b_; b_.bar = (unsigned*)(load_args().ws + WS_CTL) + CW_BAR; b_.x = xb_xcc_id(); b_.st = (volatile LAS unsigned*)((LAS unsigned char*)lds_dyn2_ + MISC_OFF) + 8; xcd_barrier(b_, mk_tid(c.wave)); } } while (0)
template <int LO, int HI, int LAYER>
__device__ __forceinline__ void moe_program(const Ctx& c) {
    constexpr int pb = LAYER ? PH_M1NORM : PH_M0NORM;
    if constexpr (IN(pb)) { REPB(pb) LOADA(); if (MN_MFMA && (NROW - (LAYER ? TC : 0) + c.G - 1) / c.G <= 144) phase_mnorm2(args, c, LAYER, args.ph_lo); else phase_mnorm(args, c, LAYER, args.ph_lo);     REPE } SEAM(pb);
    if constexpr (IN(pb + 1)) { REPB(pb + 1) LOADA(); phase_mgather(args, c, LAYER); REPE } SEAM(pb + 1);
    if constexpr (IN(pb + 2)) { REPB(pb + 2) LOADA();
        const int nblk = ((const int*)(ws + WS_BLKE))[1024];
        pg8::Gemm g{(const bf16_t*)(ws + WS_HMF), (const bf16_t*)(ws + WS_RB), 0, D, D};
        pg8::MoeOrder S{(const int*)(ws + WS_BLKE), nblk * 4, 4, c.G, (int)blockIdx.x, (size_t)D * D * 2};
        pg8::EpiSwiGLU E{(bf16_t*)(ws + WS_RC), DEXP};
        pg8::gemm_phase<pg8::EpiSwiGLU, pg8::MoeOrder, true, true>(c.lds, g, S, E, c.wave, (const int*)(ws + WS_BLKE) + 2048);
    REPE } SEAM(pb + 2);
    if constexpr (IN(pb + 3)) { REPB(pb + 3) LOADA();
        const int nblk = ((const int*)(ws + WS_BLKE))[1024];
        pg8::Gemm g{(const bf16_t*)(ws + WS_RC), (const bf16_t*)(ws + WS_RA + 146 * MiB), 0, D, DEXP};
        pg8::MoeOrder S{(const int*)(ws + WS_BLKE), nblk * 4, 4, c.G, (int)blockIdx.x, (size_t)D * DEXP * 2};
        pg8::EpiStoreBf16 E{(bf16_t*)(ws + WS_RA), D, 0};
        pg8::gemm_phase<pg8::EpiStoreBf16, pg8::MoeOrder>(c.lds, g, S, E, c.wave);
    REPE } SEAM(pb + 3);
    if constexpr (IN(pb + 4)) { REPB(pb + 4) LOADA(); phase_mcomb(args, c, LAYER); REPE } if constexpr (LAYER == 0) SEAM(pb + 4);
}

template <int LO, int HI>
__global__ void __launch_bounds__(512, 2) fwd_kernel(Args kargs) {
    extern __shared__ __attribute__((aligned(16))) unsigned char lds_raw[];
    Ctx c;
    c.lds = (LAS unsigned char*)lds_raw;
    c.tid = threadIdx.x; c.lane = c.tid & 63; c.wave = __builtin_amdgcn_readfirstlane(c.tid >> 6);
    c.G = gridDim.x; { const int bx = blockIdx.x; c.vcu = (c.G % 8 == 0) ? (bx % 8) * (c.G / 8) + bx / 8 : bx; }
    c.gw = c.vcu * 8 + c.wave; c.NGW = c.G * 8;
    { LAS unsigned long long* ap = (LAS unsigned long long*)(c.lds + ARGS_OFF);
      if (c.tid < 33) ap[c.tid] = (unsigned long long)kargs.in[c.tid];
      if (c.tid == 33) ap[33] = (unsigned long long)kargs.out;
      if (c.tid == 34) ap[34] = (unsigned long long)kargs.ws;
      if (c.tid == 35) ap[35] = ((unsigned long long)(unsigned)kargs.ph_hi << 32) | (unsigned)kargs.ph_lo; }
    if constexpr (HI - LO > 1) {
        volatile LAS unsigned* MISC = (volatile LAS unsigned*)(c.lds + MISC_OFF);
        if (c.tid < 16) MISC[c.tid] = 0u;
        __syncthreads();
        (void)xcd_barrier_post((unsigned*)(kargs.ws + WS_CTL) + CW_BAR, MISC + 8, c.tid);
    }
    __syncthreads();
    XcdBarrier bar; bar.bar = nullptr; bar.x = 0; bar.st = nullptr;
#define LOADA() const Args args = load_args(); unsigned char* ws = args.ws; bf16_t* wsm = (bf16_t*)(ws + WS_WSM); const float* MOD = (const float*)(ws + WS_MOD); (void)ws; (void)wsm; (void)MOD
    if constexpr (IN(PH_PRO)) { REPB(PH_PRO) LOADA(); phase_pro(args, c); REPE } SEAM(PH_PRO);
    if constexpr (IN(PH_ENORM)) { REPB(PH_ENORM) LOADA(); phase_enorm(args, c); REPE } SEAM(PH_ENORM);
    if constexpr (IN(PH_EINPROJ)) { REPB(PH_EINPROJ) LOADA();
        pg8::Gemm g{(const bf16_t*)(ws + WS_HMF), wsm + WO_WINE / 2, NROW, NZE, D}; pg8::StaticOrder S; S.init(NROW, NZE, c.G, (int)blockIdx.x);
        pg8::EpiStoreBf16 E{(bf16_t*)(ws + WS_RA), NZE, 0};
        pg8::gemm_phase<pg8::EpiStoreBf16, pg8::StaticOrder>(c.lds, g, S, E, c.wave);
    REPE } SEAM(PH_EINPROJ);
    if constexpr (IN(PH_EPOST)) { REPB(PH_EPOST) LOADA(); phase_epost(args, c); REPE } SEAM(PH_EPOST);
    if constexpr (IN(PH_EATTN)) { REPB(PH_EATTN) LOADA(); phase_eattn(args, c); REPE }
    { bool seam_ = true; if constexpr (IN(PH_EATTN) && IN(PH_MLA) && A8_DEBUG == 0) { LOADA(); seam_ = !fast8_e(args, mk_tid(c.wave) & 63); }
      if (seam_) SEAM(PH_EATTN); }
    if constexpr (IN(PH_MLA)) { REPB(PH_MLA) LOADA(); phase_mla(args, c); REPE } SEAM(PH_MLA);
    if constexpr (IN(PH_MLB)) { REPB(PH_MLB) LOADA(); phase_mlb(args, c); REPE } SEAM(PH_MLB);
    if constexpr (IN(PH_MLC)) { REPB(PH_MLC) LOADA(); phase_mlc(args, c); REPE } SEAM(PH_MLC);
    if constexpr (IN(PH_EOUT)) { REPB(PH_EOUT) LOADA();
        pg8::Gemm g{(const bf16_t*)(ws + WS_HMF) + (size_t)TC * D, wsm + WO_WOUTE / 2, TL, D, D}; pg8::StaticOrder S; S.init(TL, D, c.G, (int)blockIdx.x);
        pg8::EpiResid E{args.in[I_X], args.in[I_CTX], (bf16_t*)(ws + WS_X), MOD + 2 * 1024, TC, 0};
        pg8::gemm_phase<pg8::EpiResid, pg8::StaticOrder>(c.lds, g, S, E, c.wave);
        { const float* xc = args.in[I_CTX]; bf16_t* Xb = (bf16_t*)(ws + WS_X); const float* gc = MOD + 2 * 1024 + 2 * 6144;
          auto epi = [=](int row, int col, const f32x4 v) { const f32x4 xv = *(const f32x4*)(xc + (size_t)row * D + col), gv = *(const f32x4*)(gc + col); *(u32x2*)(Xb + (size_t)row * D + col) = f32_to_bf4(xv + gv * v); };
          for (int u = c.vcu; u < (TC / 64) * (D / 32); u += c.G) ctx_tile_gemm<1>(c.lds, (const bf16_t*)(ws + WS_HMF), wsm + WO_WOUTE / 2, (u / (D / 32)) * 64, (u % (D / 32)) * 32, c.wave, epi); }
    REPE } SEAM(PH_EOUT);
    moe_program<LO, HI, 0>(c);
    if constexpr (IN(PH_OINPROJ)) { REPB(PH_OINPROJ) LOADA();
        pg8::Gemm g{(const bf16_t*)(ws + WS_HMF) + (size_t)TC * D, wsm + WO_WINO / 2, TL, NZO, D}; pg8::StaticOrder S; S.init(TL, NZO, c.G, (int)blockIdx.x);
        pg8::EpiStoreBf16 E{(bf16_t*)(ws + WS_RA), NZO, TC};
        pg8::gemm_phase<pg8::EpiStoreBf16, pg8::StaticOrder>(c.lds, g, S, E, c.wave);
        { bf16_t* Zb = (bf16_t*)(ws + WS_RA);
          auto epi = [=](int row, int col, const f32x4 v) { *(u32x2*)(Zb + (size_t)row * NZO + col) = f32_to_bf4(v); };
          for (int u = c.vcu; u < (TC / 64) * (NZO / 64); u += c.G) ctx_tile_gemm<2>(c.lds, (const bf16_t*)(ws + WS_HMF), wsm + WO_WINO / 2, (u / (NZO / 64)) * 64, (u % (NZO / 64)) * 64, c.wave, epi); }
    REPE } SEAM(PH_OINPROJ);
    if constexpr (IN(PH_OPOST)) { REPB(PH_OPOST) LOADA(); phase_opost(args, c); REPE } SEAM(PH_OPOST);
    if constexpr (IN(PH_OGEMM)) { REPB(PH_OGEMM) LOADA();
        { pg8::Gemm g{(const bf16_t*)(ws + WS_RC + 33 * MiB) + (size_t)TC * 256, wsm + WO_WUQ / 2, TL, 512, 256}; pg8::StaticOrder S; S.init(TL, 512, c.G, (int)blockIdx.x);
          pg8::EpiStoreBf16 E{(bf16_t*)(ws + WS_RA), 512, TC};
          pg8::gemm_phase<pg8::EpiStoreBf16, pg8::StaticOrder>(c.lds, g, S, E, c.wave); }
        { pg8::Gemm g{(const bf16_t*)(ws + WS_RC + 50 * MiB), wsm + WO_WUKV / 2, NROW, 768, 128}; pg8::StaticOrder S; S.init(NROW, 768, c.G, (int)blockIdx.x);
          pg8::EpiStoreBf16 E{(bf16_t*)(ws + WS_RA + 33 * MiB), 768, 0};
          pg8::gemm_phase<pg8::EpiStoreBf16, pg8::StaticOrder>(c.lds, g, S, E, c.wave); }
    REPE } SEAM(PH_OGEMM);
    if constexpr (IN(PH_OPOST2)) { REPB(PH_OPOST2) LOADA(); phase_opost2(args, c); REPE } SEAM(PH_OPOST2);
    if constexpr (IN(PH_OATTN)) { REPB(PH_OATTN) LOADA(); phase_oattn(args, c); REPE } SEAM(PH_OATTN);
    { bool need_ = true;
      if constexpr (IN(PH_OSUB)) { LOADA(); const int ln_ = mk_tid(c.wave) & 63; float gqx = fabsf(args.in[I_OGQC][ln_]), gkx = fabsf(args.in[I_OGKC][ln_]); gqx = wave_max(gqx); gkx = wave_max(gkx);
        need_ = !((0.125f * LOG2E * 64.f * gqx * gkx) < 90.f); }
      if (need_) { if constexpr (IN(PH_OSUB)) { REPB(PH_OSUB) LOADA(); phase_osub(args, c); REPE } SEAM(PH_OSUB); } }
    if constexpr (IN(PH_OOUT)) { REPB(PH_OOUT) LOADA();
        pg8::Gemm g{(const bf16_t*)(ws + WS_HMF) + (size_t)TC * D, wsm + WO_WOUTO / 2, TL, D, D}; pg8::StaticOrder S; S.init(TL, D, c.G, (int)blockIdx.x);
        pg8::EpiResid E{nullptr, nullptr, (bf16_t*)(ws + WS_X), MOD + 3 * 6144 + 2 * 1024, TC, 1};
        pg8::gemm_phase<pg8::EpiResid, pg8::StaticOrder>(c.lds, g, S, E, c.wave);
    REPE } SEAM(PH_OOUT);
    moe_program<LO, HI, 1>(c);
}
#undef IN
#undef SEAM

#ifndef HOST_DUP_MASK
#define HOST_DUP_MASK 0ull
#endif
template <int P> static void launch_phase(int grid, hipStream_t stream, const Args& a) {
    for (int rep = 0; rep < ((((unsigned long long)HOST_DUP_MASK >> P) & 1ull) ? 2 : 1); ++rep) {
        Args b = a; b.ph_lo = rep;
        hipLaunchKernelGGL((fwd_kernel<P, P + 1>), dim3(grid), dim3(512), LDS_BYTES, stream, b); }
}
template <int P> static void set_attr_phase() { (void)hipFuncSetAttribute((const void*)fwd_kernel<P, P + 1>, hipFuncAttributeMaxDynamicSharedMemorySize, LDS_BYTES); }
template <int... Ps> static void set_attr_all(std::integer_sequence<int, Ps...>) { (set_attr_phase<Ps>(), ...); }
template <int... Ps> static void launch_all(int grid, hipStream_t stream, const Args& a, std::integer_sequence<int, Ps...>) { (launch_phase<Ps>(grid, stream, a), ...); }

extern "C" void kernel_launch(void* const* d_in, const int* in_sizes, int n_in, void* d_out, int out_size, void* d_ws, size_t ws_size, hipStream_t stream) {
    static int grid = 0;
    if (grid == 0) {
        if (n_in != 33 || out_size != TL * D || ws_size < WS_NEED) { fprintf(stderr, "kernel_launch: unexpected shapes (n_in %d out %d ws %zu need %zu)\n", n_in, out_size, ws_size, (size_t)WS_NEED); grid = -1; return; }
        int dev = 0, cus = 0;
        if (hipGetDevice(&dev) != hipSuccess || hipDeviceGetAttribute(&cus, hipDeviceAttributeMultiprocessorCount, dev) != hipSuccess) { grid = -1; return; }
#if MK_ONE_LAUNCH
        if (hipFuncSetAttribute((const void*)fwd_kernel<0, NPH>, hipFuncAttributeMaxDynamicSharedMemorySize, LDS_BYTES) != hipSuccess) { fprintf(stderr, "kernel_launch: hipFuncSetAttribute failed\n"); grid = -1; return; }
#else
        set_attr_all(std::make_integer_sequence<int, NPH>{});
#endif
        (void)hipGetLastError();
        grid = cus;
    }
    if (grid < 0) return;
    (void)hipMemsetAsync((char*)d_ws + WS_CTL, 0, CTL_ZERO_BYTES, stream);
    Args a{};
    for (int i = 0; i < 33; ++i) a.in[i] = (const float*)d_in[i];
    a.out = (float*)d_out; a.ws = (unsigned char*)d_ws;
    a.ph_lo = 0; a.ph_hi = NPH;
#if MK_ONE_LAUNCH
    hipLaunchKernelGGL((fwd_kernel<0, NPH>), dim3(grid), dim3(512), LDS_BYTES, stream, a);
#else
    launch_all(grid, stream, a, std::make_integer_sequence<int, NPH>{});
#endif
}
```
